# Optimizing an MI355X kernel written in HIP

```python
import math
import jax, jax.numpy as jnp
from jax import lax
import numpy as np

D_MODEL = 2048
BATCH = 4
SEQ = 4096
DEPTH = 2

HEAD_DIM = 128
A_HEADS = 6
A_HALF = HEAD_DIM // 2
A_WIDTH = A_HEADS * HEAD_DIM
B_HEADS = 6
B_WIDTH = B_HEADS * HEAD_DIM
B_Q_RANK = 512
B_KV_RANK = 256
IDX_HEADS = 16
IDX_DIM = 64
TOPK_MAX = 256
C_GROUPS = 4
C_GROUP_DIM = 128
C_WIDTH = C_GROUPS * C_GROUP_DIM
CHUNK = 128
MIX_WIDTH = A_WIDTH + B_WIDTH + C_WIDTH
IN_SIZES = (A_WIDTH, A_WIDTH, A_WIDTH, B_Q_RANK, B_KV_RANK, IDX_DIM, IDX_HEADS, C_WIDTH, C_WIDTH)
IN_COLS = sum(IN_SIZES)
MEM_LEN = 256
X_HEADS = 4
X_DIM = 128
FFN_HIDDEN = ((-(-8 * D_MODEL // 3) + 255) // 256) * 256
REL_BUCKETS = 32
REL_MAX_DIST = 128
REL_HEADS = A_HEADS + B_HEADS
Q_BLOCK = 128
EPS = 1e-6

kernel_name = "hybrid_diffattn_dsa_gmlp_block"


def rms_norm(x, g):
    xf = x.astype(jnp.float32)
    y = xf * lax.rsqrt(jnp.mean(xf * xf, axis=-1, keepdims=True) + EPS)
    return (y * g.astype(jnp.float32)).astype(x.dtype)


def layer_norm(x, g, b):
    xf = x.astype(jnp.float32)
    mu = jnp.mean(xf, axis=-1, keepdims=True)
    xc = xf - mu
    var = jnp.mean(xc * xc, axis=-1, keepdims=True)
    return (xc * lax.rsqrt(var + EPS) * g.astype(jnp.float32) + b.astype(jnp.float32)).astype(x.dtype)


def rel_bucket(dist):
    n = jnp.maximum(dist, 0)
    max_exact = REL_BUCKETS // 2
    nf = jnp.maximum(n, 1).astype(jnp.float32)
    large = max_exact + (jnp.log(nf / max_exact) / math.log(REL_MAX_DIST / max_exact)
                         * (REL_BUCKETS - max_exact)).astype(jnp.int32)
    large = jnp.minimum(large, REL_BUCKETS - 1)
    return jnp.where(n < max_exact, n, large)


def to_blocks(t):
    b, s = t.shape[:2]
    return jnp.moveaxis(t.reshape((b, s // Q_BLOCK, Q_BLOCK) + t.shape[2:]), 1, 0)


def from_blocks(t):
    t = jnp.moveaxis(t, 0, 1)
    return t.reshape((t.shape[0], t.shape[1] * t.shape[2]) + t.shape[3:])


def diff_attention(q, k, v, lam, bias_tab, sub_g, lam_init):
    s_len = q.shape[1]
    kpos = jnp.arange(s_len)
    scale = A_HALF ** -0.5

    def block(args):
        qi, i = args
        qpos = i * Q_BLOCK + jnp.arange(Q_BLOCK)
        dist = qpos[:, None] - kpos[None, :]
        bias = jnp.transpose(bias_tab[rel_bucket(dist)], (2, 0, 1)).astype(jnp.float32)
        logits = jnp.einsum('bqhmd,bshmd->bhmqs', qi, k).astype(jnp.float32) * scale
        logits = logits + bias[None, :, None]
        logits = jnp.where((dist >= 0)[None, None, None], logits, -jnp.inf)
        p = jax.nn.softmax(logits, axis=-1)
        attn = p[:, :, 0] - lam * p[:, :, 1]
        return jnp.einsum('bhqs,bshd->bqhd', attn.astype(v.dtype), v)

    nblk = s_len // Q_BLOCK
    o = from_blocks(lax.map(block, (to_blocks(q), jnp.arange(nblk))))
    return rms_norm(o, sub_g) * (1.0 - lam_init)


def dsa_attention(c_q, c_kv, k_idx, w_idx, w_uq, w_qidx, w_uk, w_uv, bias_tab):
    bsz, s_len = c_q.shape[:2]
    topk = min(TOPK_MAX, s_len // 4)
    q = jnp.einsum('bsr,rhd->bshd', c_q, w_uq)
    q_lat = jnp.einsum('bshd,rhd->bshr', q, w_uk)
    q_idx = jnp.einsum('bsr,rgd->bsgd', c_q, w_qidx)
    w_idx = w_idx * (IDX_HEADS ** -0.5)
    kpos = jnp.arange(s_len)
    bidx = jnp.arange(bsz)[:, None, None]

    def block(args):
        qi, wi, ql, i = args
        qpos = i * Q_BLOCK + jnp.arange(Q_BLOCK)
        dots = jnp.einsum('bqgd,bsd->bqsg', qi, k_idx) * (IDX_DIM ** -0.5)
        score = jnp.einsum('bqsg,bqg->bqs', jax.nn.relu(dots), wi).astype(jnp.float32)
        causal = kpos[None, :] <= qpos[:, None]
        score = jnp.where(causal[None], score, -jnp.inf)
        top_score, idx = lax.top_k(score, topk)
        valid = jnp.isfinite(top_score)
        c_sel = c_kv[bidx, idx]
        dist = qpos[None, :, None] - idx
        bias = jnp.transpose(bias_tab[rel_bucket(dist)], (0, 3, 1, 2)).astype(jnp.float32)
        logits = jnp.einsum('bqhr,bqkr->bhqk', ql, c_sel).astype(jnp.float32) * (HEAD_DIM ** -0.5) + bias
        logits = jnp.where(valid[:, None], logits, -jnp.inf)
        p = jax.nn.softmax(logits, axis=-1)
        return jnp.einsum('bhqk,bqkr->bqhr', p.astype(c_sel.dtype), c_sel)

    nblk = s_len // Q_BLOCK
    o_lat = from_blocks(lax.map(block, (to_blocks(q_idx), to_blocks(w_idx), to_blocks(q_lat),
                                        jnp.arange(nblk))))
    return jnp.einsum('bshr,rhd->bshd', o_lat, w_uv)


def chunk_spatial_gating(u, v, ln_g, ln_b, w_s, b_s):
    v = layer_norm(v, ln_g, ln_b)
    bsz, s_len = v.shape[:2]
    vc = v.reshape(bsz, s_len // CHUNK, CHUNK, C_GROUPS, C_GROUP_DIM)
    mask = jnp.tril(jnp.ones((CHUNK, CHUNK), dtype=bool))
    w = jnp.where(mask[None], w_s, jnp.zeros_like(w_s))
    y = jnp.einsum('gts,bnsgc->bntgc', w, vc) + jnp.transpose(b_s)[None, None, :, :, None]
    return u * y.reshape(bsz, s_len, C_WIDTH)


def memory_attention(h, mem_n, wq, wkv, wo):
    q = jnp.einsum('bsd,dhe->bshe', h, wq)
    kv = jnp.einsum('bmd,dche->bmche', mem_n, wkv)
    k, v = kv[:, :, 0], kv[:, :, 1]
    logits = jnp.einsum('bshe,bmhe->bhsm', q, k).astype(jnp.float32) * (X_DIM ** -0.5)
    p = jax.nn.softmax(logits, axis=-1)
    o = jnp.einsum('bhsm,bmhe->bshe', p.astype(v.dtype), v)
    return jnp.einsum('bshe,hed->bsd', o, wo)


def swiglu(h, w_gu, w_down):
    gu = jnp.einsum('bsd,dcf->bscf', h, w_gu)
    return jnp.einsum('bsf,fd->bsd', jax.nn.silu(gu[:, :, 0]) * gu[:, :, 1], w_down)


def setup_inputs(seed: int = 0) -> dict:
    key = jax.random.key(seed)
    ks = iter(jax.random.split(key, 40))
    f32 = jnp.float32

    def nrm(shape, scale):
        return jax.random.normal(next(ks), shape, f32) * scale

    def gain(shape):
        return 1.0 + 0.05 * jax.random.normal(next(ks), shape, f32)

    L = DEPTH
    return {
        "x": nrm((BATCH, SEQ, D_MODEL), 1.0),
        "mem": nrm((BATCH, MEM_LEN, D_MODEL), 1.0),
        "rel_bias": nrm((REL_BUCKETS, REL_HEADS), 0.5),
        "mix_pre_g": gain((L, D_MODEL)),
        "mix_post_g": gain((L, D_MODEL)),
        "w_in": nrm((L, D_MODEL, IN_COLS), D_MODEL ** -0.5),
        "w_out": nrm((L, MIX_WIDTH, D_MODEL), MIX_WIDTH ** -0.5),
        "a_lambda": nrm((L, 4, A_HALF), 0.1),
        "a_sub_g": gain((L, HEAD_DIM)),
        "b_cq_g": gain((L, B_Q_RANK)),
        "b_ckv_g": gain((L, B_KV_RANK)),
        "b_w_uq": nrm((L, B_Q_RANK, B_HEADS, HEAD_DIM), B_Q_RANK ** -0.5),
        "b_w_qidx": nrm((L, B_Q_RANK, IDX_HEADS, IDX_DIM), B_Q_RANK ** -0.5),
        "b_w_uk": nrm((L, B_KV_RANK, B_HEADS, HEAD_DIM), B_KV_RANK ** -0.5),
        "b_w_uv": nrm((L, B_KV_RANK, B_HEADS, HEAD_DIM), B_KV_RANK ** -0.5),
        "c_ln_g": gain((L, C_WIDTH)),
        "c_ln_b": nrm((L, C_WIDTH), 0.02),
        "c_w_s": nrm((L, C_GROUPS, CHUNK, CHUNK), CHUNK ** -0.5),
        "c_b_s": 1.0 + nrm((L, C_GROUPS, CHUNK), 0.1),
        "x_pre_g": gain((L, D_MODEL)),
        "x_post_g": gain((L, D_MODEL)),
        "mem_g": gain((L, D_MODEL)),
        "x_wq": nrm((L, D_MODEL, X_HEADS, X_DIM), D_MODEL ** -0.5),
        "x_wkv": nrm((L, D_MODEL, 2, X_HEADS, X_DIM), D_MODEL ** -0.5),
        "x_wo": nrm((L, X_HEADS, X_DIM, D_MODEL), (X_HEADS * X_DIM) ** -0.5),
        "f_pre_g": gain((L, D_MODEL)),
        "f_post_g": gain((L, D_MODEL)),
        "f_w_gu": nrm((L, D_MODEL, 2, FFN_HIDDEN), D_MODEL ** -0.5),
        "f_w_down": nrm((L, FFN_HIDDEN, D_MODEL), FFN_HIDDEN ** -0.5),
    }


def reference(x, mem, rel_bias, mix_pre_g, mix_post_g, w_in, w_out, a_lambda, a_sub_g,
              b_cq_g, b_ckv_g, b_w_uq, b_w_qidx, b_w_uk, b_w_uv,
              c_ln_g, c_ln_b, c_w_s, c_b_s,
              x_pre_g, x_post_g, mem_g, x_wq, x_wkv, x_wo,
              f_pre_g, f_post_g, f_w_gu, f_w_down):
    bsz, s_len, _ = x.shape
    bias_a = rel_bias[:, :A_HEADS]
    bias_b = rel_bias[:, A_HEADS:]
    split_at = np.cumsum(IN_SIZES)[:-1].tolist()
    h = x
    for l in range(DEPTH):
        lam_init = 0.8 - 0.6 * math.exp(-0.3 * l)
        xn = rms_norm(h, mix_pre_g[l])
        proj = jnp.einsum('bsd,dc->bsc', xn, w_in[l])
        qa, ka, va, cq, ckv, kidx, widx, cu, cv = jnp.split(proj, split_at, axis=-1)
        lp = a_lambda[l].astype(jnp.float32)
        lam = jnp.exp(jnp.sum(lp[0] * lp[1])) - jnp.exp(jnp.sum(lp[2] * lp[3])) + lam_init
        oa = diff_attention(qa.reshape(bsz, s_len, A_HEADS, 2, A_HALF),
                            ka.reshape(bsz, s_len, A_HEADS, 2, A_HALF),
                            va.reshape(bsz, s_len, A_HEADS, HEAD_DIM),
                            lam, bias_a, a_sub_g[l], lam_init)
        ob = dsa_attention(rms_norm(cq, b_cq_g[l]), rms_norm(ckv, b_ckv_g[l]), kidx, widx,
                           b_w_uq[l], b_w_qidx[l], b_w_uk[l], b_w_uv[l], bias_b)
        oc = chunk_spatial_gating(jax.nn.gelu(cu), jax.nn.gelu(cv), c_ln_g[l], c_ln_b[l],
                                  c_w_s[l], c_b_s[l])
        mix = jnp.concatenate([oa.reshape(bsz, s_len, A_WIDTH),
                               ob.reshape(bsz, s_len, B_WIDTH), oc], axis=-1)
        h = h + rms_norm(jnp.einsum('bsc,cd->bsd', mix, w_out[l]), mix_post_g[l])
        xa = memory_attention(rms_norm(h, x_pre_g[l]), rms_norm(mem, mem_g[l]),
                              x_wq[l], x_wkv[l], x_wo[l])
        h = h + rms_norm(xa, x_post_g[l])
        ff = swiglu(rms_norm(h, f_pre_g[l]), f_w_gu[l], f_w_down[l])
        h = h + rms_norm(ff, f_post_g[l])
    return h
```

```cpp
#include <hip/hip_runtime.h>
#include <stdint.h>
#include <stdio.h>

#ifndef MK_ONE_LAUNCH
#define MK_ONE_LAUNCH 0
#endif

#define LAS __attribute__((address_space(3)))
typedef unsigned short bf16_t;
typedef short bf16x8 __attribute__((ext_vector_type(8)));
typedef short s16x4 __attribute__((ext_vector_type(4)));
typedef float f32x4 __attribute__((ext_vector_type(4)));
typedef float f32x16 __attribute__((ext_vector_type(16)));
typedef unsigned u32x4 __attribute__((ext_vector_type(4)));
typedef unsigned u32x2 __attribute__((ext_vector_type(2)));

constexpr int DM = 2048, NBATCH = 4, SEQ = 4096, MTOK = NBATCH * SEQ, DEPTH = 2;
constexpr int IN_COLS = 4176, NPROJ = 4352;
constexpr int OFF_QA = 0, OFF_KA = 768, OFF_VA = 1536, OFF_CQ = 2304, OFF_CKV = 2816, OFF_KIDX = 3072, OFF_WIDX = 3136, OFF_CU = 3328, OFF_CV = 3840;
constexpr int NQB = 2560;
constexpr int NMIX = 2816;
constexpr int FH = 5632;
constexpr int MEMLEN = 256, MEMROWS = NBATCH * MEMLEN;
constexpr int TOPK = 256;
constexpr float EPS = 1e-6f;
constexpr float LOG2E = 1.4426950408889634f;

constexpr int NTHREADS = 512;
constexpr int LDS_BYTES = 155648;
constexpr int LDS_CTL = LDS_BYTES - 256;

constexpr size_t alignup(size_t x) { return (x + 255) & ~(size_t)255; }
constexpr size_t WS_CTL = 0;
constexpr size_t CTL_BYTES = 65536;
constexpr size_t WS_LUT = WS_CTL + CTL_BYTES;
constexpr size_t WS_LAM = WS_LUT + 12 * 128 * 4;
constexpr size_t WS_W = alignup(WS_LAM + 256);
constexpr size_t W_IN = WS_W;
constexpr size_t W_B = W_IN + (size_t)NPROJ * DM * 2;
constexpr size_t W_OUT = W_B + (size_t)NQB * 512 * 2;
constexpr size_t W_XQ = W_OUT + (size_t)DM * NMIX * 2;
constexpr size_t W_XKV = W_XQ + (size_t)512 * DM * 2;
constexpr size_t W_XO = W_XKV + (size_t)1024 * DM * 2;
constexpr size_t W_GU = W_XO + (size_t)DM * 512 * 2;
constexpr size_t W_DOWN = W_GU + (size_t)2 * FH * DM * 2;
constexpr size_t WS_MEMN = W_DOWN + (size_t)DM * FH * 2;
constexpr size_t WS_KVX = WS_MEMN + (size_t)MEMROWS * DM * 2;
constexpr size_t WS_XN = alignup(WS_KVX + (size_t)MEMROWS * 1024 * 2);
constexpr size_t WS_CQN = WS_XN;
constexpr size_t WS_CKVN = WS_CQN + (size_t)MTOK * 512 * 2;
constexpr size_t WS_R1 = WS_XN + (size_t)MTOK * DM * 2;
constexpr size_t WS_PROJ = WS_R1, WS_TMP = WS_R1;
constexpr size_t WS_R2 = WS_R1 + (size_t)MTOK * NPROJ * 2;
constexpr size_t WS_QB = WS_R2;
constexpr size_t WS_MIX = WS_QB + (size_t)MTOK * NQB * 2;
constexpr size_t WS_IDX = WS_MIX + (size_t)MTOK * NMIX * 2;
constexpr size_t WS_FFH = WS_R2;
constexpr size_t WS_XQ = WS_R2;
constexpr size_t WS_XO = WS_XQ + (size_t)MTOK * 512 * 2;
constexpr size_t WS_END = WS_IDX + (size_t)MTOK * TOPK * 2;
static_assert((size_t)MTOK * FH * 2 <= WS_END - WS_R2, "ffh overlay");
static_assert((size_t)MTOK * DM * 4 <= (size_t)MTOK * NPROJ * 2, "tmp overlay");

constexpr int CW_QUEUE = 0;
constexpr int NQUEUES = 64;
constexpr int CW_BAR = 64 * NQUEUES;

struct Params {
    const float* in[29];
    float* out;
    unsigned char* ws;
    int layer, phase;
};

__device__ __forceinline__ unsigned cvt_pk_bf16(float lo, float hi) { unsigned r; asm("v_cvt_pk_bf16_f32 %0, %1, %2" : "=v"(r) : "v"(lo), "v"(hi)); return r; }
__device__ __forceinline__ float bf2f(unsigned v) { return __uint_as_float(v << 16); }
__device__ __forceinline__ float bflo(unsigned w) { return __uint_as_float(w << 16); }
__device__ __forceinline__ float bfhi(unsigned w) { return __uint_as_float(w & 0xffff0000u); }
__device__ __forceinline__ bf16_t f2bf(float f) { return (bf16_t)(cvt_pk_bf16(f, 0.f) & 0xffffu); }
__device__ __forceinline__ float wave_sum(float v) {
#pragma unroll
    for (int o = 32; o > 0; o >>= 1) v += __shfl_xor(v, o, 64);
    return v;
}
__device__ __forceinline__ float fast_exp2(float x) { return __builtin_amdgcn_exp2f(x); }
__device__ __forceinline__ float fast_rcp(float x) { return __builtin_amdgcn_rcpf(x); }
__device__ __forceinline__ float gelu_tanh(float x) {
    const float u = x * (1.0f + 0.044715f * x * x) * (2.0f * 0.7978845608028654f);
    return x * fast_rcp(1.0f + fast_exp2(-u * LOG2E));
}
__device__ __forceinline__ float silu(float x) { return x * fast_rcp(1.0f + fast_exp2(-x * LOG2E)); }

__device__ __forceinline__ int opaque_tid() { int t = threadIdx.x; asm volatile("" : "+v"(t)); return t; }

__device__ __forceinline__ int queue_next(unsigned* head, unsigned char* smem) {
    volatile LAS unsigned* slot = (volatile LAS unsigned*)(smem + LDS_CTL + 64);
    __syncthreads();
    if (threadIdx.x == 0) *slot = __hip_atomic_fetch_add(head, 1u, __ATOMIC_RELAXED, __HIP_MEMORY_SCOPE_AGENT);
    __syncthreads();
    return (int)*slot;
}

namespace g8 {
constexpr int BM = 256, BK = 64, HALF = 128, HT = HALF * BK;
__device__ __forceinline__ int lds_byte(int r, int c) { const int st = (r >> 4) * 2 + (c >> 5), rr = r & 15, cc = c & 31, ob = rr * 64 + cc * 2; return st * 1024 + (ob ^ (((ob >> 9) & 1) << 5)); }
__device__ __forceinline__ void stage_rc(int b, int& R, int& C) { const int st = b / 1024, sb = b % 1024, swz = sb ^ (((sb >> 9) & 1) << 5); R = (st >> 1) * 16 + swz / 64; C = (st & 1) * 32 + (swz % 64) / 2; }

template <class Epi>
__device__ __forceinline__ void gemm_tile(const bf16_t* __restrict__ A, const bf16_t* __restrict__ Bt, const int K, const int pm, const int pn, const Epi& epi, unsigned char* smem) {
    bf16_t* shm = (bf16_t*)smem;
#define SA(b, h) (shm + ((b) * 2 + (h)) * HT)
#define SB(b, h) (shm + (4 + (b) * 2 + (h)) * HT)
#define STAGE_X(T, P, BASE, br, kt) do { long _g = (long)(br) * K + (long)(kt) * BK; \
    for (int _i = 0; _i < 2; ++_i) { int _b = (T) * 16 + _i * 8192; int _r, _c; stage_rc(_b, _r, _c); \
      __builtin_amdgcn_global_load_lds((const unsigned*)(BASE + _g + (long)_r * K + _c), (LAS unsigned*)((char*)(P) + _b), 16, 0, 0); } } while (0)
#define STAGE(P, BASE, br, kt) STAGE_X(tz0, P, BASE, br, kt)
#define LDA(dst, b, h) for (int m = 0; m < 4; ++m) for (int k = 0; k < 2; ++k) \
    dst[m][k] = *reinterpret_cast<const bf16x8*>((char*)SA(b, h) + lds_byte(wr * 64 + m * 16 + fr, k * 32 + fq * 8))
#define LDB(dst, b, h) for (int n = 0; n < 2; ++n) for (int k = 0; k < 2; ++k) \
    dst[n][k] = *reinterpret_cast<const bf16x8*>((char*)SB(b, h) + lds_byte(wc * 32 + n * 16 + fr, k * 32 + fq * 8))
#define MMA(ai, bj, At_, Bt_) do { __builtin_amdgcn_s_setprio(1); \
    for (int m = 0; m < 4; ++m) for (int n = 0; n < 2; ++n) for (int k = 0; k < 2; ++k) \
      acc[ai][bj][m][n] = __builtin_amdgcn_mfma_f32_16x16x32_bf16(Bt_[n][k], At_[m][k], acc[ai][bj][m][n], 0, 0, 0); \
    __builtin_amdgcn_s_setprio(0); } while (0)
#define WAIT_V(n) asm volatile("s_waitcnt vmcnt(" #n ")" ::: "memory")
#define WAIT_L(n) asm volatile("s_waitcnt lgkmcnt(" #n ")" ::: "memory")
#define BAR __builtin_amdgcn_s_barrier()
#define SCHED __builtin_amdgcn_sched_barrier(0)
    const int brow = pm * BM, bcol = pn * BM;
    int tz0 = threadIdx.x; asm volatile("" : "+v"(tz0));
    int wid = tz0 >> 6, lane = tz0 & 63, wr = wid >> 2, wc = wid & 3, fr = lane & 15, fq = lane >> 4;
    f32x4 acc[2][2][4][2] = {};
    bf16x8 At[4][2], B0[2][2], B1[2][2];
    const int nt = K / BK;
    WAIT_V(0);
    __syncthreads();
    STAGE(SB(0, 0), Bt, bcol, 0); STAGE(SA(0, 0), A, brow, 0);
    STAGE(SB(0, 1), Bt, bcol + HALF, 0); STAGE(SA(0, 1), A, brow + HALF, 0);
    if (wr == 1) BAR;
    WAIT_V(4); BAR;
    STAGE(SB(1, 0), Bt, bcol, 1); STAGE(SA(1, 0), A, brow, 1); STAGE(SB(1, 1), Bt, bcol + HALF, 1);
    WAIT_V(6); BAR;
    for (int t = 0; t < nt - 2; t += 2) {
        LDB(B0, 0, 0); SCHED; LDA(At, 0, 0); STAGE(SA(1, 1), A, brow + HALF, t + 1);
        WAIT_L(8); BAR; WAIT_L(0); MMA(0, 0, At, B0); BAR; SCHED;
        LDB(B1, 0, 1); STAGE(SB(0, 0), Bt, bcol, t + 2);
        BAR; WAIT_L(0); MMA(0, 1, At, B1); BAR;
        LDA(At, 0, 1); STAGE(SA(0, 0), A, brow, t + 2);
        BAR; WAIT_L(0); MMA(1, 0, At, B0); BAR; SCHED;
        STAGE(SB(0, 1), Bt, bcol + HALF, t + 2);
        WAIT_V(6); BAR; MMA(1, 1, At, B1); BAR;
        LDB(B0, 1, 0); SCHED; LDA(At, 1, 0); STAGE(SA(0, 1), A, brow + HALF, t + 2);
        WAIT_L(8); BAR; WAIT_L(0); MMA(0, 0, At, B0); BAR; SCHED;
        LDB(B1, 1, 1); STAGE(SB(1, 0), Bt, bcol, t + 3);
        BAR; WAIT_L(0); MMA(0, 1, At, B1); BAR;
        LDA(At, 1, 1); STAGE(SA(1, 0), A, brow, t + 3);
        BAR; WAIT_L(0); MMA(1, 0, At, B0); BAR; SCHED;
        STAGE(SB(1, 1), Bt, bcol + HALF, t + 3);
        WAIT_V(6); BAR; MMA(1, 1, At, B1); BAR;
    }
    int tz = threadIdx.x; asm volatile("" : "+v"(tz)); wid = tz >> 6; lane = tz & 63; wr = wid >> 2; wc = wid & 3; fr = lane & 15; fq = lane >> 4;
    { LDB(B0, 0, 0); WAIT_V(0); LDA(At, 0, 0); STAGE_X(tz, SA(1, 1), A, brow + HALF, nt - 1);
      BAR; WAIT_L(0); MMA(0, 0, At, B0); BAR;
      LDB(B1, 0, 1); BAR; WAIT_L(0); MMA(0, 1, At, B1); BAR;
      LDA(At, 0, 1); WAIT_V(4); BAR; WAIT_L(0); MMA(1, 0, At, B0); MMA(1, 1, At, B1); BAR; }
    { LDB(B0, 1, 0); LDA(At, 1, 0); WAIT_V(2); BAR; WAIT_L(0); MMA(0, 0, At, B0); BAR;
      LDB(B1, 1, 1); WAIT_V(0); BAR; WAIT_L(0); MMA(0, 1, At, B1); BAR;
      LDA(At, 1, 1); BAR; WAIT_L(0); MMA(1, 0, At, B0); MMA(1, 1, At, B1); BAR; }
    if (wr == 0) BAR;
    epi(acc, pm, pn, wr, wc, fr, fq);
#undef SA
#undef SB
#undef STAGE_X
#undef STAGE
#undef LDA
#undef LDB
#undef MMA
#undef WAIT_V
#undef WAIT_L
#undef BAR
#undef SCHED
}

struct EpiBf16 {
    bf16_t* O; int ldc; int gelu_pn;
    __device__ __forceinline__ void operator()(const f32x4 (&acc)[2][2][4][2], int pm, int pn, int wr, int wc, int fr, int fq) const {
        const bool g = pn >= gelu_pn;
#pragma unroll
        for (int ai = 0; ai < 2; ++ai)
#pragma unroll
            for (int m = 0; m < 4; ++m) {
                bf16_t* rowp = O + (size_t)(pm * BM + ai * HALF + wr * 64 + m * 16 + fr) * ldc + pn * BM + wc * 32 + fq * 4;
#pragma unroll
                for (int bj = 0; bj < 2; ++bj)
#pragma unroll
                    for (int n = 0; n < 2; ++n) {
                        f32x4 v = acc[ai][bj][m][n];
                        if (g) { v[0] = gelu_tanh(v[0]); v[1] = gelu_tanh(v[1]); v[2] = gelu_tanh(v[2]); v[3] = gelu_tanh(v[3]); }
                        u32x2 w; w.x = cvt_pk_bf16(v[0], v[1]); w.y = cvt_pk_bf16(v[2], v[3]);
                        *(u32x2*)(rowp + bj * HALF + n * 16) = w;
                    }
            }
    }
};
struct EpiF32 {
    float* O; int ldc;
    __device__ __forceinline__ void operator()(const f32x4 (&acc)[2][2][4][2], int pm, int pn, int wr, int wc, int fr, int fq) const {
#pragma unroll
        for (int ai = 0; ai < 2; ++ai)
#pragma unroll
            for (int m = 0; m < 4; ++m) {
                float* rowp = O + (size_t)(pm * BM + ai * HALF + wr * 64 + m * 16 + fr) * ldc + pn * BM + wc * 32 + fq * 4;
#pragma unroll
                for (int bj = 0; bj < 2; ++bj)
#pragma unroll
                    for (int n = 0; n < 2; ++n) *(f32x4*)(rowp + bj * HALF + n * 16) = acc[ai][bj][m][n];
            }
    }
};
struct EpiSwiglu {
    bf16_t* O;
    __device__ __forceinline__ void operator()(const f32x4 (&acc)[2][2][4][2], int pm, int pn, int wr, int wc, int fr, int fq) const {
#pragma unroll
        for (int ai = 0; ai < 2; ++ai)
#pragma unroll
            for (int m = 0; m < 4; ++m) {
                bf16_t* rowp = O + (size_t)(pm * BM + ai * HALF + wr * 64 + m * 16 + fr) * FH + pn * HALF + wc * 32 + fq * 4;
#pragma unroll
                for (int n = 0; n < 2; ++n) {
                    const f32x4 gt = acc[ai][0][m][n], up = acc[ai][1][m][n];
                    u32x2 w; w.x = cvt_pk_bf16(silu(gt[0]) * up[0], silu(gt[1]) * up[1]); w.y = cvt_pk_bf16(silu(gt[2]) * up[2], silu(gt[3]) * up[3]);
                    *(u32x2*)(rowp + n * 16) = w;
                }
            }
    }
};
template <class Epi>
__device__ __forceinline__ void gemm_phase(const bf16_t* A, const bf16_t* Bt, int M, int N, int K, const Epi& epi, unsigned char* smem) {
    const int nM = M / BM, nN = N / BM, nu = nM * nN;
    for (int u = blockIdx.x; u < nu; u += gridDim.x) {
        const int grp = u / (8 * nN), rem = u % (8 * nN);
        const int gsz = (nM - grp * 8) < 8 ? (nM - grp * 8) : 8;
        const int pm = grp * 8 + rem % gsz, pn = rem / gsz;
        gemm_tile(A, Bt, K, pm, pn, epi, smem);
    }
}
}

struct ConvJob { const float* src; int src_ld; bf16_t* dst; int dst_ld; int K, N; int map; float scale; };
__device__ __forceinline__ int conv_col(int map, int n) {
    if (map == 1) return n < 3152 ? n : (n < OFF_CU ? -1 : n - (OFF_CU - 3152));
    if (map == 2) { const int j = n >> 8, r = n & 255; return (r < 128 ? 0 : FH) + j * 128 + (r & 127); }
    return n;
}
__device__ __forceinline__ ConvJob conv_job(const Params& p, int l, int j) {
    ConvJob c; c.map = 0; c.scale = 1.0f;
    unsigned char* ws = p.ws;
    switch (j) {
    case 0: c.src = p.in[5] + (size_t)l * DM * IN_COLS; c.src_ld = IN_COLS; c.dst = (bf16_t*)(ws + W_IN); c.dst_ld = DM; c.K = DM; c.N = NPROJ; c.map = 1; break;
    case 1: c.src = p.in[12] + (size_t)l * 512 * 1024; c.src_ld = 1024; c.dst = (bf16_t*)(ws + W_B) + (size_t)1536 * 512; c.dst_ld = 512; c.K = 512; c.N = 1024; c.scale = 1.0f / 32.0f; break;
    case 2: c.src = p.in[6] + (size_t)l * DM * DM; c.src_ld = DM; c.dst = (bf16_t*)(ws + W_OUT); c.dst_ld = NMIX; c.K = 768; c.N = DM; break;
    case 3: c.src = p.in[6] + (size_t)l * DM * DM + (size_t)1536 * DM; c.src_ld = DM; c.dst = (bf16_t*)(ws + W_OUT) + 2304; c.dst_ld = NMIX; c.K = 512; c.N = DM; break;
    case 4: c.src = p.in[22] + (size_t)l * DM * 512; c.src_ld = 512; c.dst = (bf16_t*)(ws + W_XQ); c.dst_ld = DM; c.K = DM; c.N = 512; break;
    case 5: c.src = p.in[23] + (size_t)l * DM * 1024; c.src_ld = 1024; c.dst = (bf16_t*)(ws + W_XKV); c.dst_ld = DM; c.K = DM; c.N = 1024; break;
    case 6: c.src = p.in[24] + (size_t)l * 512 * DM; c.src_ld = DM; c.dst = (bf16_t*)(ws + W_XO); c.dst_ld = 512; c.K = 512; c.N = DM; break;
    case 7: c.src = p.in[27] + (size_t)l * DM * 2 * FH; c.src_ld = 2 * FH; c.dst = (bf16_t*)(ws + W_GU); c.dst_ld = DM; c.K = DM; c.N = 2 * FH; c.map = 2; break;
    default: c.src = p.in[28] + (size_t)l * FH * DM; c.src_ld = DM; c.dst = (bf16_t*)(ws + W_DOWN); c.dst_ld = FH; c.K = FH; c.N = DM; break;
    }
    return c;
}
constexpr int NCONV = 9;

__device__ __forceinline__ void conv_tile(const ConvJob& c, int kt, int nt, unsigned char* smem) {
    bf16_t* t = (bf16_t*)smem;
    const int tid = threadIdx.x, nn = tid & 63, k0 = kt * 64, n0 = nt * 64;
    const int col = conv_col(c.map, n0 + nn);
    __syncthreads();
#pragma unroll
    for (int i = 0; i < 8; ++i) {
        const int kk = (tid >> 6) + 8 * i;
        const float v = col >= 0 ? c.src[(size_t)(k0 + kk) * c.src_ld + col] * c.scale : 0.f;
        t[nn * 66 + kk] = f2bf(v);
    }
    __syncthreads();
    const int rn = tid >> 3, kc = (tid & 7) * 8;
    const unsigned* s = (const unsigned*)(t + rn * 66 + kc);
    u32x4 w; w.x = s[0]; w.y = s[1]; w.z = s[2]; w.w = s[3];
    *(u32x4*)(c.dst + (size_t)(n0 + rn) * c.dst_ld + k0 + kc) = w;
}

__device__ __forceinline__ void rownorm_to_bf16(const float* src, const float* g, bf16_t* dst, int lane) {
    f32x4 v[8]; float ss = 0.f;
#pragma unroll
    for (int i = 0; i < 8; ++i) { v[i] = *(const f32x4*)(src + (i * 64 + lane) * 4); ss += v[i][0] * v[i][0] + v[i][1] * v[i][1] + v[i][2] * v[i][2] + v[i][3] * v[i][3]; }
    ss = wave_sum(ss);
    const float r = rsqrtf(ss * (1.0f / DM) + EPS);
#pragma unroll
    for (int i = 0; i < 8; ++i) {
        const f32x4 gg = *(const f32x4*)(g + (i * 64 + lane) * 4);
        u32x2 w; w.x = cvt_pk_bf16(v[i][0] * r * gg[0], v[i][1] * r * gg[1]); w.y = cvt_pk_bf16(v[i][2] * r * gg[2], v[i][3] * r * gg[3]);
        *(u32x2*)(dst + (i * 64 + lane) * 4) = w;
    }
}

__device__ __forceinline__ int rel_bucket(int n) {
    if (n < 16) return n;
    const int b = 16 + (int)(logf((float)n / 16.0f) / 2.0794415416798357f * 16.0f);
    return b < 31 ? b : 31;
}

__device__ void phase_weights(const Params& p, int l, unsigned char* smem) {
    const int tid = threadIdx.x, wid = tid >> 6, lane = tid & 63;
    const int gtid = blockIdx.x * NTHREADS + tid, gthreads = gridDim.x * NTHREADS;
    unsigned char* ws = p.ws;
    int base = 0;
    for (int j = 0; j < NCONV; ++j) {
        const ConvJob c = conv_job(p, l, j);
        const int nkt = c.K / 64, ntl = nkt * (c.N / 64);
        int first = ((int)blockIdx.x - base % (int)gridDim.x + (int)gridDim.x) % (int)gridDim.x;
        for (int t = first; t < ntl; t += gridDim.x) conv_tile(c, t % nkt, t / nkt, smem);
        base += ntl;
    }
    {
        const float* uq = p.in[11] + (size_t)l * 512 * 768;
        const float* uk = p.in[13] + (size_t)l * 256 * 768;
        bf16_t* dst = (bf16_t*)(ws + W_B);
        for (int o = gtid; o < 1536 * 512; o += gthreads) {
            const int rq = o & 511, n = o >> 9, h = n >> 8, rkv = n & 255;
            const f32x4* a = (const f32x4*)(uq + (size_t)rq * 768 + h * 128);
            const f32x4* b = (const f32x4*)(uk + (size_t)rkv * 768 + h * 128);
            float s = 0.f;
#pragma unroll 8
            for (int d = 0; d < 32; ++d) { const f32x4 x = a[d], y = b[d]; s += x[0] * y[0] + x[1] * y[1] + x[2] * y[2] + x[3] * y[3]; }
            dst[(size_t)n * 512 + rq] = f2bf(s * 0.08838834764831845f);
        }
    }
    {
        const float* uv = p.in[14] + (size_t)l * 256 * 768;
        const float* wo = p.in[6] + (size_t)l * DM * DM;
        bf16_t* dst = (bf16_t*)(ws + W_OUT);
        for (int o = gtid; o < DM * 6 * 32; o += gthreads) {
            const int n = o & (DM - 1), hr = o >> 11, h = hr >> 5, r8 = (hr & 31) * 8;
            float acc[8] = {0.f, 0.f, 0.f, 0.f, 0.f, 0.f, 0.f, 0.f};
            const float* wcol = wo + (size_t)(768 + h * 128) * DM + n;
            const float* uvp = uv + (size_t)r8 * 768 + h * 128;
            for (int e = 0; e < 128; ++e) {
                const float w = wcol[(size_t)e * DM];
#pragma unroll
                for (int i = 0; i < 8; ++i) acc[i] += uvp[(size_t)i * 768 + e] * w;
            }
            u32x4 w4; w4.x = cvt_pk_bf16(acc[0], acc[1]); w4.y = cvt_pk_bf16(acc[2], acc[3]); w4.z = cvt_pk_bf16(acc[4], acc[5]); w4.w = cvt_pk_bf16(acc[6], acc[7]);
            *(u32x4*)(dst + (size_t)n * NMIX + 768 + h * 256 + r8) = w4;
        }
    }
    for (int r = blockIdx.x * 8 + wid; r < MEMROWS; r += gridDim.x * 8)
        rownorm_to_bf16(p.in[1] + (size_t)r * DM, p.in[21] + (size_t)l * DM, (bf16_t*)(ws + WS_MEMN) + (size_t)r * DM, lane);
    if (l == 0) {
        for (int r = blockIdx.x * 8 + wid; r < MTOK; r += gridDim.x * 8)
            rownorm_to_bf16(p.in[0] + (size_t)r * DM, p.in[3], (bf16_t*)(ws + WS_XN) + (size_t)r * DM, lane);
        float* lut = (float*)(ws + WS_LUT);
        for (int o = gtid; o < 12 * 128; o += gthreads) { const int h = o >> 7, d = o & 127; lut[o] = p.in[2][rel_bucket(d) * 12 + h] * LOG2E; }
    }
    if (blockIdx.x == 0 && wid == 0) {
        const float* lp = p.in[7] + (size_t)l * 256;
        float a = lp[lane] * lp[64 + lane], b = lp[128 + lane] * lp[192 + lane];
        a = wave_sum(a); b = wave_sum(b);
        if (lane == 0) ((float*)(ws + WS_LAM))[l] = expf(a) - expf(b) + (0.8f - 0.6f * expf(-0.3f * (float)l));
    }
}

__device__ void phase_post(const float* tmp, const float* hold, float* hnew, const float* g_post, const float* g_pre, bf16_t* xn) {
    const int wid = threadIdx.x >> 6, lane = threadIdx.x & 63;
    for (int r = blockIdx.x * 8 + wid; r < MTOK; r += gridDim.x * 8) {
        const float* t = tmp + (size_t)r * DM; const float* ho = hold + (size_t)r * DM; float* hn = hnew + (size_t)r * DM;
        f32x4 v[8], hv[8]; float ss = 0.f;
#pragma unroll
        for (int i = 0; i < 8; ++i) { v[i] = *(const f32x4*)(t + (i * 64 + lane) * 4); hv[i] = *(const f32x4*)(ho + (i * 64 + lane) * 4);
            ss += v[i][0] * v[i][0] + v[i][1] * v[i][1] + v[i][2] * v[i][2] + v[i][3] * v[i][3]; }
        ss = wave_sum(ss);
        const float rr = rsqrtf(ss * (1.0f / DM) + EPS);
        float s2 = 0.f;
#pragma unroll
        for (int i = 0; i < 8; ++i) {
            const f32x4 gg = *(const f32x4*)(g_post + (i * 64 + lane) * 4);
            hv[i] = hv[i] + v[i] * rr * gg;
            *(f32x4*)(hn + (i * 64 + lane) * 4) = hv[i];
            s2 += hv[i][0] * hv[i][0] + hv[i][1] * hv[i][1] + hv[i][2] * hv[i][2] + hv[i][3] * hv[i][3];
        }
        if (g_pre) {
            s2 = wave_sum(s2);
            const float r2 = rsqrtf(s2 * (1.0f / DM) + EPS);
            bf16_t* xr = xn + (size_t)r * DM;
#pragma unroll
            for (int i = 0; i < 8; ++i) {
                const f32x4 gg = *(const f32x4*)(g_pre + (i * 64 + lane) * 4);
                u32x2 w; w.x = cvt_pk_bf16(hv[i][0] * r2 * gg[0], hv[i][1] * r2 * gg[1]); w.y = cvt_pk_bf16(hv[i][2] * r2 * gg[2], hv[i][3] * r2 * gg[3]);
                *(u32x2*)(xr + (i * 64 + lane) * 4) = w;
            }
        }
    }
}

__device__ void phase_latent_norms(const Params& p, int l) {
    const int wid = threadIdx.x >> 6, lane = threadIdx.x & 63;
    const bf16_t* proj = (const bf16_t*)(p.ws + WS_PROJ);
    bf16_t* cqn = (bf16_t*)(p.ws + WS_CQN); bf16_t* ckvn = (bf16_t*)(p.ws + WS_CKVN);
    const float* gq = p.in[9] + (size_t)l * 512; const float* gkv = p.in[10] + (size_t)l * 256;
    for (int r = blockIdx.x * 8 + wid; r < MTOK; r += gridDim.x * 8) {
        const u32x4 a = *(const u32x4*)(proj + (size_t)r * NPROJ + OFF_CQ + lane * 8);
        const u32x2 b = *(const u32x2*)(proj + (size_t)r * NPROJ + OFF_CKV + lane * 4);
        float x[8] = {bflo(a.x), bfhi(a.x), bflo(a.y), bfhi(a.y), bflo(a.z), bfhi(a.z), bflo(a.w), bfhi(a.w)};
        float y[4] = {bflo(b.x), bfhi(b.x), bflo(b.y), bfhi(b.y)};
        float sa = 0.f, sb = 0.f;
#pragma unroll
        for (int i = 0; i < 8; ++i) sa += x[i] * x[i];
#pragma unroll
        for (int i = 0; i < 4; ++i) sb += y[i] * y[i];
        sa = wave_sum(sa); sb = wave_sum(sb);
        const float ra = rsqrtf(sa * (1.0f / 512.0f) + EPS), rb = rsqrtf(sb * (1.0f / 256.0f) + EPS);
        const f32x4 g0 = *(const f32x4*)(gq + lane * 8), g1 = *(const f32x4*)(gq + lane * 8 + 4), g2 = *(const f32x4*)(gkv + lane * 4);
        u32x4 wa; wa.x = cvt_pk_bf16(x[0] * ra * g0[0], x[1] * ra * g0[1]); wa.y = cvt_pk_bf16(x[2] * ra * g0[2], x[3] * ra * g0[3]);
        wa.z = cvt_pk_bf16(x[4] * ra * g1[0], x[5] * ra * g1[1]); wa.w = cvt_pk_bf16(x[6] * ra * g1[2], x[7] * ra * g1[3]);
        u32x2 wb; wb.x = cvt_pk_bf16(y[0] * rb * g2[0], y[1] * rb * g2[1]); wb.y = cvt_pk_bf16(y[2] * rb * g2[2], y[3] * rb * g2[3]);
        *(u32x4*)(cqn + (size_t)r * 512 + lane * 8) = wa;
        *(u32x2*)(ckvn + (size_t)r * 256 + lane * 4) = wb;
    }
}

__device__ void cbranch_unit(const Params& p, int l, int unit, unsigned char* smem) {
    constexpr int LS = 136;
    bf16_t* Ws = (bf16_t*)smem;
    bf16_t* vT = Ws + 128 * LS;
    const int tid = opaque_tid(), wid = tid >> 6, lane = tid & 63;
    const int chunk = unit >> 2, g = unit & 3, r0 = chunk * 128;
    const bf16_t* proj = (const bf16_t*)(p.ws + WS_PROJ);
    bf16_t* mix = (bf16_t*)(p.ws + WS_MIX);
    __syncthreads();
    {
        const int s = tid >> 2, part = tid & 3;
        const bf16_t* row = proj + (size_t)(r0 + s) * NPROJ + OFF_CV;
        float sum = 0.f, sq = 0.f;
#pragma unroll 4
        for (int i = 0; i < 16; ++i) {
            const u32x4 a = *(const u32x4*)(row + part * 128 + i * 8);
            const float x[8] = {bflo(a.x), bfhi(a.x), bflo(a.y), bfhi(a.y), bflo(a.z), bfhi(a.z), bflo(a.w), bfhi(a.w)};
#pragma unroll
            for (int j = 0; j < 8; ++j) { sum += x[j]; sq += x[j] * x[j]; }
        }
        sum += __shfl_xor(sum, 1, 64); sq += __shfl_xor(sq, 1, 64);
        sum += __shfl_xor(sum, 2, 64); sq += __shfl_xor(sq, 2, 64);
        const float mu = sum * (1.0f / 512.0f);
        const float var = fmaxf(sq * (1.0f / 512.0f) - mu * mu, 0.f);
        const float rstd = rsqrtf(var + EPS);
        const float* lg = p.in[15] + (size_t)l * 512 + g * 128 + part * 32;
        const float* lb = p.in[16] + (size_t)l * 512 + g * 128 + part * 32;
#pragma unroll
        for (int i = 0; i < 4; ++i) {
            const u32x4 a = *(const u32x4*)(row + g * 128 + part * 32 + i * 8);
            const float x[8] = {bflo(a.x), bfhi(a.x), bflo(a.y), bfhi(a.y), bflo(a.z), bfhi(a.z), bflo(a.w), bfhi(a.w)};
#pragma unroll
            for (int j = 0; j < 8; ++j) {
                const int c = part * 32 + i * 8 + j;
                vT[c * LS + s] = f2bf((x[j] - mu) * rstd * lg[i * 8 + j] + lb[i * 8 + j]);
            }
        }
        const float* wsrc = p.in[17] + ((size_t)l * 4 + g) * 128 * 128 + (size_t)s * 128 + part * 32;
#pragma unroll
        for (int i = 0; i < 8; ++i) {
            const f32x4 w = *(const f32x4*)(wsrc + i * 4);
            const int c0 = part * 32 + i * 4;
            u32x2 o; o.x = cvt_pk_bf16(c0 <= s ? w[0] : 0.f, c0 + 1 <= s ? w[1] : 0.f); o.y = cvt_pk_bf16(c0 + 2 <= s ? w[2] : 0.f, c0 + 3 <= s ? w[3] : 0.f);
            *(u32x2*)(Ws + s * LS + c0) = o;
        }
    }
    __syncthreads();
    const int fr = lane & 15, fq = lane >> 4;
    const int t = wid * 16 + fr;
    const float bs = p.in[18][((size_t)l * 4 + g) * 128 + t];
    const int nks = (wid * 16 + 15) / 32 + 1;
    bf16x8 af[4];
    for (int ks = 0; ks < 4; ++ks) af[ks] = *(const bf16x8*)(Ws + t * LS + ks * 32 + fq * 8);
#pragma unroll
    for (int ct = 0; ct < 8; ++ct) {
        f32x4 acc = {0.f, 0.f, 0.f, 0.f};
        for (int ks = 0; ks < nks; ++ks) {
            const bf16x8 bfr = *(const bf16x8*)(vT + (ct * 16 + fr) * LS + ks * 32 + fq * 8);
            acc = __builtin_amdgcn_mfma_f32_16x16x32_bf16(bfr, af[ks], acc, 0, 0, 0);
        }
        const int c = ct * 16 + fq * 4;
        const u32x2 u = *(const u32x2*)(proj + (size_t)(r0 + t) * NPROJ + OFF_CU + g * 128 + c);
        u32x2 o; o.x = cvt_pk_bf16(bflo(u.x) * (acc[0] + bs), bfhi(u.x) * (acc[1] + bs)); o.y = cvt_pk_bf16(bflo(u.y) * (acc[2] + bs), bfhi(u.y) * (acc[3] + bs));
        *(u32x2*)(mix + (size_t)(r0 + t) * NMIX + 2304 + g * 128 + c) = o;
    }
}

namespace at {
constexpr int VS = 320;
__device__ __forceinline__ int crow(int r, int hi) { return (r & 3) + 8 * (r >> 2) + 4 * hi; }

template <int DQK, bool CAUSAL>
__device__ __forceinline__ void attn_pass(const bf16_t* __restrict__ Qp, const int ldq, const bf16_t* __restrict__ Kp, const int ldk,
                                          const bf16_t* __restrict__ Vp, const int ldv, const int q0, const int ntiles, const float c2,
                                          const float* lutp, f32x16 (&O)[4], float& lsum_out, unsigned char* smem) {
    constexpr int KS = DQK * 2 + 16, KB = 64 * KS, BUF = KB + 64 * VS, NKC = DQK / 64, NKS = DQK / 16;
    const int tid = opaque_tid(), wid = tid >> 6, lane = tid & 63, l31 = lane & 31, hi = lane >> 5;
    const int krow = (DQK == 64) ? (tid >> 3) : (tid >> 4), kch = (DQK == 64) ? (tid & 7) : (tid & 15);
    const int vrow = tid >> 4, vch = tid & 15;
    u32x4 kr[NKC], vr[2];
#define AT_GLOAD(j) do { const int k0_ = (j) * 64; \
        for (int i_ = 0; i_ < NKC; ++i_) kr[i_] = *(const u32x4*)(Kp + (size_t)(k0_ + krow + 32 * i_) * ldk + kch * 8); \
        for (int i_ = 0; i_ < 2; ++i_) vr[i_] = *(const u32x4*)(Vp + (size_t)(k0_ + vrow + 32 * i_) * ldv + vch * 8); } while (0)
#define AT_LSTORE(buf) do { \
        for (int i_ = 0; i_ < NKC; ++i_) *(u32x4*)((buf) + (krow + 32 * i_) * KS + kch * 16) = kr[i_]; \
        for (int i_ = 0; i_ < 2; ++i_) *(u32x4*)((buf) + KB + (vrow + 32 * i_) * VS + vch * 16) = vr[i_]; } while (0)
    bf16x8 qf[NKS];
#pragma unroll
    for (int ks = 0; ks < NKS; ++ks) qf[ks] = *(const bf16x8*)(Qp + (size_t)(wid * 32 + l31) * ldq + ks * 16 + hi * 8);
#pragma unroll
    for (int d = 0; d < 4; ++d)
#pragma unroll
        for (int r = 0; r < 16; ++r) O[d][r] = 0.f;
    float m = -1e30f, lsum = 0.f;
    const int qw0 = q0 + wid * 32;
    const int q4 = (lane & 15) >> 2, p4 = lane & 3, blk = (lane >> 4) & 1;
    const int vtr = (4 * hi + q4) * VS + (16 * blk + 4 * p4) * 2;
    __syncthreads();
    AT_GLOAD(0);
    AT_LSTORE(smem);
    __syncthreads();
    const float lut127 = CAUSAL ? lutp[127] : 0.f;
#pragma unroll 1
    for (int j = 0; j < ntiles; ++j) {
        unsigned char* buf = smem + (j & 1) * BUF;
        if (j + 1 < ntiles) AT_GLOAD(j + 1);
        const int k0 = j * 64;
        if (!CAUSAL || k0 <= qw0 + 31) {
            f32x16 st[2];
#pragma unroll
            for (int kt = 0; kt < 2; ++kt) {
#pragma unroll
                for (int r = 0; r < 16; ++r) st[kt][r] = 0.f;
#pragma unroll
                for (int ks = 0; ks < NKS; ++ks) {
                    const bf16x8 kf = *(const bf16x8*)(buf + (kt * 32 + l31) * KS + (ks * 16 + hi * 8) * 2);
                    st[kt] = __builtin_amdgcn_mfma_f32_32x32x16_bf16(kf, qf[ks], st[kt], 0, 0, 0);
                }
                if (DQK > 64) __builtin_amdgcn_sched_barrier(0);
            }
            if (CAUSAL) {
                if (qw0 - (k0 + 63) >= 127) {
#pragma unroll
                    for (int kt = 0; kt < 2; ++kt)
#pragma unroll
                        for (int r = 0; r < 16; ++r) st[kt][r] = fmaf(st[kt][r], c2, lut127);
                } else {
                    const int tq = qw0 + l31;
#pragma unroll
                    for (int kt = 0; kt < 2; ++kt)
#pragma unroll
                        for (int r = 0; r < 16; ++r) {
                            const int dd = tq - (k0 + 32 * kt + crow(r, hi));
                            const float bias = lutp[dd < 0 ? 0 : (dd > 127 ? 127 : dd)];
                            st[kt][r] = dd < 0 ? -__builtin_inff() : fmaf(st[kt][r], c2, bias);
                        }
                }
            } else {
#pragma unroll
                for (int kt = 0; kt < 2; ++kt)
#pragma unroll
                    for (int r = 0; r < 16; ++r) st[kt][r] *= c2;
            }
            float pmax = st[0][0];
#pragma unroll
            for (int r = 1; r < 16; ++r) pmax = fmaxf(pmax, st[0][r]);
#pragma unroll
            for (int r = 0; r < 16; ++r) pmax = fmaxf(pmax, st[1][r]);
            pmax = fmaxf(pmax, __shfl_xor(pmax, 32, 64));
            const float mn = fmaxf(m, pmax);
            const float alpha = fast_exp2(m - mn);
            m = mn;
            float ps = 0.f;
#pragma unroll
            for (int kt = 0; kt < 2; ++kt)
#pragma unroll
                for (int r = 0; r < 16; ++r) { st[kt][r] = fast_exp2(st[kt][r] - mn); ps += st[kt][r]; }
            lsum = lsum * alpha + ps;
#pragma unroll
            for (int d = 0; d < 4; ++d)
#pragma unroll
                for (int r = 0; r < 16; ++r) O[d][r] *= alpha;
            bf16x8 pf[2][2];
#pragma unroll
            for (int kt = 0; kt < 2; ++kt)
#pragma unroll
                for (int s = 0; s < 2; ++s) {
                    u32x4 w; w.x = cvt_pk_bf16(st[kt][8 * s + 0], st[kt][8 * s + 1]); w.y = cvt_pk_bf16(st[kt][8 * s + 2], st[kt][8 * s + 3]);
                    w.z = cvt_pk_bf16(st[kt][8 * s + 4], st[kt][8 * s + 5]); w.w = cvt_pk_bf16(st[kt][8 * s + 6], st[kt][8 * s + 7]);
                    pf[kt][s] = *reinterpret_cast<bf16x8*>(&w);
                }
            const unsigned char* vb = buf + KB + vtr;
#pragma unroll
            for (int d = 0; d < 4; ++d)
#pragma unroll
                for (int kt = 0; kt < 2; ++kt)
#pragma unroll
                    for (int s = 0; s < 2; ++s) {
                        const s16x4 lo = __builtin_amdgcn_ds_read_tr16_b64_v4i16((LAS s16x4*)(vb + (32 * kt + 16 * s) * VS + d * 64));
                        const s16x4 hh = __builtin_amdgcn_ds_read_tr16_b64_v4i16((LAS s16x4*)(vb + (32 * kt + 16 * s + 8) * VS + d * 64));
                        const bf16x8 vf = __builtin_shufflevector(lo, hh, 0, 1, 2, 3, 4, 5, 6, 7);
                        O[d] = __builtin_amdgcn_mfma_f32_32x32x16_bf16(vf, pf[kt][s], O[d], 0, 0, 0);
                        if (DQK > 64 && s == 1) __builtin_amdgcn_sched_barrier(0);
                    }
        }
        if (j + 1 < ntiles) AT_LSTORE(smem + ((j + 1) & 1) * BUF);
        __syncthreads();
    }
    lsum_out = lsum + __shfl_xor(lsum, 32, 64);
#undef AT_GLOAD
#undef AT_LSTORE
}
constexpr int LDS_LUT_A = 2 * (64 * (64 * 2 + 16) + 64 * VS);

__device__ void attnA_unit(const Params& p, int l, int unit, unsigned char* smem) {
    const int qblk = 15 - unit / 24, bh = unit % 24, b = bh / 6, h = bh % 6;
    const int tid = opaque_tid(), wid = tid >> 6, lane = tid & 63, l31 = lane & 31, hi = lane >> 5;
    const bf16_t* proj = (const bf16_t*)(p.ws + WS_PROJ);
    const size_t rowb = (size_t)b * SEQ;
    const int q0 = qblk * 256;
    float* lut = (float*)(smem + LDS_LUT_A);
    __syncthreads();
    if (tid < 128) lut[tid] = ((const float*)(p.ws + WS_LUT))[h * 128 + tid];
    const float lam = ((const float*)(p.ws + WS_LAM))[l];
    const float lam_init = 0.8f - 0.6f * expf(-0.3f * (float)l);
    unsigned o0p[32];
    f32x16 O[4]; float lsum;
    const int ntiles = 4 * (qblk + 1);
    const float c2 = 0.125f * LOG2E;
    for (int map = 0; map < 2; ++map) {
        const bf16_t* Qp = proj + (rowb + q0) * NPROJ + OFF_QA + h * 128 + map * 64;
        const bf16_t* Kp = proj + rowb * NPROJ + OFF_KA + h * 128 + map * 64;
        const bf16_t* Vp = proj + rowb * NPROJ + OFF_VA + h * 128;
        attn_pass<64, true>(Qp, NPROJ, Kp, NPROJ, Vp, NPROJ, q0, ntiles, c2, lut, O, lsum, smem);
        if (map == 0) {
            const float inv = 1.0f / lsum;
#pragma unroll
            for (int d = 0; d < 4; ++d)
#pragma unroll
                for (int r = 0; r < 16; r += 2) o0p[d * 8 + (r >> 1)] = cvt_pk_bf16(O[d][r] * inv, O[d][r + 1] * inv);
        }
    }
    const float inv1 = lam / lsum;
    float ss = 0.f;
#pragma unroll
    for (int d = 0; d < 4; ++d)
#pragma unroll
        for (int r = 0; r < 16; r += 2) {
            const unsigned w = o0p[d * 8 + (r >> 1)];
            O[d][r] = bflo(w) - O[d][r] * inv1; O[d][r + 1] = bfhi(w) - O[d][r + 1] * inv1;
            ss += O[d][r] * O[d][r] + O[d][r + 1] * O[d][r + 1];
        }
    ss += __shfl_xor(ss, 32, 64);
    const float rn = rsqrtf(ss * (1.0f / 128.0f) + EPS) * (1.0f - lam_init);
    const float* sg = p.in[8] + (size_t)l * 128;
    bf16_t* orow = (bf16_t*)(p.ws + WS_MIX) + (rowb + q0 + wid * 32 + l31) * NMIX + h * 128;
#pragma unroll
    for (int d = 0; d < 4; ++d)
#pragma unroll
        for (int g = 0; g < 4; ++g) {
            const int dv0 = 32 * d + 8 * g + 4 * hi;
            const f32x4 gg = *(const f32x4*)(sg + dv0);
            u32x2 w; w.x = cvt_pk_bf16(O[d][4 * g] * rn * gg[0], O[d][4 * g + 1] * rn * gg[1]); w.y = cvt_pk_bf16(O[d][4 * g + 2] * rn * gg[2], O[d][4 * g + 3] * rn * gg[3]);
            *(u32x2*)(orow + dv0) = w;
        }
}

__device__ void attnX_unit(const Params& p, int unit, unsigned char* smem) {
    const int qblk = unit & 15, bh = unit >> 4, b = bh >> 2, h = bh & 3;
    const int tid = opaque_tid(), wid = tid >> 6, lane = tid & 63, l31 = lane & 31, hi = lane >> 5;
    const bf16_t* xq = (const bf16_t*)(p.ws + WS_XQ);
    const bf16_t* kvx = (const bf16_t*)(p.ws + WS_KVX);
    const size_t row0 = (size_t)b * SEQ + qblk * 256;
    f32x16 O[4]; float lsum;
    attn_pass<128, false>(xq + row0 * 512 + h * 128, 512, kvx + (size_t)b * MEMLEN * 1024 + h * 128, 1024, kvx + (size_t)b * MEMLEN * 1024 + 512 + h * 128, 1024,
                          0, 4, 0.08838834764831845f * LOG2E, nullptr, O, lsum, smem);
    const float inv = 1.0f / lsum;
    bf16_t* orow = (bf16_t*)(p.ws + WS_XO) + (row0 + wid * 32 + l31) * 512 + h * 128;
#pragma unroll
    for (int d = 0; d < 4; ++d)
#pragma unroll
        for (int g = 0; g < 4; ++g) {
            const int dv0 = 32 * d + 8 * g + 4 * hi;
            u32x2 w; w.x = cvt_pk_bf16(O[d][4 * g] * inv, O[d][4 * g + 1] * inv); w.y = cvt_pk_bf16(O[d][4 * g + 2] * inv, O[d][4 * g + 3] * inv);
            *(u32x2*)(orow + dv0) = w;
        }
}
}

namespace ix {
constexpr int RS = 8208;
constexpr int LDS_STAGE = 16 * RS;
__device__ __forceinline__ unsigned wave_sum_u(unsigned v) {
#pragma unroll
    for (int o = 32; o > 0; o >>= 1) v += (unsigned)__shfl_xor((int)v, o, 64);
    return v;
}
__device__ __forceinline__ unsigned wave_excl_scan(unsigned v, int lane) {
    unsigned s = v;
#pragma unroll
    for (int o = 1; o < 64; o <<= 1) { const unsigned t = (unsigned)__shfl_up((int)s, o, 64); if (lane >= o) s += t; }
    return s - v;
}
__device__ void indexer_unit(const Params& p, int b, int qt, unsigned char* smem) {
    const int tid = opaque_tid(), wid = tid >> 6, lane = tid & 63, fr = lane & 15, fq = lane >> 4;
    const int q0 = qt * 16;
    const size_t rowb = (size_t)b * SEQ;
    unsigned short* idxg = (unsigned short*)(p.ws + WS_IDX);
    __syncthreads();
    if (qt < 16) {
        for (int e = tid; e < 16 * 128; e += NTHREADS) { const int r = e >> 7, c = (e & 127) * 2; *(unsigned*)(idxg + (rowb + q0 + r) * TOPK + c) = (unsigned)c | ((unsigned)(c + 1) << 16); }
        return;
    }
    const bf16_t* proj = (const bf16_t*)(p.ws + WS_PROJ);
    const bf16_t* qb = (const bf16_t*)(p.ws + WS_QB);
    const int nkt = qt + 1;
    {
        bf16x8 qf[16][2];
        const bf16_t* qrow = qb + (rowb + q0 + fr) * NQB + 1536 + fq * 8;
#pragma unroll
        for (int g = 0; g < 16; ++g)
#pragma unroll
            for (int ks = 0; ks < 2; ++ks) qf[g][ks] = *(const bf16x8*)(qrow + g * 64 + ks * 32);
        unsigned wp[8];
        {
            const u32x4 a = *(const u32x4*)(proj + (rowb + q0 + fr) * NPROJ + OFF_WIDX), c = *(const u32x4*)(proj + (rowb + q0 + fr) * NPROJ + OFF_WIDX + 8);
            wp[0] = a.x; wp[1] = a.y; wp[2] = a.z; wp[3] = a.w; wp[4] = c.x; wp[5] = c.y; wp[6] = c.z; wp[7] = c.w;
        }
        const bf16_t* kbase = proj + (rowb + fr) * NPROJ + OFF_KIDX + fq * 8;
        bf16x8 af0, af1;
        if (wid < nkt) { af0 = *(const bf16x8*)(kbase + (size_t)wid * 16 * NPROJ); af1 = *(const bf16x8*)(kbase + (size_t)wid * 16 * NPROJ + 32); }
        for (int kt = wid; kt < nkt; kt += 8) {
            const bf16x8 a0 = af0, a1 = af1;
            if (kt + 8 < nkt) { af0 = *(const bf16x8*)(kbase + (size_t)(kt + 8) * 16 * NPROJ); af1 = *(const bf16x8*)(kbase + (size_t)(kt + 8) * 16 * NPROJ + 32); }
            f32x4 sc = {0.f, 0.f, 0.f, 0.f};
#pragma unroll
            for (int g = 0; g < 16; ++g) {
                f32x4 d = {0.f, 0.f, 0.f, 0.f};
                d = __builtin_amdgcn_mfma_f32_16x16x32_bf16(a0, qf[g][0], d, 0, 0, 0);
                d = __builtin_amdgcn_mfma_f32_16x16x32_bf16(a1, qf[g][1], d, 0, 0, 0);
                const float wg = (g & 1) ? bfhi(wp[g >> 1]) : bflo(wp[g >> 1]);
#pragma unroll
                for (int r = 0; r < 4; ++r) { const float rl = fmaxf(d[r], 0.f); asm("v_fmac_f32 %0, %1, %2" : "+v"(sc[r]) : "v"(wg), "v"(rl)); }
                if ((g & 1) == 1) __builtin_amdgcn_sched_barrier(0);
            }
            if (kt == qt) {
#pragma unroll
                for (int r = 0; r < 4; ++r) if (4 * fq + r > fr) sc[r] = -__builtin_inff();
            }
            unsigned x0 = __builtin_bit_cast(unsigned, __builtin_amdgcn_cvt_pkrtz(sc[0], sc[1]));
            unsigned x1 = __builtin_bit_cast(unsigned, __builtin_amdgcn_cvt_pkrtz(sc[2], sc[3]));
            x0 ^= (((x0 >> 15) & 0x00010001u) * 0xFFFFu) | 0x80008000u; x1 ^= (((x1 >> 15) & 0x00010001u) * 0xFFFFu) | 0x80008000u;
            u32x2 o; o.x = (x0 >> 1) & 0x7FFF7FFFu; o.y = (x1 >> 1) & 0x7FFF7FFFu;
            *(u32x2*)(smem + fr * RS + (kt * 16 + 4 * fq) * 2) = o;
        }
    }
    __syncthreads();
    unsigned short* stage = (unsigned short*)(smem + LDS_STAGE + wid * 512);
    for (int rr = 0; rr < 2; ++rr) {
        const int qi = wid * 2 + rr;
        const unsigned char* rowp = smem + qi * RS;
        const int nch = nkt * 4;
        unsigned kreg[32];
#pragma unroll
        for (int i = 0; i < 16; ++i) {
            const int c = lane + 64 * i;
            u32x2 v = {0u, 0u};
            if (c < nch) v = *(const u32x2*)(rowp + c * 8);
            kreg[2 * i] = v.x; kreg[2 * i + 1] = v.y;
        }
        unsigned T = 0;
        for (int bit = 14; bit >= 0; --bit) {
            const unsigned cand = T | (1u << bit);
            const unsigned kk = (0x8000u - cand) * 0x10001u;
            unsigned cnt = 0;
#pragma unroll
            for (int i = 0; i < 32; ++i) cnt += __builtin_popcount((kreg[i] + kk) & 0x80008000u);
            if (wave_sum_u(cnt) >= (unsigned)TOPK) T = cand;
        }
        unsigned cg = 0, ce = 0;
        const unsigned kg = (0x8000u - (T + 1u)) * 0x10001u, tt = T * 0x10001u;
#pragma unroll
        for (int i = 0; i < 32; ++i) {
            cg += __builtin_popcount((kreg[i] + kg) & 0x80008000u);
            const unsigned e = kreg[i] ^ tt;
            ce += ((e & 0xFFFFu) == 0u) + ((e >> 16) == 0u);
        }
        const unsigned cgt = wave_sum_u(cg);
        unsigned pg = wave_excl_scan(cg, lane);
        unsigned pe = wave_excl_scan(ce, lane);
        const unsigned need = (unsigned)TOPK - cgt;
#pragma unroll 1
        for (int c = lane; c < nch; c += 64) {
            const u32x2 v = *(const u32x2*)(rowp + c * 8);
#pragma unroll
            for (int e = 0; e < 4; ++e) {
                const unsigned w2 = e < 2 ? v.x : v.y;
                const unsigned k15 = (e & 1) ? (w2 >> 16) : (w2 & 0xFFFFu);
                const unsigned key = (unsigned)(c * 4 + e);
                if (k15 > T) { stage[pg] = (unsigned short)key; ++pg; }
                else if (k15 == T) { if (pe < need) stage[cgt + pe] = (unsigned short)key; ++pe; }
            }
        }
        asm volatile("s_waitcnt lgkmcnt(0)" ::: "memory");
        const u32x2 o = *(const u32x2*)(stage + lane * 4);
        *(u32x2*)(idxg + (rowb + q0 + qi) * TOPK + lane * 4) = o;
        asm volatile("s_waitcnt lgkmcnt(0)" ::: "memory");
    }
}
}

namespace bt {
constexpr int CS = 544;
constexpr int CHUNK_BYTES = 32 * CS;
constexpr int LDS_IST = 8 * CHUNK_BYTES;
constexpr int LDS_LUT = LDS_IST + 8 * 512;
__device__ void battn_rows(const Params& p, unsigned char* smem) {
    const int tid = threadIdx.x, wid = tid >> 6, lane = tid & 63, hh = lane & 15, kg = lane >> 4;
    const bool hv = hh < 6;
    const bf16_t* qb = (const bf16_t*)(p.ws + WS_QB);
    const bf16_t* ckvn = (const bf16_t*)(p.ws + WS_CKVN);
    const unsigned short* idxg = (const unsigned short*)(p.ws + WS_IDX);
    bf16_t* mix = (bf16_t*)(p.ws + WS_MIX);
    unsigned char* cs = smem + wid * CHUNK_BYTES;
    unsigned short* ist = (unsigned short*)(smem + LDS_IST + wid * 512);
    float* lut = (float*)(smem + LDS_LUT);
    __syncthreads();
    for (int e = tid; e < 6 * 128; e += NTHREADS) lut[e] = ((const float*)(p.ws + WS_LUT))[6 * 128 + e];
    __syncthreads();
    const float* lrow = lut + (hv ? hh : 0) * 128;
    const int q4 = (lane & 15) >> 2, p4 = lane & 3;
    const unsigned char* trb = cs + (4 * kg + q4) * CS + 4 * p4 * 2;
    for (int row = blockIdx.x * 8 + wid; row < MTOK; row += gridDim.x * 8) {
        const int t = row & (SEQ - 1);
        const size_t rowb = (size_t)(row - t);
        const int nvalid = t + 1 < TOPK ? t + 1 : TOPK;
        const int nchunks = (nvalid + 31) >> 5;
        *(u32x2*)(ist + lane * 4) = *(const u32x2*)(idxg + (size_t)row * TOPK + lane * 4);
        bf16x8 qlf[8];
#pragma unroll
        for (int ks = 0; ks < 8; ++ks) {
            bf16x8 z = {0, 0, 0, 0, 0, 0, 0, 0};
            qlf[ks] = hv ? *(const bf16x8*)(qb + (size_t)row * NQB + hh * 256 + ks * 32 + kg * 8) : z;
        }
        f32x4 O[16];
#pragma unroll
        for (int d = 0; d < 16; ++d) O[d] = (f32x4){0.f, 0.f, 0.f, 0.f};
        float m = -1e30f, lsum = 0.f;
        u32x4 gr[16];
#define BT_GATHER(c) do { _Pragma("unroll") for (int i_ = 0; i_ < 16; ++i_) { const int slot_ = (c) * 32 + 2 * i_ + (lane >> 5); \
            const unsigned id_ = slot_ < nvalid ? (unsigned)ist[slot_] : 0u; \
            gr[i_] = *(const u32x4*)(ckvn + (rowb + id_) * 256 + (lane & 31) * 8); } } while (0)
        BT_GATHER(0);
        for (int c = 0; c < nchunks; ++c) {
#pragma unroll
            for (int i = 0; i < 16; ++i) *(u32x4*)(cs + (2 * i + (lane >> 5)) * CS + (lane & 31) * 16) = gr[i];
            if (c + 1 < nchunks) BT_GATHER(c + 1);
            f32x4 s[2];
#pragma unroll
            for (int tt = 0; tt < 2; ++tt) {
                s[tt] = (f32x4){0.f, 0.f, 0.f, 0.f};
#pragma unroll
                for (int ks = 0; ks < 8; ++ks) {
                    const bf16x8 af = *(const bf16x8*)(cs + (tt * 16 + hh) * CS + (ks * 32 + kg * 8) * 2);
                    s[tt] = __builtin_amdgcn_mfma_f32_16x16x32_bf16(af, qlf[ks], s[tt], 0, 0, 0);
                }
            }
            float pmax = -__builtin_inff();
#pragma unroll
            for (int tt = 0; tt < 2; ++tt) {
                const int slot0 = c * 32 + tt * 16 + 4 * kg;
                const u32x2 iv = *(const u32x2*)(ist + slot0);
                const unsigned ids[4] = {iv.x & 0xFFFFu, iv.x >> 16, iv.y & 0xFFFFu, iv.y >> 16};
#pragma unroll
                for (int r = 0; r < 4; ++r) {
                    int dd = t - (int)ids[r]; dd = dd < 0 ? 0 : (dd > 127 ? 127 : dd);
                    const float z = fmaf(s[tt][r], LOG2E, lrow[dd]);
                    s[tt][r] = (slot0 + r < nvalid) ? z : -__builtin_inff();
                    pmax = fmaxf(pmax, s[tt][r]);
                }
            }
            pmax = fmaxf(pmax, __shfl_xor(pmax, 16, 64));
            pmax = fmaxf(pmax, __shfl_xor(pmax, 32, 64));
            const float mn = fmaxf(m, pmax);
            const float alpha = fast_exp2(m - mn);
            m = mn;
            float ps = 0.f;
#pragma unroll
            for (int tt = 0; tt < 2; ++tt)
#pragma unroll
                for (int r = 0; r < 4; ++r) { s[tt][r] = fast_exp2(s[tt][r] - mn); ps += s[tt][r]; }
            lsum = lsum * alpha + ps;
            u32x4 pw; pw.x = cvt_pk_bf16(s[0][0], s[0][1]); pw.y = cvt_pk_bf16(s[0][2], s[0][3]); pw.z = cvt_pk_bf16(s[1][0], s[1][1]); pw.w = cvt_pk_bf16(s[1][2], s[1][3]);
            const bf16x8 pf = *reinterpret_cast<bf16x8*>(&pw);
#pragma unroll
            for (int d = 0; d < 16; ++d) {
                const s16x4 lo = __builtin_amdgcn_ds_read_tr16_b64_v4i16((LAS s16x4*)(trb + d * 32));
                const s16x4 hi2 = __builtin_amdgcn_ds_read_tr16_b64_v4i16((LAS s16x4*)(trb + 16 * CS + d * 32));
                const bf16x8 vf = __builtin_shufflevector(lo, hi2, 0, 1, 2, 3, 4, 5, 6, 7);
                O[d] = O[d] * alpha;
                O[d] = __builtin_amdgcn_mfma_f32_16x16x32_bf16(vf, pf, O[d], 0, 0, 0);
            }
        }
#undef BT_GATHER
        lsum += __shfl_xor(lsum, 16, 64);
        lsum += __shfl_xor(lsum, 32, 64);
        const float inv = 1.0f / lsum;
        if (hv) {
            bf16_t* orow = mix + (size_t)row * NMIX + 768 + hh * 256 + 4 * kg;
#pragma unroll
            for (int d = 0; d < 16; ++d) {
                u32x2 w; w.x = cvt_pk_bf16(O[d][0] * inv, O[d][1] * inv); w.y = cvt_pk_bf16(O[d][2] * inv, O[d][3] * inv);
                *(u32x2*)(orow + d * 16) = w;
            }
        }
    }
}
}

enum { PH_W = 0, PH_INPROJ, PH_LAT, PH_QB_A, PH_IDX, PH_BATT, PH_OUT, PH_POST1, PH_XQ, PH_XATT, PH_XO, PH_POST2, PH_GU, PH_DOWN, PH_POST3, NPHASES };

template <int PH>
__device__ __forceinline__ void run_phase(const Params& p, const int l, unsigned char* smem) {
    unsigned char* ws = p.ws;
    unsigned* ctl = (unsigned*)(ws + WS_CTL);
    if constexpr (PH == PH_W) {
        phase_weights(p, l, smem);
    } else if constexpr (PH == PH_INPROJ) {
        g8::gemm_phase((const bf16_t*)(ws + WS_XN), (const bf16_t*)(ws + W_IN), MTOK, NPROJ, DM, g8::EpiBf16{(bf16_t*)(ws + WS_PROJ), NPROJ, OFF_CU / 256}, smem);
        g8::gemm_phase((const bf16_t*)(ws + WS_MEMN), (const bf16_t*)(ws + W_XKV), MEMROWS, 1024, DM, g8::EpiBf16{(bf16_t*)(ws + WS_KVX), 1024, 1 << 30}, smem);
    } else if constexpr (PH == PH_LAT) {
        phase_latent_norms(p, l);
        for (int u = blockIdx.x; u < 512; u += gridDim.x) cbranch_unit(p, l, u, smem);
    } else if constexpr (PH == PH_QB_A) {
        unsigned* head = ctl + CW_QUEUE + 64 * (l * 8 + 0);
        const g8::EpiBf16 epi{(bf16_t*)(ws + WS_QB), NQB, 1 << 30};
        for (;;) {
            const int u = queue_next(head, smem);
            if (u >= 384 + 640) break;
            if (u < 384) at::attnA_unit(p, l, u, smem);
            else { const int g = u - 384; g8::gemm_tile((const bf16_t*)(ws + WS_CQN), (const bf16_t*)(ws + W_B), 512, g / 10, g % 10, epi, smem); }
        }
    } else if constexpr (PH == PH_IDX) {
        unsigned* head = ctl + CW_QUEUE + 64 * (l * 8 + 1);
        for (;;) {
            const int u = queue_next(head, smem);
            if (u >= 1024) break;
            ix::indexer_unit(p, u & 3, 255 - (u >> 2), smem);
        }
    } else if constexpr (PH == PH_BATT) {
        bt::battn_rows(p, smem);
    } else if constexpr (PH == PH_OUT) {
        g8::gemm_phase((const bf16_t*)(ws + WS_MIX), (const bf16_t*)(ws + W_OUT), MTOK, DM, NMIX, g8::EpiF32{(float*)(ws + WS_TMP), DM}, smem);
    } else if constexpr (PH == PH_POST1) {
        phase_post((const float*)(ws + WS_TMP), l == 0 ? p.in[0] : p.out, p.out, p.in[4] + (size_t)l * DM, p.in[19] + (size_t)l * DM, (bf16_t*)(ws + WS_XN));
    } else if constexpr (PH == PH_XQ) {
        g8::gemm_phase((const bf16_t*)(ws + WS_XN), (const bf16_t*)(ws + W_XQ), MTOK, 512, DM, g8::EpiBf16{(bf16_t*)(ws + WS_XQ), 512, 1 << 30}, smem);
    } else if constexpr (PH == PH_XATT) {
        for (int u = blockIdx.x; u < 256; u += gridDim.x) at::attnX_unit(p, u, smem);
    } else if constexpr (PH == PH_XO) {
        g8::gemm_phase((const bf16_t*)(ws + WS_XO), (const bf16_t*)(ws + W_XO), MTOK, DM, 512, g8::EpiF32{(float*)(ws + WS_TMP), DM}, smem);
    } else if constexpr (PH == PH_POST2) {
        phase_post((const float*)(ws + WS_TMP), p.out, p.out, p.in[20] + (size_t)l * DM, p.in[25] + (size_t)l * DM, (bf16_t*)(ws + WS_XN));
    } else if constexpr (PH == PH_GU) {
        g8::gemm_phase((const bf16_t*)(ws + WS_XN), (const bf16_t*)(ws + W_GU), MTOK, 2 * FH, DM, g8::EpiSwiglu{(bf16_t*)(ws + WS_FFH)}, smem);
    } else if constexpr (PH == PH_DOWN) {
        g8::gemm_phase((const bf16_t*)(ws + WS_FFH), (const bf16_t*)(ws + W_DOWN), MTOK, DM, FH, g8::EpiF32{(float*)(ws + WS_TMP), DM}, smem);
    } else if constexpr (PH == PH_POST3) {
        phase_post((const float*)(ws + WS_TMP), p.out, p.out, p.in[26] + (size_t)l * DM, l + 1 < DEPTH ? p.in[3] + (size_t)(l + 1) * DM : nullptr, (bf16_t*)(ws + WS_XN));
    }
}

template <int PH>
__global__ void __launch_bounds__(NTHREADS, 2) k_phase(Params p) {
    extern __shared__ __attribute__((aligned(16))) unsigned char smem[];
    run_phase<PH>(p, p.layer, smem);
}

template <int PH>
static void launch_phase(Params& p, int grid, hipStream_t stream) {
    static bool attr = false;
    if (!attr) { (void)hipFuncSetAttribute((const void*)k_phase<PH>, hipFuncAttributeMaxDynamicSharedMemorySize, LDS_BYTES); attr = true; }
    hipLaunchKernelGGL(k_phase<PH>, dim3(grid), dim3(NTHREADS), LDS_BYTES, stream, p);
}

extern "C" void kernel_launch(void* const* d_in, const int* in_sizes, int n_in, void* d_out, int out_size, void* d_ws, size_t ws_size, hipStream_t stream) {
    if (n_in != 29 || out_size != MTOK * DM || ws_size < WS_END) {
        fprintf(stderr, "kernel_launch: unexpected problem (n_in %d, out %d, ws %zu, need %zu); nothing launched\n", n_in, out_size, ws_size, (size_t)WS_END);
        return;
    }
    static int grid = 0;
    if (!grid) { int dev = 0, cus = 0; (void)hipGetDevice(&dev); (void)hipDeviceGetAttribute(&cus, hipDeviceAttributeMultiprocessorCount, dev); grid = cus > 0 ? cus : 256; }
    (void)hipMemsetAsync((char*)d_ws + WS_CTL, 0, CTL_BYTES, stream);
    Params p{};
    for (int i = 0; i < 29; ++i) p.in[i] = (const float*)d_in[i];
    p.out = (float*)d_out; p.ws = (unsigned char*)d_ws; p.layer = 0; p.phase = 0;
    for (int l = 0; l < DEPTH; ++l) {
        p.layer = l;
        launch_phase<PH_W>(p, grid, stream);
        launch_phase<PH_INPROJ>(p, grid, stream);
        launch_phase<PH_LAT>(p, grid, stream);
        launch_phase<PH_QB_A>(p, grid, stream);
        launch_phase<PH_IDX>(p, grid, stream);
        launch_phase<PH_BATT>(p, grid, stream);
        launch_phase<PH_OUT>(p, grid, stream);
        launch_phase<PH_POST1>(p, grid, stream);
        launch_phase<PH_XQ>(p, grid, stream);
        launch_phase<PH_XATT>(p, grid, stream);
        launch_phase<PH_XO>(p, grid, stream);
        launch_phase<PH_POST2>(p, grid, stream);
        launch_phase<PH_GU>(p, grid, stream);
        launch_phase<PH_DOWN>(p, grid, stream);
        launch_phase<PH_POST3>(p, grid, stream);
    }
}
```

```cpp
#include <hip/hip_runtime.h>
#include <stdint.h>
#include <stdio.h>

#ifndef PROBE_DUP
#define PROBE_DUP -1
#endif
#ifndef PROBE_SUB
#define PROBE_SUB 0
#endif
#ifndef IX_HIST
#define IX_HIST 3
#endif
#ifndef IX_CHECK
#define IX_CHECK 0
#endif
#ifndef PROBE_CHK
#define PROBE_CHK 0
#endif
#ifndef MK_ONE_LAUNCH
#define MK_ONE_LAUNCH 1
#endif

#define LAS __attribute__((address_space(3)))
typedef unsigned short bf16_t;
typedef short bf16x8 __attribute__((ext_vector_type(8)));
typedef short s16x4 __attribute__((ext_vector_type(4)));
typedef float f32x4 __attribute__((ext_vector_type(4)));
typedef float f32x16 __attribute__((ext_vector_type(16)));
typedef unsigned u32x4 __attribute__((ext_vector_type(4)));
typedef unsigned u32x2 __attribute__((ext_vector_type(2)));

constexpr int DM = 2048, NBATCH = 4, SEQ = 4096, MTOK = NBATCH * SEQ, DEPTH = 2;
constexpr int IN_COLS = 4176, NPROJ = 4352;
constexpr int OFF_QA = 0, OFF_KA = 768, OFF_VA = 1536, OFF_CQ = 2304, OFF_CKV = 2816, OFF_KIDX = 3072, OFF_WIDX = 3136, OFF_CU = 3328, OFF_CV = 3840;
constexpr int NQB = 2560;
constexpr int NMIX = 2048;
constexpr int FH = 5632;
constexpr int MEMLEN = 256, MEMROWS = NBATCH * MEMLEN;
constexpr int TOPK = 256;
constexpr float EPS = 1e-6f;
constexpr float LOG2E = 1.4426950408889634f;

constexpr int NTHREADS = 512;
constexpr int LDS_BYTES = 155648;
constexpr int LDS_CTL = LDS_BYTES - 256;

constexpr size_t alignup(size_t x) { return (x + 255) & ~(size_t)255; }
constexpr size_t WS_CTL = 0;
constexpr size_t CTL_BYTES = 65536;
constexpr int NSSQ = 1 + 3 * DEPTH;
constexpr size_t ZERO_BYTES = CTL_BYTES;
constexpr size_t WS_SSQ = WS_CTL + CTL_BYTES;
constexpr size_t WS_LUT = WS_SSQ + (size_t)NSSQ * MTOK * 8 * 4;
constexpr size_t WS_LAM = WS_LUT + 12 * 128 * 4;
constexpr size_t WS_XBUF = alignup(WS_LAM + 256);
constexpr size_t WS_W = WS_XBUF + (size_t)64 * 256 * 8 * 4;
constexpr size_t W_IN = WS_W;
constexpr size_t W_B = W_IN + (size_t)NPROJ * DM * 2;
constexpr size_t W_OUT = W_B + (size_t)NQB * 512 * 2;
constexpr size_t W_XQ = W_OUT + (size_t)DM * NMIX * 2;
constexpr size_t W_XKV = W_XQ + (size_t)512 * DM * 2;
constexpr size_t W_XO = W_XKV + (size_t)1024 * DM * 2;
constexpr size_t W_GU = W_XO + (size_t)DM * 512 * 2;
constexpr size_t W_DOWN = W_GU + (size_t)2 * FH * DM * 2;
constexpr size_t W_UVT = W_DOWN + (size_t)DM * FH * 2;
constexpr size_t WS_MEMN = W_UVT + (size_t)(768 + 128) * 256 * 2;
constexpr size_t WS_KVX = WS_MEMN + (size_t)MEMROWS * DM * 2;
constexpr size_t WS_H16 = alignup(WS_KVX + (size_t)MEMROWS * 1024 * 2);
constexpr size_t WS_RSTD = WS_H16 + (size_t)MTOK * DM * 2;
constexpr size_t WS_CQN = WS_RSTD + (size_t)MTOK * 4;
constexpr size_t WS_CKVN = WS_CQN + (size_t)MTOK * 512 * 2;
constexpr size_t WS_R1 = WS_CKVN + (size_t)MTOK * 256 * 2;
constexpr size_t WS_PROJ = WS_R1, WS_TMP = WS_R1, WS_OLAT = WS_R1;
constexpr size_t WS_R2 = WS_R1 + (size_t)MTOK * NPROJ * 2;
constexpr size_t WS_QB = WS_R2;
constexpr size_t WS_MIX = WS_QB + (size_t)MTOK * NQB * 2;
constexpr size_t WS_IDX = WS_MIX + (size_t)MTOK * NMIX * 2;
constexpr size_t WS_FFH = WS_R2;
constexpr size_t WS_XQ = WS_R2;
constexpr size_t WS_XO = WS_XQ + (size_t)MTOK * 512 * 2;
constexpr size_t WS_CSTAT = WS_IDX + (size_t)MTOK * TOPK * 2;
constexpr size_t WS_END_A = WS_CSTAT + (size_t)MTOK * 8, WS_END_B = WS_FFH + (size_t)MTOK * FH * 2;
constexpr size_t WS_END = WS_END_A > WS_END_B ? WS_END_A : WS_END_B;
static_assert((size_t)MTOK * DM * 4 <= (size_t)MTOK * NPROJ * 2, "tmp overlay");

constexpr int CW_QUEUE = 0;
constexpr int NQUEUES = 64;
constexpr int CW_BAR = 64 * NQUEUES;
constexpr int CW_PANEL = 8192;
constexpr int CW_TMO = CW_PANEL + DEPTH * 3 * 64 * 16;
static_assert((size_t)(CW_TMO + 16) * 4 <= 65536, "control area");

struct Params {
    const float* in[29];
    float* out;
    unsigned char* ws;
    int layer, phase;
};

__device__ __forceinline__ unsigned cvt_pk_bf16(float lo, float hi) { unsigned r; asm("v_cvt_pk_bf16_f32 %0, %1, %2" : "=v"(r) : "v"(lo), "v"(hi)); return r; }
__device__ __forceinline__ float bf2f(unsigned v) { return __uint_as_float(v << 16); }
__device__ __forceinline__ float bflo(unsigned w) { return __uint_as_float(w << 16); }
__device__ __forceinline__ float bfhi(unsigned w) { return __uint_as_float(w & 0xffff0000u); }
__device__ __forceinline__ bf16_t f2bf(float f) { return (bf16_t)(cvt_pk_bf16(f, 0.f) & 0xffffu); }
#define DPP_I(v, ctrl, rmask, bc) __builtin_amdgcn_update_dpp(0, (v), (ctrl), (rmask), 0xF, (bc))
__device__ __forceinline__ int wave_iscan_i(int v) {
    v += DPP_I(v, 0x111, 0xF, true); v += DPP_I(v, 0x112, 0xF, true); v += DPP_I(v, 0x114, 0xF, true); v += DPP_I(v, 0x118, 0xF, true);
    v += DPP_I(v, 0x142, 0xA, false); v += DPP_I(v, 0x143, 0xC, false);
    return v;
}
__device__ __forceinline__ float wave_sum(float v) {
    v += __int_as_float(DPP_I(__float_as_int(v), 0x111, 0xF, true)); v += __int_as_float(DPP_I(__float_as_int(v), 0x112, 0xF, true));
    v += __int_as_float(DPP_I(__float_as_int(v), 0x114, 0xF, true)); v += __int_as_float(DPP_I(__float_as_int(v), 0x118, 0xF, true));
    v += __int_as_float(DPP_I(__float_as_int(v), 0x142, 0xA, false)); v += __int_as_float(DPP_I(__float_as_int(v), 0x143, 0xC, false));
    return __int_as_float(__builtin_amdgcn_readlane(__float_as_int(v), 63));
}
__device__ __forceinline__ float fast_exp2(float x) { return __builtin_amdgcn_exp2f(x); }
__device__ __forceinline__ float fast_rcp(float x) { return __builtin_amdgcn_rcpf(x); }
__device__ __forceinline__ float gelu_tanh(float x) {
    const float u = x * (1.0f + 0.044715f * x * x) * (2.0f * 0.7978845608028654f);
    return x * fast_rcp(1.0f + fast_exp2(-u * LOG2E));
}
__device__ __forceinline__ float silu(float x) { return x * fast_rcp(1.0f + fast_exp2(-x * LOG2E)); }

__device__ __forceinline__ int opaque_tid() { int t = threadIdx.x; asm volatile("" : "+v"(t)); return t; }

__device__ __forceinline__ void glds16(const void* gsrc, unsigned lds_dst) {
    unsigned keep;
    asm volatile("s_mov_b32 %0, m0\n\ts_mov_b32 m0, %2\n\ts_nop 0\n\tglobal_load_lds_dwordx4 %1, off\n\ts_mov_b32 m0, %0" : "=&s"(keep) : "v"(gsrc), "s"(lds_dst) : "memory");
}

__device__ __forceinline__ int queue_next(unsigned* head, unsigned char* smem) {
    volatile LAS unsigned* slot = (volatile LAS unsigned*)(smem + LDS_CTL + 64);
    __syncthreads();
    if (threadIdx.x == 0) *slot = __hip_atomic_fetch_add(head, 1u, __ATOMIC_RELAXED, __HIP_MEMORY_SCOPE_AGENT);
    __syncthreads();
    return (int)*slot;
}

namespace g8 {
constexpr int BM = 256, BK = 64, HALF = 128, HT = HALF * BK;
__device__ __forceinline__ int lds_byte(int r, int c) { const int st = (r >> 4) * 2 + (c >> 5), rr = r & 15, cc = c & 31, ob = rr * 64 + cc * 2; return st * 1024 + (ob ^ (((ob >> 9) & 1) << 5)); }
__device__ __forceinline__ void stage_rc(int b, int& R, int& C) { const int st = b / 1024, sb = b % 1024, swz = sb ^ (((sb >> 9) & 1) << 5); R = (st >> 1) * 16 + swz / 64; C = (st & 1) * 32 + (swz % 64) / 2; }

template <class Epi>
__device__ __forceinline__ void gemm_tile(const bf16_t* __restrict__ A, const bf16_t* __restrict__ Bt, const int K, const int pm, const int pn, const Epi& epi, unsigned char* smem) {
    bf16_t* shm = (bf16_t*)smem;
#define SA(b, h) (shm + ((b) * 2 + (h)) * HT)
#define SB(b, h) (shm + (4 + (b) * 2 + (h)) * HT)
#define STAGE_X(T, P, BASE, br, kt) do { long _g = (long)(br) * K + (long)(kt) * BK; \
    for (int _i = 0; _i < 2; ++_i) { int _b = (T) * 16 + _i * 8192; int _r, _c; stage_rc(_b, _r, _c); \
      __builtin_amdgcn_global_load_lds((const unsigned*)(BASE + _g + (long)_r * K + _c), (LAS unsigned*)((char*)(P) + _b), 16, 0, 0); } } while (0)
#define STAGE(P, BASE, br, kt) STAGE_X(tz0, P, BASE, br, kt)
#define LDA(dst, b, h) for (int m = 0; m < 4; ++m) for (int k = 0; k < 2; ++k) \
    dst[m][k] = *reinterpret_cast<const bf16x8*>((char*)SA(b, h) + lds_byte(wr * 64 + m * 16 + fr, k * 32 + fq * 8))
#define LDB(dst, b, h) for (int n = 0; n < 2; ++n) for (int k = 0; k < 2; ++k) \
    dst[n][k] = *reinterpret_cast<const bf16x8*>((char*)SB(b, h) + lds_byte(wc * 32 + n * 16 + fr, k * 32 + fq * 8))
#define MMA(ai, bj, At_, Bt_) do { __builtin_amdgcn_s_setprio(1); \
    for (int m = 0; m < 4; ++m) for (int n = 0; n < 2; ++n) for (int k = 0; k < 2; ++k) \
      acc[ai][bj][m][n] = __builtin_amdgcn_mfma_f32_16x16x32_bf16(Bt_[n][k], At_[m][k], acc[ai][bj][m][n], 0, 0, 0); \
    __builtin_amdgcn_s_setprio(0); } while (0)
#define WAIT_V(n) asm volatile("s_waitcnt vmcnt(" #n ")" ::: "memory")
#define WAIT_L(n) asm volatile("s_waitcnt lgkmcnt(" #n ")" ::: "memory")
#define BAR __builtin_amdgcn_s_barrier()
#define SCHED __builtin_amdgcn_sched_barrier(0)
    const int brow = pm * BM, bcol = pn * BM;
    int tz0 = threadIdx.x; asm volatile("" : "+v"(tz0));
    int wid = tz0 >> 6, lane = tz0 & 63, wr = wid >> 2, wc = wid & 3, fr = lane & 15, fq = lane >> 4;
    f32x4 acc[2][2][4][2] = {};
    bf16x8 At[4][2], B0[2][2], B1[2][2];
    const int nt = K / BK;
    __syncthreads();
    STAGE(SB(0, 0), Bt, bcol, 0); STAGE(SA(0, 0), A, brow, 0);
    STAGE(SB(0, 1), Bt, bcol + HALF, 0); STAGE(SA(0, 1), A, brow + HALF, 0);
    if (wr == 1) BAR;
    WAIT_V(4); BAR;
    STAGE(SB(1, 0), Bt, bcol, 1); STAGE(SA(1, 0), A, brow, 1); STAGE(SB(1, 1), Bt, bcol + HALF, 1);
    WAIT_V(6); BAR;
    for (int t = 0; t < nt - 2; t += 2) {
        LDB(B0, 0, 0); SCHED; LDA(At, 0, 0); STAGE(SA(1, 1), A, brow + HALF, t + 1);
        WAIT_L(8); BAR; WAIT_L(0); MMA(0, 0, At, B0); BAR; SCHED;
        LDB(B1, 0, 1); STAGE(SB(0, 0), Bt, bcol, t + 2);
        BAR; WAIT_L(0); MMA(0, 1, At, B1); BAR;
        LDA(At, 0, 1); STAGE(SA(0, 0), A, brow, t + 2);
        BAR; WAIT_L(0); MMA(1, 0, At, B0); BAR; SCHED;
        STAGE(SB(0, 1), Bt, bcol + HALF, t + 2);
        WAIT_V(6); BAR; MMA(1, 1, At, B1); BAR;
        LDB(B0, 1, 0); SCHED; LDA(At, 1, 0); STAGE(SA(0, 1), A, brow + HALF, t + 2);
        WAIT_L(8); BAR; WAIT_L(0); MMA(0, 0, At, B0); BAR; SCHED;
        LDB(B1, 1, 1); STAGE(SB(1, 0), Bt, bcol, t + 3);
        BAR; WAIT_L(0); MMA(0, 1, At, B1); BAR;
        LDA(At, 1, 1); STAGE(SA(1, 0), A, brow, t + 3);
        BAR; WAIT_L(0); MMA(1, 0, At, B0); BAR; SCHED;
        STAGE(SB(1, 1), Bt, bcol + HALF, t + 3);
        WAIT_V(6); BAR; MMA(1, 1, At, B1); BAR;
    }
    int tz = threadIdx.x; asm volatile("" : "+v"(tz)); wid = tz >> 6; lane = tz & 63; wr = wid >> 2; wc = wid & 3; fr = lane & 15; fq = lane >> 4;
    { LDB(B0, 0, 0); WAIT_V(0); LDA(At, 0, 0); STAGE_X(tz, SA(1, 1), A, brow + HALF, nt - 1);
      BAR; WAIT_L(0); MMA(0, 0, At, B0); BAR;
      LDB(B1, 0, 1); BAR; WAIT_L(0); MMA(0, 1, At, B1); BAR;
      LDA(At, 0, 1); WAIT_V(4); BAR; WAIT_L(0); MMA(1, 0, At, B0); MMA(1, 1, At, B1); BAR; }
    { LDB(B0, 1, 0); LDA(At, 1, 0); WAIT_V(2); BAR; WAIT_L(0); MMA(0, 0, At, B0); BAR;
      LDB(B1, 1, 1); WAIT_V(0); BAR; WAIT_L(0); MMA(0, 1, At, B1); BAR;
      LDA(At, 1, 1); BAR; WAIT_L(0); MMA(1, 0, At, B0); MMA(1, 1, At, B1); BAR; }
    if (wr == 0) BAR;
    { float rsv[8]; epi.pre(pm, wr, fr, rsv); epi(acc, rsv, pm, pn, wr, wc, fr, fq); }
#undef SA
#undef SB
#undef STAGE_X
#undef STAGE
#undef LDA
#undef LDB
#undef MMA
#undef WAIT_V
#undef WAIT_L
#undef BAR
#undef SCHED
}

struct EpiBf16 {
    bf16_t* O; int ldc; int gelu_pn; const float* rs;
    static constexpr int NSTORES = 16;
    __device__ __forceinline__ void pre(int pm, int wr, int fr, float (&rsv)[8]) const {
#pragma unroll
        for (int i = 0; i < 8; ++i) {
            if (rs) { const float* q = rs + (size_t)(pm * BM + (i >> 2) * HALF + wr * 64 + (i & 3) * 16 + fr) * 8; const f32x4 a = *(const f32x4*)q, b = *(const f32x4*)(q + 4);
                      rsv[i] = rsqrtf((((a[0] + a[1]) + (a[2] + a[3])) + ((b[0] + b[1]) + (b[2] + b[3]))) * (1.0f / DM) + EPS); }
            else rsv[i] = 1.0f;
        }
    }
    __device__ __forceinline__ void operator()(const f32x4 (&acc)[2][2][4][2], const float (&rsv8)[8], int pm, int pn, int wr, int wc, int fr, int fq) const {
        const bool g = pn >= gelu_pn;
#pragma unroll
        for (int ai = 0; ai < 2; ++ai)
#pragma unroll
            for (int m = 0; m < 4; ++m) {
                const int row = pm * BM + ai * HALF + wr * 64 + m * 16 + fr;
                bf16_t* rowp = O + (size_t)row * ldc + pn * BM + wc * 32 + fq * 8;
                const float rsv = rsv8[ai * 4 + m];
#pragma unroll
                for (int bj = 0; bj < 2; ++bj) {
                    f32x4 v0 = acc[ai][bj][m][0] * rsv, v1 = acc[ai][bj][m][1] * rsv;
                    if (g) { v0[0] = gelu_tanh(v0[0]); v0[1] = gelu_tanh(v0[1]); v0[2] = gelu_tanh(v0[2]); v0[3] = gelu_tanh(v0[3]);
                             v1[0] = gelu_tanh(v1[0]); v1[1] = gelu_tanh(v1[1]); v1[2] = gelu_tanh(v1[2]); v1[3] = gelu_tanh(v1[3]); }
                    u32x4 w; w.x = cvt_pk_bf16(v0[0], v0[1]); w.y = cvt_pk_bf16(v0[2], v0[3]); w.z = cvt_pk_bf16(v1[0], v1[1]); w.w = cvt_pk_bf16(v1[2], v1[3]);
                    *(u32x4*)(rowp + bj * HALF) = w;
                }
            }
    }
};
struct EpiHalfBf16 {
    bf16_t* O; int ldc;
    static constexpr int NSTORES = 8;
    __device__ __forceinline__ void pre(int, int, int, float (&rsv)[8]) const {
#pragma unroll
        for (int i = 0; i < 8; ++i) rsv[i] = 1.0f;
    }
    __device__ __forceinline__ void operator()(const f32x4 (&acc)[2][2][4][2], const float (&)[8], int pm, int, int wr, int wc, int fr, int fq) const {
#pragma unroll
        for (int ai = 0; ai < 2; ++ai)
#pragma unroll
            for (int m = 0; m < 4; ++m) {
                const int row = pm * BM + ai * HALF + wr * 64 + m * 16 + fr;
                const f32x4 v0 = acc[ai][0][m][0], v1 = acc[ai][0][m][1];
                u32x4 w; w.x = cvt_pk_bf16(v0[0], v0[1]); w.y = cvt_pk_bf16(v0[2], v0[3]); w.z = cvt_pk_bf16(v1[0], v1[1]); w.w = cvt_pk_bf16(v1[2], v1[3]);
                *(u32x4*)(O + (size_t)row * ldc + wc * 32 + fq * 8) = w;
            }
    }
};
struct EpiF32 {
    float* O; int ldc;
    static constexpr int NSTORES = 32;
    __device__ __forceinline__ void pre(int, int, int, float (&rsv)[8]) const {
#pragma unroll
        for (int i = 0; i < 8; ++i) rsv[i] = 1.0f;
    }
    __device__ __forceinline__ void operator()(const f32x4 (&acc)[2][2][4][2], const float (&)[8], int pm, int pn, int wr, int wc, int fr, int fq) const {
#pragma unroll
        for (int ai = 0; ai < 2; ++ai)
#pragma unroll
            for (int m = 0; m < 4; ++m) {
                float* rowp = O + (size_t)(pm * BM + ai * HALF + wr * 64 + m * 16 + fr) * ldc + pn * BM + wc * 32 + fq * 8;
#pragma unroll
                for (int bj = 0; bj < 2; ++bj)
#pragma unroll
                    for (int n = 0; n < 2; ++n) *(f32x4*)(rowp + bj * HALF + n * 4) = acc[ai][bj][m][n];
            }
    }
};
struct EpiSwiglu {
    bf16_t* O; const float* rs;
    static constexpr int NSTORES = 8;
    __device__ __forceinline__ void pre(int pm, int wr, int fr, float (&rsv)[8]) const {
#pragma unroll
        for (int i = 0; i < 8; ++i) { const float* q = rs + (size_t)(pm * BM + (i >> 2) * HALF + wr * 64 + (i & 3) * 16 + fr) * 8; const f32x4 a = *(const f32x4*)q, b = *(const f32x4*)(q + 4);
            rsv[i] = rsqrtf((((a[0] + a[1]) + (a[2] + a[3])) + ((b[0] + b[1]) + (b[2] + b[3]))) * (1.0f / DM) + EPS); }
    }
    __device__ __forceinline__ void operator()(const f32x4 (&acc)[2][2][4][2], const float (&rsv8)[8], int pm, int pn, int wr, int wc, int fr, int fq) const {
#pragma unroll
        for (int ai = 0; ai < 2; ++ai)
#pragma unroll
            for (int m = 0; m < 4; ++m) {
                const int row = pm * BM + ai * HALF + wr * 64 + m * 16 + fr;
                bf16_t* rowp = O + (size_t)row * FH + pn * HALF + wc * 32 + fq * 8;
                const float rsv = rsv8[ai * 4 + m];
                u32x4 w;
                { const f32x4 gt = acc[ai][0][m][0] * rsv, up = acc[ai][1][m][0] * rsv;
                  w.x = cvt_pk_bf16(silu(gt[0]) * up[0], silu(gt[1]) * up[1]); w.y = cvt_pk_bf16(silu(gt[2]) * up[2], silu(gt[3]) * up[3]); }
                { const f32x4 gt = acc[ai][0][m][1] * rsv, up = acc[ai][1][m][1] * rsv;
                  w.z = cvt_pk_bf16(silu(gt[0]) * up[0], silu(gt[1]) * up[1]); w.w = cvt_pk_bf16(silu(gt[2]) * up[2], silu(gt[3]) * up[3]); }
                *(u32x4*)rowp = w;
            }
    }
};
__device__ __forceinline__ void unit_to_tile(int L, int nM, int nN, int& pm, int& pn) {
    const int nwg = nM * nN;
    int wgid = L;
    { const int q = nwg / 8, r = nwg % 8, xcd = L % 8, off = L / 8; wgid = (xcd < r ? xcd * (q + 1) : r * (q + 1) + (xcd - r) * q) + off; }
    const int nig = 8 * nN, gid = wgid / nig, fm = gid * 8, gsz = (nM - fm) < 8 ? (nM - fm) : 8;
    pm = fm + ((wgid % nig) % gsz); pn = (wgid % nig) / gsz;
}
struct EpiFusedPost {
    bf16_t* h16; float* out32; const float* g_post; float* ssq_next; float* xbuf; unsigned* cnt; unsigned* tmo; unsigned char* smem;
    static constexpr int NSTORES = 0;
    __device__ __forceinline__ void pre(int, int, int, float (&rsv)[8]) const {
#pragma unroll
        for (int i = 0; i < 8; ++i) rsv[i] = 1.0f;
    }
    __device__ __forceinline__ void operator()(const f32x4 (&acc)[2][2][4][2], const float (&)[8], int pm, int pn, int wr, int wc, int fr, int fq) const {
        float* P = (float*)(smem + 131072);
        float* S = P + 1024;
        const int tid = opaque_tid();
#pragma unroll
        for (int ai = 0; ai < 2; ++ai)
#pragma unroll
            for (int m = 0; m < 4; ++m) {
                float q = 0.f;
#pragma unroll
                for (int bj = 0; bj < 2; ++bj)
#pragma unroll
                    for (int n = 0; n < 2; ++n) { const f32x4 v = acc[ai][bj][m][n]; q += v[0] * v[0] + v[1] * v[1] + v[2] * v[2] + v[3] * v[3]; }
                q += __shfl_xor(q, 16, 64); q += __shfl_xor(q, 32, 64);
                if (fq == 0) P[(ai * HALF + wr * 64 + m * 16 + fr) * 4 + wc] = q;
            }
        __syncthreads();
        if (tid < 256) {
            const f32x4 pp = *(const f32x4*)(P + tid * 4);
            __hip_atomic_store(xbuf + ((size_t)pm * 256 + tid) * 8 + pn, (pp[0] + pp[1]) + (pp[2] + pp[3]), __ATOMIC_RELAXED, __HIP_MEMORY_SCOPE_AGENT);
        }
        asm volatile("s_waitcnt vmcnt(0)" ::: "memory");
        __syncthreads();
        const int wru = __builtin_amdgcn_readfirstlane(wr), wcu = __builtin_amdgcn_readfirstlane(wc);
        const size_t ubase = ((size_t)pm * BM + wru * 64) * DM + pn * BM + wcu * 32;
        const unsigned loff = (unsigned)fr * DM + fq * 8;
        u32x4 hw[2][4][2];
#pragma unroll
        for (int m = 0; m < 4; ++m)
#pragma unroll
            for (int bj = 0; bj < 2; ++bj)
                hw[0][m][bj] = *(const u32x4*)(h16 + (ubase + (size_t)(m * 16) * DM + bj * HALF) + loff);
        if (tid == 0) {
            __hip_atomic_fetch_add(cnt + pm * 16, 1u, __ATOMIC_RELAXED, __HIP_MEMORY_SCOPE_AGENT);
            unsigned spins = 0;
            while (__hip_atomic_load(cnt + pm * 16, __ATOMIC_RELAXED, __HIP_MEMORY_SCOPE_AGENT) < 8u) {
                __builtin_amdgcn_s_sleep(1);
                if (++spins > (1u << 22)) { __hip_atomic_store(tmo, 1u, __ATOMIC_RELAXED, __HIP_MEMORY_SCOPE_AGENT); break; }
            }
        }
        __syncthreads();
        if (tid < 256) {
            const unsigned long long* xp = (const unsigned long long*)(xbuf + ((size_t)pm * 256 + tid) * 8);
            f32x4 xa, xb;
            asm volatile("global_load_dwordx4 %0, %2, off sc1\n\tglobal_load_dwordx4 %1, %2, off offset:16 sc1\n\ts_waitcnt vmcnt(0)" : "=&v"(xa), "=&v"(xb) : "v"(xp) : "memory");
            const float tot = ((xa[0] + xa[1]) + (xa[2] + xa[3])) + ((xb[0] + xb[1]) + (xb[2] + xb[3]));
            S[tid] = rsqrtf(tot * (1.0f / DM) + EPS);
        }
        __syncthreads();
        f32x4 gg[2][2];
#pragma unroll
        for (int bj = 0; bj < 2; ++bj) { const float* gp = g_post + pn * BM + bj * HALF + wc * 32 + fq * 8; gg[bj][0] = *(const f32x4*)gp; gg[bj][1] = *(const f32x4*)(gp + 4); }
#pragma unroll
        for (int m = 0; m < 4; ++m)
#pragma unroll
            for (int bj = 0; bj < 2; ++bj)
                hw[1][m][bj] = *(const u32x4*)(h16 + (ubase + (size_t)(HALF + m * 16) * DM + bj * HALF) + loff);
#pragma unroll
        for (int ai = 0; ai < 2; ++ai)
#pragma unroll
            for (int m = 0; m < 4; ++m) {
                const int rl = ai * HALF + wr * 64 + m * 16 + fr;
                const float rp = S[rl];
                float s2 = 0.f;
#pragma unroll
                for (int bj = 0; bj < 2; ++bj) {
                    const size_t offu = ubase + (size_t)(ai * HALF + m * 16) * DM + bj * HALF;
                    const u32x4 hq = hw[ai][m][bj];
                    f32x4 h0 = (f32x4){bflo(hq.x), bfhi(hq.x), bflo(hq.y), bfhi(hq.y)}, h1 = (f32x4){bflo(hq.z), bfhi(hq.z), bflo(hq.w), bfhi(hq.w)};
                    h0 = h0 + acc[ai][bj][m][0] * rp * gg[bj][0];
                    h1 = h1 + acc[ai][bj][m][1] * rp * gg[bj][1];
                    if (out32) { *(f32x4*)(out32 + offu + loff) = h0; *(f32x4*)(out32 + offu + loff + 4) = h1; }
                    else {
                        u32x4 w; w.x = cvt_pk_bf16(h0[0], h0[1]); w.y = cvt_pk_bf16(h0[2], h0[3]); w.z = cvt_pk_bf16(h1[0], h1[1]); w.w = cvt_pk_bf16(h1[2], h1[3]);
                        *(u32x4*)(h16 + offu + loff) = w;
                        const float e0 = bflo(w.x), e1 = bfhi(w.x), e2 = bflo(w.y), e3 = bfhi(w.y), e4 = bflo(w.z), e5 = bfhi(w.z), e6 = bflo(w.w), e7 = bfhi(w.w);
                        s2 += (e0 * e0 + e1 * e1) + (e2 * e2 + e3 * e3) + (e4 * e4 + e5 * e5) + (e6 * e6 + e7 * e7);
                    }
                }
                if (!out32) {
                    s2 += __shfl_xor(s2, 16, 64); s2 += __shfl_xor(s2, 32, 64);
                    if (fq == 0) P[rl * 4 + wc] = s2;
                }
            }
        if (!out32) {
            __syncthreads();
            if (tid < 256) { const f32x4 pp = *(const f32x4*)(P + tid * 4); ssq_next[((size_t)pm * BM + tid) * 8 + pn] = (pp[0] + pp[1]) + (pp[2] + pp[3]); }
        }
    }
};
__device__ __forceinline__ void gemm_post_fused(const bf16_t* A, const bf16_t* Bt, int K, const EpiFusedPost& epi, unsigned char* smem) {
    const int c = blockIdx.x, x = c & 7, slot = c >> 3;
    for (int sl = 0; sl < 2; ++sl) gemm_tile(A, Bt, K, 32 * sl + 4 * x + (slot >> 3), slot & 7, epi, smem);
}

template <class Epi>
__device__ __forceinline__ void gemm_phase(const bf16_t* __restrict__ A, const bf16_t* __restrict__ Bt, const int M, const int N, const int K, const Epi& epi, unsigned char* smem) {
    bf16_t* shm = (bf16_t*)smem;
    const int LD = K;
#define SA(b, h) (shm + ((b) * 2 + (h)) * HT)
#define SB(b, h) (shm + (4 + (b) * 2 + (h)) * HT)
#define STAGE_X(T, P, BASE, br, kt) do { long _g = (long)(br) * LD + (long)(kt) * BK; \
    for (int _i = 0; _i < 2; ++_i) { int _b = (T) * 16 + _i * 8192; int _r, _c; stage_rc(_b, _r, _c); \
      __builtin_amdgcn_global_load_lds((const unsigned*)(BASE + _g + (long)_r * LD + _c), (LAS unsigned*)((char*)(P) + _b), 16, 0, 0); } } while (0)
#define STAGE(P, BASE, br, kt) STAGE_X(tz0, P, BASE, br, kt)
#define LDA(dst, b, h) for (int m = 0; m < 4; ++m) for (int k = 0; k < 2; ++k) \
    dst[m][k] = *reinterpret_cast<const bf16x8*>((char*)SA(b, h) + lds_byte(wr * 64 + m * 16 + fr, k * 32 + fq * 8))
#define LDB(dst, b, h) for (int n = 0; n < 2; ++n) for (int k = 0; k < 2; ++k) \
    dst[n][k] = *reinterpret_cast<const bf16x8*>((char*)SB(b, h) + lds_byte(wc * 32 + n * 16 + fr, k * 32 + fq * 8))
#define MMA(ai, bj, At_, Bt_) do { __builtin_amdgcn_s_setprio(1); \
    for (int m = 0; m < 4; ++m) for (int n = 0; n < 2; ++n) for (int k = 0; k < 2; ++k) \
      acc[ai][bj][m][n] = __builtin_amdgcn_mfma_f32_16x16x32_bf16(Bt_[n][k], At_[m][k], acc[ai][bj][m][n], 0, 0, 0); \
    __builtin_amdgcn_s_setprio(0); } while (0)
#define WAIT_V(n) asm volatile("s_waitcnt vmcnt(" #n ")" ::: "memory")
#define WAIT_VN(n) asm volatile("s_waitcnt vmcnt(%0)" :: "n"(n) : "memory")
#define WAIT_L(n) asm volatile("s_waitcnt lgkmcnt(" #n ")" ::: "memory")
#define BAR __builtin_amdgcn_s_barrier()
#define SCHED __builtin_amdgcn_sched_barrier(0)
    const int nM = M / BM, nN = N / BM, nu = nM * nN, nt = K / BK;
    int u = blockIdx.x;
    if (u >= nu) return;
    int pm, pn; unit_to_tile(u, nM, nN, pm, pn);
    int tz0 = opaque_tid();
    int wid = tz0 >> 6, lane = tz0 & 63, wr = wid >> 2, wc = wid & 3, fr = lane & 15, fq = lane >> 4;
    __syncthreads();
    {
        const int brow = pm * BM, bcol = pn * BM;
        STAGE(SB(0, 0), Bt, bcol, 0); STAGE(SA(0, 0), A, brow, 0);
        STAGE(SB(0, 1), Bt, bcol + HALF, 0); STAGE(SA(0, 1), A, brow + HALF, 0);
        if (wr == 1) BAR;
        WAIT_V(4); BAR;
        STAGE(SB(1, 0), Bt, bcol, 1); STAGE(SA(1, 0), A, brow, 1); STAGE(SB(1, 1), Bt, bcol + HALF, 1);
        WAIT_V(6); BAR;
    }
    for (;;) {
        const int brow = pm * BM, bcol = pn * BM;
        f32x4 acc[2][2][4][2] = {};
        bf16x8 At[4][2], B0[2][2], B1[2][2];
        for (int t = 0; t < nt - 2; t += 2) {
            LDB(B0, 0, 0); SCHED; LDA(At, 0, 0); STAGE(SA(1, 1), A, brow + HALF, t + 1);
            WAIT_L(8); BAR; WAIT_L(0); MMA(0, 0, At, B0); BAR; SCHED;
            LDB(B1, 0, 1); STAGE(SB(0, 0), Bt, bcol, t + 2);
            BAR; WAIT_L(0); MMA(0, 1, At, B1); BAR;
            LDA(At, 0, 1); STAGE(SA(0, 0), A, brow, t + 2);
            BAR; WAIT_L(0); MMA(1, 0, At, B0); BAR; SCHED;
            STAGE(SB(0, 1), Bt, bcol + HALF, t + 2);
            WAIT_V(6); BAR; MMA(1, 1, At, B1); BAR;
            LDB(B0, 1, 0); SCHED; LDA(At, 1, 0); STAGE(SA(0, 1), A, brow + HALF, t + 2);
            WAIT_L(8); BAR; WAIT_L(0); MMA(0, 0, At, B0); BAR; SCHED;
            LDB(B1, 1, 1); STAGE(SB(1, 0), Bt, bcol, t + 3);
            BAR; WAIT_L(0); MMA(0, 1, At, B1); BAR;
            LDA(At, 1, 1); STAGE(SA(1, 0), A, brow, t + 3);
            BAR; WAIT_L(0); MMA(1, 0, At, B0); BAR; SCHED;
            STAGE(SB(1, 1), Bt, bcol + HALF, t + 3);
            WAIT_V(6); BAR; MMA(1, 1, At, B1); BAR;
        }
        tz0 = opaque_tid(); wid = tz0 >> 6; lane = tz0 & 63; wr = wid >> 2; wc = wid & 3; fr = lane & 15; fq = lane >> 4;
        { LDB(B0, 0, 0); WAIT_V(0); LDA(At, 0, 0); STAGE(SA(1, 1), A, brow + HALF, nt - 1);
          BAR; WAIT_L(0); MMA(0, 0, At, B0); BAR;
          LDB(B1, 0, 1); BAR; WAIT_L(0); MMA(0, 1, At, B1); BAR;
          LDA(At, 0, 1); WAIT_V(4); BAR; WAIT_L(0); MMA(1, 0, At, B0); MMA(1, 1, At, B1); BAR; }
        { LDB(B0, 1, 0); LDA(At, 1, 0); WAIT_V(2); BAR; WAIT_L(0); MMA(0, 0, At, B0); BAR;
          LDB(B1, 1, 1); WAIT_V(0); BAR; WAIT_L(0); MMA(0, 1, At, B1); BAR;
          LDA(At, 1, 1); BAR; WAIT_L(0); MMA(1, 0, At, B0); MMA(1, 1, At, B1); BAR; }
        if (wr == 0) BAR;
        float rsv[8];
        epi.pre(pm, wr, fr, rsv);
        const bool has_next = u + (int)gridDim.x < nu;
        int pm2 = pm, pn2 = pn;
        if (has_next) {
            unit_to_tile(u + gridDim.x, nM, nN, pm2, pn2);
            const int nbrow = pm2 * BM, nbcol = pn2 * BM;
            STAGE(SB(0, 0), Bt, nbcol, 0); STAGE(SA(0, 0), A, nbrow, 0);
            STAGE(SB(0, 1), Bt, nbcol + HALF, 0); STAGE(SA(0, 1), A, nbrow + HALF, 0);
        }
        epi(acc, rsv, pm, pn, wr, wc, fr, fq);
        if (!has_next) break;
        {
            const int nbrow = pm2 * BM, nbcol = pn2 * BM;
            if (wr == 1) BAR;
            WAIT_VN(4 + Epi::NSTORES); BAR;
            STAGE(SB(1, 0), Bt, nbcol, 1); STAGE(SA(1, 0), A, nbrow, 1); STAGE(SB(1, 1), Bt, nbcol + HALF, 1);
            WAIT_VN(6 + Epi::NSTORES); BAR;
        }
        u += gridDim.x; pm = pm2; pn = pn2;
    }
#undef SA
#undef SB
#undef STAGE_X
#undef STAGE
#undef LDA
#undef LDB
#undef MMA
#undef WAIT_V
#undef WAIT_VN
#undef WAIT_L
#undef BAR
#undef SCHED
}
}

__host__ __device__ __forceinline__ int perm32(int rho) { return 8 * ((rho >> 2) & 3) + 4 * (rho >> 4) + (rho & 3); }
__host__ __device__ __forceinline__ int perm32_inv(int a) { return 16 * ((a >> 2) & 1) + 4 * (a >> 3) + (a & 3); }
struct ConvJob { const float* src; int src_ld; bf16_t* dst; int dst_ld; int K, N; int map; float scale; const float* kscale; };
__device__ __forceinline__ int conv_col(int map, int n) {
    if (map == 1) return n < 3152 ? n : (n < OFF_CU ? -1 : n - (OFF_CU - 3152));
    if (map == 2) { const int j = n >> 8, r = n & 255; return (r < 128 ? 0 : FH) + j * 128 + (r & 127); }
    return n;
}
__device__ __forceinline__ ConvJob conv_job(const Params& p, int l, int j) {
    ConvJob c; c.map = 0; c.scale = 1.0f; c.kscale = nullptr;
    unsigned char* ws = p.ws;
    switch (j) {
    case 0: c.src = p.in[5] + (size_t)l * DM * IN_COLS; c.src_ld = IN_COLS; c.dst = (bf16_t*)(ws + W_IN); c.dst_ld = DM; c.K = DM; c.N = NPROJ; c.map = 1; c.kscale = p.in[3] + (size_t)l * DM; break;
    case 1: c.src = p.in[12] + (size_t)l * 512 * 1024; c.src_ld = 1024; c.dst = (bf16_t*)(ws + W_B) + (size_t)1536 * 512; c.dst_ld = 512; c.K = 512; c.N = 1024; c.scale = 1.0f / 32.0f; break;
    case 2: c.src = p.in[6] + (size_t)l * DM * DM; c.src_ld = DM; c.dst = (bf16_t*)(ws + W_OUT); c.dst_ld = NMIX; c.K = DM; c.N = DM; break;
    case 3: c.src = p.in[14] + (size_t)l * 256 * 768; c.src_ld = 768; c.dst = (bf16_t*)(ws + W_UVT); c.dst_ld = 256; c.K = 256; c.N = 768; break;
    case 4: c.src = p.in[22] + (size_t)l * DM * 512; c.src_ld = 512; c.dst = (bf16_t*)(ws + W_XQ); c.dst_ld = DM; c.K = DM; c.N = 512; c.kscale = p.in[19] + (size_t)l * DM; break;
    case 5: c.src = p.in[23] + (size_t)l * DM * 1024; c.src_ld = 1024; c.dst = (bf16_t*)(ws + W_XKV); c.dst_ld = DM; c.K = DM; c.N = 1024; break;
    case 6: c.src = p.in[24] + (size_t)l * 512 * DM; c.src_ld = DM; c.dst = (bf16_t*)(ws + W_XO); c.dst_ld = 512; c.K = 512; c.N = DM; break;
    case 7: c.src = p.in[27] + (size_t)l * DM * 2 * FH; c.src_ld = 2 * FH; c.dst = (bf16_t*)(ws + W_GU); c.dst_ld = DM; c.K = DM; c.N = 2 * FH; c.map = 2; c.kscale = p.in[25] + (size_t)l * DM; break;
    default: c.src = p.in[28] + (size_t)l * FH * DM; c.src_ld = DM; c.dst = (bf16_t*)(ws + W_DOWN); c.dst_ld = FH; c.K = FH; c.N = DM; break;
    }
    return c;
}
constexpr int NCONV = 9;

struct ConvRegs { f32x4 r[8]; };
__device__ __forceinline__ void conv_load(const ConvJob& c, int kt, int nt, int tid, ConvRegs& R) {
    const int n = nt * 128 + (tid & 31) * 4, k = kt * 128 + (tid >> 5) * 8;
    const int col = conv_col(c.map, (n & ~31) | perm32(n & 31));
    if (col >= 0) {
        const float* sp = c.src + (size_t)k * c.src_ld + col;
#pragma unroll
        for (int i = 0; i < 8; ++i) R.r[i] = *(const f32x4*)(sp + (size_t)i * c.src_ld);
    } else {
#pragma unroll
        for (int i = 0; i < 8; ++i) R.r[i] = (f32x4){0.f, 0.f, 0.f, 0.f};
    }
}
__device__ __forceinline__ void conv_store(const ConvJob& c, int kt, int nt, int tid, const ConvRegs& R) {
    const int n = nt * 128 + (tid & 31) * 4, k = kt * 128 + (tid >> 5) * 8;
    bf16_t* dp = c.dst + (size_t)n * c.dst_ld + k;
    float sc[8];
    if (c.kscale) { const f32x4 g0 = *(const f32x4*)(c.kscale + k), g1 = *(const f32x4*)(c.kscale + k + 4);
        sc[0] = g0[0]; sc[1] = g0[1]; sc[2] = g0[2]; sc[3] = g0[3]; sc[4] = g1[0]; sc[5] = g1[1]; sc[6] = g1[2]; sc[7] = g1[3]; }
    else {
#pragma unroll
        for (int i = 0; i < 8; ++i) sc[i] = c.scale;
    }
#pragma unroll
    for (int j = 0; j < 4; ++j) {
        u32x4 w;
        w.x = cvt_pk_bf16(R.r[0][j] * sc[0], R.r[1][j] * sc[1]); w.y = cvt_pk_bf16(R.r[2][j] * sc[2], R.r[3][j] * sc[3]);
        w.z = cvt_pk_bf16(R.r[4][j] * sc[4], R.r[5][j] * sc[5]); w.w = cvt_pk_bf16(R.r[6][j] * sc[6], R.r[7][j] * sc[7]);
        *(u32x4*)(dp + (size_t)j * c.dst_ld) = w;
    }
}
constexpr int NCONV_EARLY = 7;
__device__ __forceinline__ bool conv_locate(const Params& p, int l, int g, int j0, int j1, ConvJob& c, int& kt, int& nt) {
    for (int j = j0; j < j1; ++j) {
        c = conv_job(p, l, j);
        const int nk = c.K / 128, n = nk * (c.N / 128);
        if (g < n) { kt = g % nk; nt = g / nk; return true; }
        g -= n;
    }
    return false;
}

__device__ void combo_tile(const float* Ap, int a_i, int a_d, const float* Bp, int b_j, bf16_t* dst, int ldc, float scale, unsigned char* smem) {
    constexpr int S = 132;
    float* As = (float*)smem; float* Bs = As + 64 * S;
    const int tid = opaque_tid();
    __syncthreads();
#pragma unroll
    for (int q = 0; q < 4; ++q) {
        const int idx = tid + 512 * q;
        { const int j = idx >> 5, d4 = (idx & 31) * 4; *(f32x4*)(Bs + j * S + d4) = *(const f32x4*)(Bp + (size_t)j * b_j + d4); }
        if (a_d == 1) { const int i = idx >> 5, d4 = (idx & 31) * 4; *(f32x4*)(As + i * S + d4) = *(const f32x4*)(Ap + (size_t)i * a_i + d4); }
        else { const int e = idx >> 4, i4 = (idx & 15) * 4; const f32x4 v = *(const f32x4*)(Ap + (size_t)e * a_d + i4);
               As[(i4 + 0) * S + e] = v[0]; As[(i4 + 1) * S + e] = v[1]; As[(i4 + 2) * S + e] = v[2]; As[(i4 + 3) * S + e] = v[3]; }
    }
    __syncthreads();
    const int ty = tid >> 4, tx = tid & 15;
    float acc[2][4] = {{0.f, 0.f, 0.f, 0.f}, {0.f, 0.f, 0.f, 0.f}};
#pragma unroll 4
    for (int d4 = 0; d4 < 128; d4 += 4) {
        const f32x4 a0 = *(const f32x4*)(As + (2 * ty) * S + d4), a1 = *(const f32x4*)(As + (2 * ty + 1) * S + d4);
#pragma unroll
        for (int c = 0; c < 4; ++c) {
            const f32x4 b = *(const f32x4*)(Bs + (tx + 16 * c) * S + d4);
            acc[0][c] += a0[0] * b[0] + a0[1] * b[1] + a0[2] * b[2] + a0[3] * b[3];
            acc[1][c] += a1[0] * b[0] + a1[1] * b[1] + a1[2] * b[2] + a1[3] * b[3];
        }
    }
#pragma unroll
    for (int r = 0; r < 2; ++r) {
        const int i = 2 * ty + r, ip = (i & ~31) | perm32_inv(i & 31);
#pragma unroll
        for (int c = 0; c < 4; ++c) dst[(size_t)ip * ldc + tx + 16 * c] = f2bf(acc[r][c] * scale);
    }
}

__device__ __forceinline__ void rownorm_to_bf16(const float* src, const float* g, bf16_t* dst, int lane) {
    f32x4 v[8]; float ss = 0.f;
#pragma unroll
    for (int i = 0; i < 8; ++i) { v[i] = *(const f32x4*)(src + (i * 64 + lane) * 4); ss += v[i][0] * v[i][0] + v[i][1] * v[i][1] + v[i][2] * v[i][2] + v[i][3] * v[i][3]; }
    ss = wave_sum(ss);
    const float r = rsqrtf(ss * (1.0f / DM) + EPS);
#pragma unroll
    for (int i = 0; i < 8; ++i) {
        const f32x4 gg = *(const f32x4*)(g + (i * 64 + lane) * 4);
        u32x2 w; w.x = cvt_pk_bf16(v[i][0] * r * gg[0], v[i][1] * r * gg[1]); w.y = cvt_pk_bf16(v[i][2] * r * gg[2], v[i][3] * r * gg[3]);
        *(u32x2*)(dst + (i * 64 + lane) * 4) = w;
    }
}

__device__ __forceinline__ int rel_bucket(int n) {
    if (n < 16) return n;
    const int b = 16 + (int)(logf((float)n / 16.0f) / 2.0794415416798357f * 16.0f);
    return b < 31 ? b : 31;
}

__device__ __forceinline__ void conv_run(const Params& p, int l, int j0, int j1, int g0, int stride, int cnt, int tid) {
    ConvJob c0, c1; int kt0 = 0, nt0 = 0, kt1 = 0, nt1 = 0;
    ConvRegs R0, R1;
    int g = g0;
    bool v0 = cnt > 0 && conv_locate(p, l, g, j0, j1, c0, kt0, nt0);
    if (v0) conv_load(c0, kt0, nt0, tid, R0);
    while (v0) {
        const bool v1 = cnt > 1 && conv_locate(p, l, g + stride, j0, j1, c1, kt1, nt1);
        if (v1) conv_load(c1, kt1, nt1, tid, R1);
        conv_store(c0, kt0, nt0, tid, R0);
        if (!v1) break;
        g += 2 * stride; cnt -= 2;
        v0 = cnt > 0 && conv_locate(p, l, g, j0, j1, c0, kt0, nt0);
        if (v0) conv_load(c0, kt0, nt0, tid, R0);
        conv_store(c1, kt1, nt1, tid, R1);
    }
}

__device__ void phase_weights(const Params& p, int l, unsigned char* smem) {
    const int tid = opaque_tid(), wid = tid >> 6, lane = tid & 63;
    const int gtid = blockIdx.x * NTHREADS + tid, gthreads = gridDim.x * NTHREADS;
    unsigned char* ws = p.ws;
    conv_run(p, l, 0, NCONV_EARLY, blockIdx.x, gridDim.x, 1 << 30, tid);
    {
        const float* uq = p.in[11] + (size_t)l * 512 * 768;
        const float* uk = p.in[13] + (size_t)l * 256 * 768;
        const float* uv = p.in[14] + (size_t)l * 256 * 768;
        const float* wo = p.in[6] + (size_t)l * DM * DM;
        for (int t = blockIdx.x; t < 192; t += gridDim.x) {
            {
                const int it = t >> 3, jt = t & 7, n0 = it * 64, h = n0 >> 8, rkv0 = n0 & 255;
                combo_tile(uk + (size_t)rkv0 * 768 + h * 128, 768, 1, uq + (size_t)(jt * 64) * 768 + h * 128, 768,
                           (bf16_t*)(ws + W_B) + (size_t)n0 * 512 + jt * 64, 512, 0.08838834764831845f, smem);
            }
        }
    }
    for (int r = blockIdx.x * 8 + wid; r < MEMROWS; r += gridDim.x * 8)
        rownorm_to_bf16(p.in[1] + (size_t)r * DM, p.in[21] + (size_t)l * DM, (bf16_t*)(ws + WS_MEMN) + (size_t)r * DM, lane);
    if (l == 0) {
        {
            const int stride = gridDim.x * 8;
            int r = blockIdx.x * 8 + wid;
            f32x4 nx[8];
            if (r < MTOK) {
#pragma unroll
                for (int i = 0; i < 8; ++i) nx[i] = *(const f32x4*)(p.in[0] + (size_t)r * DM + (i * 64 + lane) * 4);
            }
            for (; r < MTOK; r += stride) {
                bf16_t* dst = (bf16_t*)(ws + WS_H16) + (size_t)r * DM;
                f32x4 v[8];
#pragma unroll
                for (int i = 0; i < 8; ++i) v[i] = nx[i];
                if (r + stride < MTOK) {
#pragma unroll
                    for (int i = 0; i < 8; ++i) nx[i] = *(const f32x4*)(p.in[0] + (size_t)(r + stride) * DM + (i * 64 + lane) * 4);
                }
                float ss = 0.f;
#pragma unroll
                for (int i = 0; i < 8; ++i) { ss += v[i][0] * v[i][0] + v[i][1] * v[i][1] + v[i][2] * v[i][2] + v[i][3] * v[i][3];
                    u32x2 w; w.x = cvt_pk_bf16(v[i][0], v[i][1]); w.y = cvt_pk_bf16(v[i][2], v[i][3]); *(u32x2*)(dst + (i * 64 + lane) * 4) = w; }
                ss = wave_sum(ss);
                if (lane < 8) ((float*)(ws + WS_SSQ))[(size_t)r * 8 + lane] = lane == 0 ? ss : 0.f;
            }
        }
        float* lut = (float*)(ws + WS_LUT);
        for (int o = gtid; o < 12 * 128; o += gthreads) { const int h = o >> 7, d = o & 127; lut[o] = p.in[2][rel_bucket(d) * 12 + h] * LOG2E; }
    }
    if (blockIdx.x == 0 && wid == 0) {
        bool ok = true;
#if PROBE_CHK
        {
            typedef int v2i __attribute__((ext_vector_type(2)));
            unsigned char* tb = smem + 100000;
            const int g = lane >> 4, i = lane & 15;
#if PROBE_CHK & 1
            for (int e = lane; e < 512; e += 64) { const int gg = e >> 7, rr = (e >> 4) & 7, cc = e & 15; tb[e] = (unsigned char)((rr * 16 + cc + 37 * gg) & 255); }
            asm volatile("s_waitcnt lgkmcnt(0)" ::: "memory");
            const v2i r = __builtin_amdgcn_ds_read_tr8_b64_v2i32((LAS v2i*)(tb + g * 128 + (i >> 1) * 16 + (i & 1) * 8));
            unsigned long long got = ((unsigned long long)(unsigned)r.y << 32) | (unsigned)r.x, want = 0ull;
            for (int e = 0; e < 8; ++e) want |= (unsigned long long)((e * 16 + i + 37 * g) & 255) << (8 * e);
            ok = ok && __all(got == want);
#endif
#if PROBE_CHK & 2
            unsigned long long av = 0ull, bv = 0ull;
            for (int e = 0; e < 8; e += 2) {
                const int k0 = 8 * g + e;
                const int pa = __builtin_amdgcn_cvt_pk_fp8_f32((float)((i + 2 * k0) % 5), (float)((i + 2 * (k0 + 1)) % 5), 0, false);
                const int pb = __builtin_amdgcn_cvt_pk_fp8_f32((float)((3 * i + k0) % 7), (float)((3 * i + k0 + 1) % 7), 0, false);
                av |= (unsigned long long)(pa & 0xFFFF) << (8 * e); bv |= (unsigned long long)(pb & 0xFFFF) << (8 * e);
            }
            f32x4 acc = {0.f, 0.f, 0.f, 0.f};
            acc = __builtin_amdgcn_mfma_f32_16x16x32_fp8_fp8((long)av, (long)bv, acc, 0, 0, 0);
            bool good = true;
            for (int r = 0; r < 4; ++r) { const int ii = 4 * g + r, jj = i; float want2 = 0.f; for (int k = 0; k < 32; ++k) want2 += (float)(((ii + 2 * k) % 5) * ((3 * jj + k) % 7)); good = good && (acc[r] == want2); }
            ok = ok && __all(good);
#endif
        }
#endif
        const float* lp = p.in[7] + (size_t)l * 256;
        float a = lp[lane] * lp[64 + lane], b = lp[128 + lane] * lp[192 + lane];
        a = wave_sum(a); b = wave_sum(b);
        if (lane == 0) ((float*)(ws + WS_LAM))[l] = ok ? expf(a) - expf(b) + (0.8f - 0.6f * expf(-0.3f * (float)l)) : __builtin_nanf("");
    }
}

__device__ void phase_post(const bf16_t* tmp, const float* hold32, bf16_t* h16, float* out32, const float* g_post, float* rstd) {
    const int tid = opaque_tid(), wid = tid >> 6, lane = tid & 63;
    f32x4 gg[8];
#pragma unroll
    for (int i = 0; i < 4; ++i) { gg[2 * i] = *(const f32x4*)(g_post + (i * 64 + lane) * 8); gg[2 * i + 1] = *(const f32x4*)(g_post + (i * 64 + lane) * 8 + 4); }
    const int stride = gridDim.x * 8;
    u32x4 tw[4], hw[4]; f32x4 hf[8];
#define PP_LOAD(r_) do { _Pragma("unroll") for (int i_ = 0; i_ < 4; ++i_) { \
        tw[i_] = *(const u32x4*)(tmp + (size_t)(r_) * DM + (i_ * 64 + lane) * 8); \
        if (hold32) { hf[2 * i_] = *(const f32x4*)(hold32 + (size_t)(r_) * DM + (i_ * 64 + lane) * 8); hf[2 * i_ + 1] = *(const f32x4*)(hold32 + (size_t)(r_) * DM + (i_ * 64 + lane) * 8 + 4); } \
        else hw[i_] = *(const u32x4*)(h16 + (size_t)(r_) * DM + (i_ * 64 + lane) * 8); } } while (0)
    int r = blockIdx.x * 8 + wid;
    if (r < MTOK) PP_LOAD(r);
    for (; r < MTOK; r += stride) {
        bf16_t* hr = h16 + (size_t)r * DM;
        f32x4 v[8], hv[8]; float ss = 0.f;
#pragma unroll
        for (int i = 0; i < 4; ++i) {
            v[2 * i] = (f32x4){bflo(tw[i].x), bfhi(tw[i].x), bflo(tw[i].y), bfhi(tw[i].y)}; v[2 * i + 1] = (f32x4){bflo(tw[i].z), bfhi(tw[i].z), bflo(tw[i].w), bfhi(tw[i].w)};
            if (hold32) { hv[2 * i] = hf[2 * i]; hv[2 * i + 1] = hf[2 * i + 1]; }
            else { hv[2 * i] = (f32x4){bflo(hw[i].x), bfhi(hw[i].x), bflo(hw[i].y), bfhi(hw[i].y)}; hv[2 * i + 1] = (f32x4){bflo(hw[i].z), bfhi(hw[i].z), bflo(hw[i].w), bfhi(hw[i].w)}; }
        }
#pragma unroll
        for (int i = 0; i < 8; ++i) ss += v[i][0] * v[i][0] + v[i][1] * v[i][1] + v[i][2] * v[i][2] + v[i][3] * v[i][3];
        if (r + stride < MTOK) PP_LOAD(r + stride);
        ss = wave_sum(ss);
        const float rr = rsqrtf(ss * (1.0f / DM) + EPS);
        float s2 = 0.f;
#pragma unroll
        for (int i = 0; i < 8; ++i) hv[i] = hv[i] + v[i] * rr * gg[i];
#pragma unroll
        for (int i = 0; i < 4; ++i) {
            if (out32) { *(f32x4*)(out32 + (size_t)r * DM + (i * 64 + lane) * 8) = hv[2 * i]; *(f32x4*)(out32 + (size_t)r * DM + (i * 64 + lane) * 8 + 4) = hv[2 * i + 1]; }
            else {
                u32x4 w; w.x = cvt_pk_bf16(hv[2 * i][0], hv[2 * i][1]); w.y = cvt_pk_bf16(hv[2 * i][2], hv[2 * i][3]); w.z = cvt_pk_bf16(hv[2 * i + 1][0], hv[2 * i + 1][1]); w.w = cvt_pk_bf16(hv[2 * i + 1][2], hv[2 * i + 1][3]);
                *(u32x4*)(hr + (i * 64 + lane) * 8) = w;
                const float e0 = bflo(w.x), e1 = bfhi(w.x), e2 = bflo(w.y), e3 = bfhi(w.y), e4 = bflo(w.z), e5 = bfhi(w.z), e6 = bflo(w.w), e7 = bfhi(w.w);
                s2 += e0 * e0 + e1 * e1 + e2 * e2 + e3 * e3 + e4 * e4 + e5 * e5 + e6 * e6 + e7 * e7;
            }
        }
        if (!out32) { s2 = wave_sum(s2); if (lane < 8) rstd[(size_t)r * 8 + lane] = lane == 0 ? s2 : 0.f; }
    }
#undef PP_LOAD
}

__device__ void phase_latent_norms(const Params& p, int l) {
    const int tid = opaque_tid(), wid = tid >> 6, lane = tid & 63;
    const bf16_t* proj = (const bf16_t*)(p.ws + WS_PROJ);
    bf16_t* cqn = (bf16_t*)(p.ws + WS_CQN); unsigned char* ckv8 = p.ws + WS_CKVN;
    float* cstat = (float*)(p.ws + WS_CSTAT);
    const float* gq = p.in[9] + (size_t)l * 512; const float* gkv = p.in[10] + (size_t)l * 256;
    const f32x4 g0 = *(const f32x4*)(gq + lane * 8), g1 = *(const f32x4*)(gq + lane * 8 + 4), g2 = *(const f32x4*)(gkv + lane * 4);
    const int stride = gridDim.x * 8;
    int r = blockIdx.x * 8 + wid;
    u32x4 na = {0u, 0u, 0u, 0u}, ncv = {0u, 0u, 0u, 0u}; u32x2 nb = {0u, 0u};
    if (r < MTOK) { na = *(const u32x4*)(proj + (size_t)r * NPROJ + OFF_CQ + lane * 8); nb = *(const u32x2*)(proj + (size_t)r * NPROJ + OFF_CKV + lane * 4); ncv = *(const u32x4*)(proj + (size_t)r * NPROJ + OFF_CV + lane * 8); }
    for (; r < MTOK; r += stride) {
        const u32x4 a = na; const u32x2 b = nb; const u32x4 cvv = ncv;
        if (r + stride < MTOK) { const size_t rn = (size_t)(r + stride);
            na = *(const u32x4*)(proj + rn * NPROJ + OFF_CQ + lane * 8); nb = *(const u32x2*)(proj + rn * NPROJ + OFF_CKV + lane * 4); ncv = *(const u32x4*)(proj + rn * NPROJ + OFF_CV + lane * 8); }
        float x[8] = {bflo(a.x), bfhi(a.x), bflo(a.y), bfhi(a.y), bflo(a.z), bfhi(a.z), bflo(a.w), bfhi(a.w)};
        float y[4] = {bflo(b.x), bfhi(b.x), bflo(b.y), bfhi(b.y)};
        float z[8] = {bflo(cvv.x), bfhi(cvv.x), bflo(cvv.y), bfhi(cvv.y), bflo(cvv.z), bfhi(cvv.z), bflo(cvv.w), bfhi(cvv.w)};
        float sa = 0.f, sb = 0.f, sc = 0.f, sd = 0.f;
#pragma unroll
        for (int i = 0; i < 8; ++i) { sa += x[i] * x[i]; sc += z[i]; sd += z[i] * z[i]; }
#pragma unroll
        for (int i = 0; i < 4; ++i) sb += y[i] * y[i];
        sa = wave_sum(sa); sb = wave_sum(sb); sc = wave_sum(sc); sd = wave_sum(sd);
        const float ra = rsqrtf(sa * (1.0f / 512.0f) + EPS), rb = rsqrtf(sb * (1.0f / 256.0f) + EPS);
        const float mu = sc * (1.0f / 512.0f), var = fmaxf(sd * (1.0f / 512.0f) - mu * mu, 0.f);
        u32x4 wa; wa.x = cvt_pk_bf16(x[0] * ra * g0[0], x[1] * ra * g0[1]); wa.y = cvt_pk_bf16(x[2] * ra * g0[2], x[3] * ra * g0[3]);
        wa.z = cvt_pk_bf16(x[4] * ra * g1[0], x[5] * ra * g1[1]); wa.w = cvt_pk_bf16(x[6] * ra * g1[2], x[7] * ra * g1[3]);
        int wb = __builtin_amdgcn_cvt_pk_fp8_f32(y[0] * rb * g2[0], y[1] * rb * g2[1], 0, false);
        wb = __builtin_amdgcn_cvt_pk_fp8_f32(y[2] * rb * g2[2], y[3] * rb * g2[3], wb, true);
        *(u32x4*)(cqn + (size_t)r * 512 + lane * 8) = wa;
        *(int*)(ckv8 + (size_t)r * 256 + lane * 4) = wb;
        if (lane == 0) { cstat[2 * (size_t)r] = mu; cstat[2 * (size_t)r + 1] = rsqrtf(var + EPS); }
    }
}

__device__ void cbranch_unit(const Params& p, int l, int unit, unsigned char* smem) {
    constexpr int LS = 136;
    bf16_t* Ws = (bf16_t*)smem;
    bf16_t* Vs = Ws + 128 * LS;
    const int tid = opaque_tid(), wid = tid >> 6, lane = tid & 63;
    const int chunk = unit >> 2, g = unit & 3, r0 = chunk * 128;
    const bf16_t* proj = (const bf16_t*)(p.ws + WS_PROJ);
    const float* cstat = (const float*)(p.ws + WS_CSTAT);
    bf16_t* mix = (bf16_t*)(p.ws + WS_MIX);
    __syncthreads();
    {
        const int c8 = (tid & 15) * 8;
        const float* lg = p.in[15] + (size_t)l * 512 + g * 128 + c8;
        const float* lb = p.in[16] + (size_t)l * 512 + g * 128 + c8;
        const f32x4 lg0 = *(const f32x4*)lg, lg1 = *(const f32x4*)(lg + 4), lb0 = *(const f32x4*)lb, lb1 = *(const f32x4*)(lb + 4);
#pragma unroll
        for (int i = 0; i < 4; ++i) {
            const int sr = (tid >> 4) + 32 * i;
            const u32x4 a = *(const u32x4*)(proj + (size_t)(r0 + sr) * NPROJ + OFF_CV + g * 128 + c8);
            const float mu = cstat[2 * (size_t)(r0 + sr)], rs = cstat[2 * (size_t)(r0 + sr) + 1];
            u32x4 o;
            o.x = cvt_pk_bf16((bflo(a.x) - mu) * rs * lg0[0] + lb0[0], (bfhi(a.x) - mu) * rs * lg0[1] + lb0[1]);
            o.y = cvt_pk_bf16((bflo(a.y) - mu) * rs * lg0[2] + lb0[2], (bfhi(a.y) - mu) * rs * lg0[3] + lb0[3]);
            o.z = cvt_pk_bf16((bflo(a.z) - mu) * rs * lg1[0] + lb1[0], (bfhi(a.z) - mu) * rs * lg1[1] + lb1[1]);
            o.w = cvt_pk_bf16((bflo(a.w) - mu) * rs * lg1[2] + lb1[2], (bfhi(a.w) - mu) * rs * lg1[3] + lb1[3]);
            *(u32x4*)(Vs + sr * LS + c8) = o;
        }
        const float* wsrc = p.in[17] + ((size_t)l * 4 + g) * 128 * 128;
        const int s4 = (tid & 31) * 4;
#pragma unroll
        for (int i = 0; i < 8; ++i) {
            const int tr = (tid >> 5) + 16 * i;
            const f32x4 w = *(const f32x4*)(wsrc + (size_t)tr * 128 + s4);
            u32x2 o; o.x = cvt_pk_bf16(s4 <= tr ? w[0] : 0.f, s4 + 1 <= tr ? w[1] : 0.f); o.y = cvt_pk_bf16(s4 + 2 <= tr ? w[2] : 0.f, s4 + 3 <= tr ? w[3] : 0.f);
            *(u32x2*)(Ws + tr * LS + s4) = o;
        }
    }
    __syncthreads();
    const int fr = lane & 15, fq = lane >> 4, q4 = fr >> 2, p4 = lane & 3;
    const int t = wid * 16 + fr;
    const float bs = p.in[18][((size_t)l * 4 + g) * 128 + t];
    bf16x8 bw[4];
#pragma unroll
    for (int ks = 0; ks < 4; ++ks) bw[ks] = *(const bf16x8*)(Ws + t * LS + ks * 32 + fq * 8);
    const unsigned char* vtr = (const unsigned char*)Vs + ((8 * fq + q4) * LS + 4 * p4) * 2;
    u32x2 uu[8];
#pragma unroll
    for (int ct = 0; ct < 8; ++ct) uu[ct] = *(const u32x2*)(proj + (size_t)(r0 + t) * NPROJ + OFF_CU + g * 128 + ct * 16 + fq * 4);
#pragma unroll
    for (int ct = 0; ct < 8; ++ct) {
        f32x4 acc = {0.f, 0.f, 0.f, 0.f};
        s16x4 lo[4], hi[4];
#pragma unroll
        for (int ks = 0; ks < 4; ++ks) {
            lo[ks] = __builtin_amdgcn_ds_read_tr16_b64_v4i16((LAS s16x4*)(vtr + (32 * ks) * LS * 2 + ct * 32));
            hi[ks] = __builtin_amdgcn_ds_read_tr16_b64_v4i16((LAS s16x4*)(vtr + (32 * ks + 4) * LS * 2 + ct * 32));
        }
#pragma unroll
        for (int ks = 0; ks < 4; ++ks) {
            const bf16x8 af = __builtin_shufflevector(lo[ks], hi[ks], 0, 1, 2, 3, 4, 5, 6, 7);
            acc = __builtin_amdgcn_mfma_f32_16x16x32_bf16(af, bw[ks], acc, 0, 0, 0);
        }
        const int c = ct * 16 + fq * 4;
        const u32x2 u = uu[ct];
        u32x2 o; o.x = cvt_pk_bf16(bflo(u.x) * (acc[0] + bs), bfhi(u.x) * (acc[1] + bs)); o.y = cvt_pk_bf16(bflo(u.y) * (acc[2] + bs), bfhi(u.y) * (acc[3] + bs));
        *(u32x2*)(mix + (size_t)(r0 + t) * NMIX + 1536 + g * 128 + c) = o;
    }
}

namespace at {
constexpr int VS = 320;
__device__ __forceinline__ int crow(int r, int hi) { return (r & 3) + 8 * (r >> 2) + 4 * hi; }

template <int DQK, bool CAUSAL>
__device__ __forceinline__ void attn_pass(const bf16_t* __restrict__ Qp, const int ldq, const bf16_t* __restrict__ Kp, const int ldk,
                                          const bf16_t* __restrict__ Vp, const int ldv, const int q0, const int ntiles, const float c2,
                                          const float* lutp, f32x16 (&O)[4], float& lsum_out, unsigned char* smem) {
    constexpr int KS = DQK * 2 + 16, KB = 64 * KS, BUF = KB + 64 * VS, NKC = DQK / 64, NKS = DQK / 16;
    const int tid = opaque_tid(), wid = tid >> 6, lane = tid & 63, l31 = lane & 31, hi = lane >> 5;
    const int krow = (DQK == 64) ? (tid >> 3) : (tid >> 4), kch = (DQK == 64) ? (tid & 7) : (tid & 15);
    const int vrow = tid >> 4, vch = tid & 15;
    u32x4 kr[NKC], vr[2];
#define AT_GLOAD(j) do { const int k0_ = (j) * 64; \
        for (int i_ = 0; i_ < NKC; ++i_) kr[i_] = *(const u32x4*)(Kp + (size_t)(k0_ + krow + 32 * i_) * ldk + kch * 8); \
        for (int i_ = 0; i_ < 2; ++i_) vr[i_] = *(const u32x4*)(Vp + (size_t)(k0_ + vrow + 32 * i_) * ldv + vch * 8); } while (0)
#define AT_LSTORE(buf) do { \
        for (int i_ = 0; i_ < NKC; ++i_) *(u32x4*)((buf) + (krow + 32 * i_) * KS + kch * 16) = kr[i_]; \
        for (int i_ = 0; i_ < 2; ++i_) *(u32x4*)((buf) + KB + (vrow + 32 * i_) * VS + vch * 16) = vr[i_]; } while (0)
    bf16x8 qf[NKS];
#pragma unroll
    for (int ks = 0; ks < NKS; ++ks) qf[ks] = *(const bf16x8*)(Qp + (size_t)(wid * 32 + l31) * ldq + ks * 16 + hi * 8);
#pragma unroll
    for (int d = 0; d < 4; ++d)
#pragma unroll
        for (int r = 0; r < 16; ++r) O[d][r] = 0.f;
    float m = -1e30f, lsum = 0.f;
    const int qw0 = q0 + wid * 32;
    const int q4 = (lane & 15) >> 2, p4 = lane & 3, blk = (lane >> 4) & 1;
    const int vtr = (4 * hi + q4) * VS + (16 * blk + 4 * p4) * 2;
    __syncthreads();
    AT_GLOAD(0);
    AT_LSTORE(smem);
    __syncthreads();
    const float lut127 = CAUSAL ? lutp[127] : 0.f;
#pragma unroll 1
    for (int j = 0; j < ntiles; ++j) {
        unsigned char* buf = smem + (j & 1) * BUF;
        if (j + 1 < ntiles) AT_GLOAD(j + 1);
        const int k0 = j * 64;
        if (!CAUSAL || k0 <= qw0 + 31) {
            f32x16 st[2];
#pragma unroll
            for (int kt = 0; kt < 2; ++kt)
#pragma unroll
                for (int r = 0; r < 16; ++r) st[kt][r] = 0.f;
            if (DQK == 64) {
                bf16x8 kf[2][NKS];
#pragma unroll
                for (int kt = 0; kt < 2; ++kt)
#pragma unroll
                    for (int ks = 0; ks < NKS; ++ks) kf[kt][ks] = *(const bf16x8*)(buf + (kt * 32 + l31) * KS + (ks * 16 + hi * 8) * 2);
                __builtin_amdgcn_sched_barrier(0);
#pragma unroll
                for (int ks = 0; ks < NKS; ++ks)
#pragma unroll
                    for (int kt = 0; kt < 2; ++kt) st[kt] = __builtin_amdgcn_mfma_f32_32x32x16_bf16(kf[kt][ks], qf[ks], st[kt], 0, 0, 0);
                __builtin_amdgcn_sched_barrier(0);
            } else {
#pragma unroll
                for (int kt = 0; kt < 2; ++kt) {
                    bf16x8 kf[NKS];
#pragma unroll
                    for (int ks = 0; ks < NKS; ++ks) kf[ks] = *(const bf16x8*)(buf + (kt * 32 + l31) * KS + (ks * 16 + hi * 8) * 2);
                    __builtin_amdgcn_sched_barrier(0);
#pragma unroll
                    for (int ks = 0; ks < NKS; ++ks) st[kt] = __builtin_amdgcn_mfma_f32_32x32x16_bf16(kf[ks], qf[ks], st[kt], 0, 0, 0);
                    __builtin_amdgcn_sched_barrier(0);
                }
            }
            const bool unif = !CAUSAL || (qw0 - (k0 + 63) >= 127);
            float pmax;
            if (unif) {
                pmax = st[0][0];
#pragma unroll
                for (int r = 1; r < 16; ++r) pmax = fmaxf(pmax, st[0][r]);
#pragma unroll
                for (int r = 0; r < 16; ++r) pmax = fmaxf(pmax, st[1][r]);
                pmax = fmaf(pmax, c2, lut127);
            } else {
                const int tq = qw0 + l31;
                pmax = -__builtin_inff();
                float bias[2][16];
#pragma unroll
                for (int kt = 0; kt < 2; ++kt)
#pragma unroll
                    for (int r = 0; r < 16; ++r) {
                        const int dd = tq - (k0 + 32 * kt + crow(r, hi));
                        bias[kt][r] = lutp[dd < 0 ? 0 : (dd > 127 ? 127 : dd)];
                    }
                __builtin_amdgcn_sched_barrier(0);
#pragma unroll
                for (int kt = 0; kt < 2; ++kt)
#pragma unroll
                    for (int r = 0; r < 16; ++r) {
                        const int dd = tq - (k0 + 32 * kt + crow(r, hi));
                        st[kt][r] = dd < 0 ? -__builtin_inff() : fmaf(st[kt][r], c2, bias[kt][r]);
                        pmax = fmaxf(pmax, st[kt][r]);
                    }
            }
            pmax = fmaxf(pmax, __shfl_xor(pmax, 32, 64));
            if (!__all(pmax - m <= 8.0f)) {
                const float mn = fmaxf(m, pmax);
                const float alpha = fast_exp2(m - mn);
                m = mn;
                lsum *= alpha;
#pragma unroll
                for (int d = 0; d < 4; ++d)
#pragma unroll
                    for (int r = 0; r < 16; ++r) O[d][r] *= alpha;
            }
            typedef float f32x2_ __attribute__((ext_vector_type(2)));
            f32x2_ ps2 = {0.f, 0.f};
            const float off = unif ? lut127 - m : -m, csc = unif ? c2 : 1.0f;
            const f32x2_ off2 = {off, off}, csc2 = {csc, csc};
            bf16x8 pf[2][2];
#define AT_EXP(kt) do { _Pragma("unroll") for (int r = 0; r < 16; r += 2) { f32x2_ z_ = {st[kt][r], st[kt][r + 1]}; z_ = __builtin_elementwise_fma(z_, csc2, off2); \
                    f32x2_ e_ = {fast_exp2(z_.x), fast_exp2(z_.y)}; st[kt][r] = e_.x; st[kt][r + 1] = e_.y; ps2 += e_; } \
                _Pragma("unroll") for (int s_ = 0; s_ < 2; ++s_) { \
                    u32x4 w; w.x = cvt_pk_bf16(st[kt][8 * s_ + 0], st[kt][8 * s_ + 1]); w.y = cvt_pk_bf16(st[kt][8 * s_ + 2], st[kt][8 * s_ + 3]); \
                    w.z = cvt_pk_bf16(st[kt][8 * s_ + 4], st[kt][8 * s_ + 5]); w.w = cvt_pk_bf16(st[kt][8 * s_ + 6], st[kt][8 * s_ + 7]); \
                    pf[kt][s_] = *reinterpret_cast<bf16x8*>(&w); } } while (0)
            const unsigned char* vb = buf + KB + vtr;
#define AT_LOADV(dst, q_) do { _Pragma("unroll") for (int d_ = 0; d_ < 4; ++d_) { \
                dst[2 * d_]     = __builtin_amdgcn_ds_read_tr16_b64_v4i16((LAS s16x4*)(vb + (16 * (q_)) * VS + d_ * 64)); \
                dst[2 * d_ + 1] = __builtin_amdgcn_ds_read_tr16_b64_v4i16((LAS s16x4*)(vb + (16 * (q_) + 8) * VS + d_ * 64)); } } while (0)
#define AT_PV(src, q_) do { _Pragma("unroll") for (int d_ = 0; d_ < 4; ++d_) { \
                const bf16x8 vf_ = __builtin_shufflevector(src[2 * d_], src[2 * d_ + 1], 0, 1, 2, 3, 4, 5, 6, 7); \
                O[d_] = __builtin_amdgcn_mfma_f32_32x32x16_bf16(vf_, pf[(q_) >> 1][(q_) & 1], O[d_], 0, 0, 0); } } while (0)
            s16x4 va[8], vc[8];
            AT_LOADV(va, 0); AT_LOADV(vc, 1);
            AT_EXP(0);
            __builtin_amdgcn_sched_barrier(0);
            __builtin_amdgcn_s_waitcnt(0xC07F);
            AT_PV(va, 0); AT_PV(vc, 1);
            AT_EXP(1);
#pragma unroll
            for (int i_ = 0; i_ < 8; ++i_) { __builtin_amdgcn_sched_group_barrier(0x008, 1, 0); __builtin_amdgcn_sched_group_barrier(0x002, 7, 0); }
            __builtin_amdgcn_sched_barrier(0);
            lsum += ps2.x + ps2.y;
            AT_LOADV(va, 2); AT_LOADV(vc, 3); __builtin_amdgcn_sched_barrier(0);
            AT_PV(va, 2);    __builtin_amdgcn_sched_barrier(0);
            AT_PV(vc, 3);    __builtin_amdgcn_sched_barrier(0);
#undef AT_EXP
#undef AT_LOADV
#undef AT_PV
        }
        if (j + 1 < ntiles) AT_LSTORE(smem + ((j + 1) & 1) * BUF);
        __syncthreads();
    }
    lsum_out = lsum + __shfl_xor(lsum, 32, 64);
#undef AT_GLOAD
#undef AT_LSTORE
}
constexpr int LDS_LUT_A = 2 * (64 * (64 * 2 + 16) + 64 * VS);

__device__ void attnA_unit(const Params& p, int unit, unsigned char* smem) {
    const int qblk = 15 - unit / 48, rem = unit % 48, bh = rem >> 1, map = rem & 1, b = bh / 6, h = bh % 6;
    const int tid = opaque_tid(), wid = tid >> 6, lane = tid & 63, l31 = lane & 31, hi = lane >> 5;
    const bf16_t* proj = (const bf16_t*)(p.ws + WS_PROJ);
    const size_t rowb = (size_t)b * SEQ;
    const int q0 = qblk * 256;
    float* lut = (float*)(smem + LDS_LUT_A);
    __syncthreads();
    if (tid < 128) lut[tid] = ((const float*)(p.ws + WS_LUT))[h * 128 + tid];
    f32x16 O[4]; float lsum;
    attn_pass<64, true>(proj + (rowb + q0) * NPROJ + OFF_QA + h * 128 + map * 64, NPROJ, proj + rowb * NPROJ + OFF_KA + h * 128 + map * 64, NPROJ,
                        proj + rowb * NPROJ + OFF_VA + h * 128, NPROJ, q0, 4 * (qblk + 1), 0.125f * LOG2E, lut, O, lsum, smem);
    const float inv = 1.0f / lsum;
    bf16_t* orow = map == 0 ? (bf16_t*)(p.ws + WS_MIX) + (rowb + q0 + wid * 32 + l31) * NMIX + h * 128
                            : (bf16_t*)p.out + (rowb + q0 + wid * 32 + l31) * 768 + h * 128;
#pragma unroll
    for (int d = 0; d < 4; ++d)
#pragma unroll
        for (int g = 0; g < 4; ++g) {
            const int dv0 = 32 * d + 8 * g + 4 * hi;
            u32x2 w; w.x = cvt_pk_bf16(O[d][4 * g] * inv, O[d][4 * g + 1] * inv); w.y = cvt_pk_bf16(O[d][4 * g + 2] * inv, O[d][4 * g + 3] * inv);
            *(u32x2*)(orow + dv0) = w;
        }
}
__device__ void attnA_combine(const Params& p, int l, int unit) {
    const int tid = opaque_tid(), sub = tid & 15, grp = tid >> 4;
    const float lam = ((const float*)(p.ws + WS_LAM))[l];
    const float lam_init = 0.8f - 0.6f * expf(-0.3f * (float)l);
    const float* sg = p.in[8] + (size_t)l * 128 + sub * 8;
    const f32x4 g0 = *(const f32x4*)sg, g1 = *(const f32x4*)(sg + 4);
    bf16_t* mix = (bf16_t*)(p.ws + WS_MIX); const bf16_t* oa1 = (const bf16_t*)p.out;
    constexpr int NPAIR = 64 * 6;
    u32x4 na, nc;
    { const size_t row = (size_t)unit * 64 + grp / 6; const int h = grp % 6; na = *(const u32x4*)(mix + row * NMIX + h * 128 + sub * 8); nc = *(const u32x4*)(oa1 + row * 768 + h * 128 + sub * 8); }
    for (int pr = grp; pr < NPAIR; pr += 32) {
        const size_t row = (size_t)unit * 64 + pr / 6; const int h = pr % 6;
        bf16_t* mp = mix + row * NMIX + h * 128 + sub * 8;
        const u32x4 a = na, c = nc;
        if (pr + 32 < NPAIR) { const size_t row2 = (size_t)unit * 64 + (pr + 32) / 6; const int h2 = (pr + 32) % 6;
            na = *(const u32x4*)(mix + row2 * NMIX + h2 * 128 + sub * 8); nc = *(const u32x4*)(oa1 + row2 * 768 + h2 * 128 + sub * 8); }
        float o[8] = {bflo(a.x) - lam * bflo(c.x), bfhi(a.x) - lam * bfhi(c.x), bflo(a.y) - lam * bflo(c.y), bfhi(a.y) - lam * bfhi(c.y),
                      bflo(a.z) - lam * bflo(c.z), bfhi(a.z) - lam * bfhi(c.z), bflo(a.w) - lam * bflo(c.w), bfhi(a.w) - lam * bfhi(c.w)};
        float ss = 0.f;
#pragma unroll
        for (int i = 0; i < 8; ++i) ss += o[i] * o[i];
        ss += __shfl_xor(ss, 1, 64); ss += __shfl_xor(ss, 2, 64); ss += __shfl_xor(ss, 4, 64); ss += __shfl_xor(ss, 8, 64);
        const float rn = rsqrtf(ss * (1.0f / 128.0f) + EPS) * (1.0f - lam_init);
        u32x4 w; w.x = cvt_pk_bf16(o[0] * rn * g0[0], o[1] * rn * g0[1]); w.y = cvt_pk_bf16(o[2] * rn * g0[2], o[3] * rn * g0[3]);
        w.z = cvt_pk_bf16(o[4] * rn * g1[0], o[5] * rn * g1[1]); w.w = cvt_pk_bf16(o[6] * rn * g1[2], o[7] * rn * g1[3]);
        *(u32x4*)mp = w;
    }
}

__device__ void attnX_unit(const Params& p, int unit, unsigned char* smem) {
    const int qblk = unit & 15, bh = unit >> 4, b = bh >> 2, h = bh & 3;
    const int tid = opaque_tid(), wid = tid >> 6, lane = tid & 63, l31 = lane & 31, hi = lane >> 5;
    const bf16_t* xq = (const bf16_t*)(p.ws + WS_XQ);
    const bf16_t* kvx = (const bf16_t*)(p.ws + WS_KVX);
    const size_t row0 = (size_t)b * SEQ + qblk * 256;
    f32x16 O[4]; float lsum;
    attn_pass<128, false>(xq + row0 * 512 + h * 128, 512, kvx + (size_t)b * MEMLEN * 1024 + h * 128, 1024, kvx + (size_t)b * MEMLEN * 1024 + 512 + h * 128, 1024,
                          0, 4, 0.08838834764831845f * LOG2E, nullptr, O, lsum, smem);
    const float inv = 1.0f / lsum;
    bf16_t* orow = (bf16_t*)(p.ws + WS_XO) + (row0 + wid * 32 + l31) * 512 + h * 128;
#pragma unroll
    for (int d = 0; d < 4; ++d)
#pragma unroll
        for (int g = 0; g < 4; ++g) {
            const int dv0 = 32 * d + 8 * g + 4 * hi;
            u32x2 w; w.x = cvt_pk_bf16(O[d][4 * g] * inv, O[d][4 * g + 1] * inv); w.y = cvt_pk_bf16(O[d][4 * g + 2] * inv, O[d][4 * g + 3] * inv);
            *(u32x2*)(orow + dv0) = w;
        }
}
}

namespace ix {
constexpr int RS = 8208;
constexpr int LDS_STAGE = 16 * RS;
constexpr int LDS_HIST = LDS_STAGE + 8 * 512;
constexpr int HS = 257;
constexpr int LDS_DUMMY = LDS_HIST + 16 * HS * 4;
static_assert(LDS_DUMMY + 8 * 256 <= LDS_CTL, "indexer LDS");
__device__ __forceinline__ unsigned wave_sum_u(unsigned v) { return (unsigned)__builtin_amdgcn_readlane(wave_iscan_i((int)v), 63); }
__device__ __forceinline__ unsigned wave_excl_scan(unsigned v, int lane) { return (unsigned)wave_iscan_i((int)v) - v; }
__device__ void indexer_unit(const Params& p, int b, int qt, unsigned char* smem) {
    const int tid = opaque_tid(), wid = tid >> 6, lane = tid & 63, fr = lane & 15, fq = lane >> 4;
    const int q0 = qt * 16;
    const size_t rowb = (size_t)b * SEQ;
    unsigned short* idxg = (unsigned short*)(p.ws + WS_IDX);
    __syncthreads();
    if (qt < 16) {
        for (int e = tid; e < 16 * 128; e += NTHREADS) { const int r = e >> 7, c = (e & 127) * 2; *(unsigned*)(idxg + (rowb + q0 + r) * TOPK + c) = (unsigned)c | ((unsigned)(c + 1) << 16); }
        return;
    }
    const bf16_t* proj = (const bf16_t*)(p.ws + WS_PROJ);
    const bf16_t* qb = (const bf16_t*)(p.ws + WS_QB);
    const int nkt = qt + 1;
    unsigned* hist = (unsigned*)(smem + LDS_HIST);
#if IX_HIST & 1
    for (int e = tid; e < 16 * HS; e += NTHREADS) hist[e] = 0u;
    __syncthreads();
#endif
    {
        bf16x8 qf[16][2];
        const bf16_t* qrow = qb + (rowb + q0 + fr) * NQB + 1536 + fq * 8;
#pragma unroll
        for (int g = 0; g < 16; ++g)
#pragma unroll
            for (int ks = 0; ks < 2; ++ks) qf[g][ks] = *(const bf16x8*)(qrow + g * 64 + ks * 32);
        unsigned wp[8];
        {
            const u32x4 a = *(const u32x4*)(proj + (rowb + q0 + fr) * NPROJ + OFF_WIDX), c = *(const u32x4*)(proj + (rowb + q0 + fr) * NPROJ + OFF_WIDX + 8);
            wp[0] = a.x; wp[1] = a.y; wp[2] = a.z; wp[3] = a.w; wp[4] = c.x; wp[5] = c.y; wp[6] = c.z; wp[7] = c.w;
        }
        bf16x8 qc[2];
#pragma unroll
        for (int ks = 0; ks < 2; ++ks) {
            float a8[8] = {0.f, 0.f, 0.f, 0.f, 0.f, 0.f, 0.f, 0.f};
#pragma unroll
            for (int g = 0; g < 16; ++g) {
                const float wg = (g & 1) ? bfhi(wp[g >> 1]) : bflo(wp[g >> 1]);
                const u32x4 qv = *reinterpret_cast<const u32x4*>(&qf[g][ks]);
                a8[0] = fmaf(wg, bflo(qv.x), a8[0]); a8[1] = fmaf(wg, bfhi(qv.x), a8[1]); a8[2] = fmaf(wg, bflo(qv.y), a8[2]); a8[3] = fmaf(wg, bfhi(qv.y), a8[3]);
                a8[4] = fmaf(wg, bflo(qv.z), a8[4]); a8[5] = fmaf(wg, bfhi(qv.z), a8[5]); a8[6] = fmaf(wg, bflo(qv.w), a8[6]); a8[7] = fmaf(wg, bfhi(qv.w), a8[7]);
            }
            u32x4 o4; o4.x = cvt_pk_bf16(a8[0], a8[1]); o4.y = cvt_pk_bf16(a8[2], a8[3]); o4.z = cvt_pk_bf16(a8[4], a8[5]); o4.w = cvt_pk_bf16(a8[6], a8[7]);
            qc[ks] = *reinterpret_cast<bf16x8*>(&o4);
        }
        const bf16_t* kbase = proj + (rowb + fr) * NPROJ + OFF_KIDX + fq * 8;
        bf16x8 af0, af1;
        for (int rep_ = 0; rep_ < (PROBE_SUB == 1 ? 2 : 1); ++rep_) {
        bf16x8 ag0 = af0, ag1 = af1;
        if (wid < nkt) { af0 = *(const bf16x8*)(kbase + (size_t)wid * 16 * NPROJ); af1 = *(const bf16x8*)(kbase + (size_t)wid * 16 * NPROJ + 32); }
        if (wid + 8 < nkt) { ag0 = *(const bf16x8*)(kbase + (size_t)(wid + 8) * 16 * NPROJ); ag1 = *(const bf16x8*)(kbase + (size_t)(wid + 8) * 16 * NPROJ + 32); }
        for (int kt = wid; kt < nkt; kt += 8) {
            const bf16x8 a0 = af0, a1 = af1;
            af0 = ag0; af1 = ag1;
            if (kt + 16 < nkt) { ag0 = *(const bf16x8*)(kbase + (size_t)(kt + 16) * 16 * NPROJ); ag1 = *(const bf16x8*)(kbase + (size_t)(kt + 16) * 16 * NPROJ + 32); }
            f32x4 sc = {0.f, 0.f, 0.f, 0.f};
            sc = __builtin_amdgcn_mfma_f32_16x16x32_bf16(a0, qc[0], sc, 0, 0, 0);
            sc = __builtin_amdgcn_mfma_f32_16x16x32_bf16(a1, qc[1], sc, 0, 0, 0);
            f32x4 dc = {0.f, 0.f, 0.f, 0.f};
            dc = __builtin_amdgcn_mfma_f32_16x16x32_bf16(a0, qf[0][0], dc, 0, 0, 0);
            dc = __builtin_amdgcn_mfma_f32_16x16x32_bf16(a1, qf[0][1], dc, 0, 0, 0);
            __builtin_amdgcn_sched_barrier(0);
#pragma unroll
            for (int g = 0; g < 16; ++g) {
                f32x4 dn = {0.f, 0.f, 0.f, 0.f};
                if (g < 15) {
                    dn = __builtin_amdgcn_mfma_f32_16x16x32_bf16(a0, qf[g + 1][0], dn, 0, 0, 0);
                    dn = __builtin_amdgcn_mfma_f32_16x16x32_bf16(a1, qf[g + 1][1], dn, 0, 0, 0);
                }
                __builtin_amdgcn_sched_barrier(0);
                const float wg = (g & 1) ? bfhi(wp[g >> 1]) : bflo(wp[g >> 1]);
                if (g < 15) {
                    asm volatile("v_fma_f32 %0, %4, |%5|, %0\n\tv_fma_f32 %1, %4, |%6|, %1\n\tv_fma_f32 %2, %4, |%7|, %2\n\tv_fma_f32 %3, %4, |%8|, %3"
                                 : "+v"(sc[0]), "+v"(sc[1]), "+v"(sc[2]), "+v"(sc[3]) : "v"(wg), "v"(dc[0]), "v"(dc[1]), "v"(dc[2]), "v"(dc[3]));
                } else {
                    asm volatile("s_nop 7\n\ts_nop 7\n\tv_fma_f32 %0, %4, |%5|, %0\n\tv_fma_f32 %1, %4, |%6|, %1\n\tv_fma_f32 %2, %4, |%7|, %2\n\tv_fma_f32 %3, %4, |%8|, %3"
                                 : "+v"(sc[0]), "+v"(sc[1]), "+v"(sc[2]), "+v"(sc[3]) : "v"(wg), "v"(dc[0]), "v"(dc[1]), "v"(dc[2]), "v"(dc[3]));
                }
                __builtin_amdgcn_sched_barrier(0);
                dc = dn;
            }
            if (kt == qt) {
#pragma unroll
                for (int r = 0; r < 4; ++r) if (4 * fq + r > fr) sc[r] = -__builtin_inff();
            }
            unsigned x0 = __builtin_bit_cast(unsigned, __builtin_amdgcn_cvt_pkrtz(sc[0], sc[1]));
            unsigned x1 = __builtin_bit_cast(unsigned, __builtin_amdgcn_cvt_pkrtz(sc[2], sc[3]));
            x0 ^= (((x0 >> 15) & 0x00010001u) * 0xFFFFu) | 0x80008000u; x1 ^= (((x1 >> 15) & 0x00010001u) * 0xFFFFu) | 0x80008000u;
            u32x2 o; o.x = (x0 >> 1) & 0x7FFF7FFFu; o.y = (x1 >> 1) & 0x7FFF7FFFu;
            *(u32x2*)(smem + fr * RS + (kt * 16 + 4 * fq) * 2) = o;
#if IX_HIST & 2
            {
                unsigned* hq = hist + fr * HS;
                unsigned one;
                asm volatile("v_mov_b32 %0, 1" : "=v"(one));
                __hip_atomic_fetch_add(hq + ((o.x >> 7) & 0xFFu), one, __ATOMIC_RELAXED, __HIP_MEMORY_SCOPE_WORKGROUP);
                __hip_atomic_fetch_add(hq + (o.x >> 23), one, __ATOMIC_RELAXED, __HIP_MEMORY_SCOPE_WORKGROUP);
                __hip_atomic_fetch_add(hq + ((o.y >> 7) & 0xFFu), one, __ATOMIC_RELAXED, __HIP_MEMORY_SCOPE_WORKGROUP);
                __hip_atomic_fetch_add(hq + (o.y >> 23), one, __ATOMIC_RELAXED, __HIP_MEMORY_SCOPE_WORKGROUP);
            }
#endif
        }
        }
    }
    __syncthreads();
    unsigned short* stage = (unsigned short*)(smem + LDS_STAGE + wid * 512);
    for (int rr = 0; rr < (PROBE_SUB == 2 ? 4 : 2); ++rr) {
        const int qi = wid * 2 + (rr & 1);
        const unsigned char* rowp = smem + qi * RS;
        const int nch = nkt * 4;
        const int nsl = __builtin_amdgcn_readfirstlane((nch + 63) >> 6);
        unsigned kreg[32];
#pragma unroll
        for (int i = 0; i < 16; ++i) {
            const int c = lane + 64 * i;
            const u32x2 v = *(const u32x2*)(rowp + c * 8);
            const bool ok = c < nch;
            kreg[2 * i] = ok ? v.x : 0u; kreg[2 * i + 1] = ok ? v.y : 0u;
        }
        unsigned T;
        {
            const unsigned* hp = hist + qi * HS + lane * 4;
            u32x4 hv; hv.x = hp[0]; hv.y = hp[1]; hv.z = hp[2]; hv.w = hp[3];
            const unsigned s4 = (hv.x + hv.y) + (hv.z + hv.w);
            const unsigned pin = (unsigned)wave_iscan_i((int)s4);
            const unsigned tot = (unsigned)__builtin_amdgcn_readlane((int)pin, 63);
            const unsigned above = tot - pin;
            const unsigned long long mk = __builtin_amdgcn_ballot_w64(above + s4 >= (unsigned)TOPK);
            const int L = 63 - __builtin_clzll(mk);
            const unsigned a3 = above + hv.w, a2 = a3 + hv.z, a1 = a2 + hv.y;
            const unsigned bo = a3 >= (unsigned)TOPK ? 3u : (a2 >= (unsigned)TOPK ? 2u : (a1 >= (unsigned)TOPK ? 1u : 0u));
            T = ((unsigned)(4 * L) + (unsigned)__builtin_amdgcn_readlane((int)bo, L)) << 7;
#if IX_CHECK & 1
            if (tot != (unsigned)(16 * nkt)) *(unsigned short*)(p.ws + WS_H16) = 0x7FC0;
#endif
        }
        const int ngr = nsl > 12 ? 16 : (nsl > 8 ? 12 : 8);
        const int ntot = ngr * 256;
#define IX_G4(B, g) { B(4 * (g)) B(4 * (g) + 1) B(4 * (g) + 2) B(4 * (g) + 3) }
#define IX_SW(B) { IX_G4(B, 0) IX_G4(B, 1) if (nsl > 8) { asm volatile(""); IX_G4(B, 2) if (nsl > 12) { asm volatile(""); IX_G4(B, 3) } } }
#define IX_SAD(i) { f0 = __builtin_amdgcn_sad_u16(kreg[2 * (i)], c0, f0); f1 = __builtin_amdgcn_sad_u16(kreg[2 * (i)], c1, f1); \
                    f0 = __builtin_amdgcn_sad_u16(kreg[2 * (i) + 1], c0, f0); f1 = __builtin_amdgcn_sad_u16(kreg[2 * (i) + 1], c1, f1); }
#pragma unroll 1
        for (int bit = 6; bit >= 0; --bit) {
            const unsigned cand = T | (1u << bit);
            const unsigned c1 = cand * 0x10001u, c0 = (cand - 1u) * 0x10001u;
            unsigned f0 = 0, f1 = 0;
            IX_SW(IX_SAD)
            const int dsum = __builtin_amdgcn_readlane(wave_iscan_i((int)f0 - (int)f1), 63);
            if (ntot + dsum >= 2 * TOPK) T = cand;
        }
        unsigned cg, ce;
        {
            const unsigned c0 = (T - 1u) * 0x10001u, c1 = T * 0x10001u, c2 = (T + 1u) * 0x10001u;
            unsigned f0 = 0, f1 = 0, f2 = 0;
#define IX_SAD3(i) { f0 = __builtin_amdgcn_sad_u16(kreg[2 * (i)], c0, f0); f1 = __builtin_amdgcn_sad_u16(kreg[2 * (i)], c1, f1); f2 = __builtin_amdgcn_sad_u16(kreg[2 * (i)], c2, f2); \
                     f0 = __builtin_amdgcn_sad_u16(kreg[2 * (i) + 1], c0, f0); f1 = __builtin_amdgcn_sad_u16(kreg[2 * (i) + 1], c1, f1); f2 = __builtin_amdgcn_sad_u16(kreg[2 * (i) + 1], c2, f2); }
            IX_SW(IX_SAD3)
            cg = (unsigned)(ngr * 4 + (int)f1 - (int)f2) >> 1;
            ce = ((unsigned)(ngr * 4 + (int)f0 - (int)f1) >> 1) - cg;
        }
        const unsigned cgt = wave_sum_u(cg);
        unsigned pg = wave_excl_scan(cg, lane);
        unsigned pe = wave_excl_scan(ce, lane);
        const unsigned need = (unsigned)TOPK - cgt;
        const unsigned didx = (unsigned)((LDS_DUMMY + wid * 256) - (LDS_STAGE + wid * 512)) / 2u + 2u * (unsigned)lane;
#define IX_PUT(i) { _Pragma("unroll") for (int e = 0; e < 4; ++e) { \
                    const unsigned w2 = kreg[2 * (i) + (e >> 1)]; const unsigned k15 = (e & 1) ? (w2 >> 16) : (w2 & 0xFFFFu); \
                    const bool gt = k15 > T, eq = k15 == T; \
                    const unsigned te = eq ? pe : ~0u; \
                    const unsigned ix = gt ? pg : (te < need ? cgt + pe : didx); \
                    stage[ix] = (unsigned short)(lane * 4 + (i) * 256 + e); \
                    pg += gt ? 1u : 0u; pe += eq ? 1u : 0u; } }
        IX_SW(IX_PUT)
#undef IX_SAD3
#undef IX_PUT
#undef IX_SW
#undef IX_G4
#undef IX_SAD
        asm volatile("s_waitcnt lgkmcnt(0)" ::: "memory");
        const u32x2 o = *(const u32x2*)(stage + lane * 4);
        *(u32x2*)(idxg + (rowb + q0 + qi) * TOPK + lane * 4) = o;
        asm volatile("s_waitcnt lgkmcnt(0)" ::: "memory");
    }
}
}

namespace bt {
constexpr int BUF_BYTES = 32 * 256;
constexpr int WAVE_BYTES = 2 * BUF_BYTES;
constexpr int LDS_IST = 8 * WAVE_BYTES;
constexpr int LDS_LUT = LDS_IST + 8 * 512;
typedef int v2i __attribute__((ext_vector_type(2)));
__device__ __forceinline__ int swz(int k) { return (k & 15) ^ (8 * (k >> 4)); }
__device__ void battn_rows(const Params& p, unsigned char* smem) {
    const int tid = opaque_tid(), wid = tid >> 6, lane = tid & 63, hh = lane & 15, kg = lane >> 4;
    const bool hv = hh < 6;
    const bf16_t* qb = (const bf16_t*)(p.ws + WS_QB);
    const unsigned char* ckv8 = p.ws + WS_CKVN;
    const unsigned short* idxg = (const unsigned short*)(p.ws + WS_IDX);
    bf16_t* mix = (bf16_t*)(p.ws + WS_MIX);
    unsigned char* cs = smem + wid * WAVE_BYTES;
    const unsigned csa = (unsigned)__builtin_amdgcn_readfirstlane((int)(unsigned)(size_t)(LAS unsigned char*)cs);
    unsigned short* ist = (unsigned short*)(smem + LDS_IST + wid * 512);
    float* lut = (float*)(smem + LDS_LUT);
    __syncthreads();
    for (int e = tid; e < 6 * 128; e += NTHREADS) lut[e] = ((const float*)(p.ws + WS_LUT))[6 * 128 + e];
    __syncthreads();
    const float* lrow = lut + (hv ? hh : 0) * 128;
    const int qk0 = hh * 256 + 8 * (kg & 1), qk1 = (16 + hh) * 256 + 8 * (kg & 1), qs0 = swz(hh), qs1 = swz(16 + hh), qc = kg >> 1;
    const int tq = hh >> 1, tkey = tq < 4 ? 4 * kg + tq : 16 + 4 * kg + (tq - 4), tr0 = tkey * 256 + 8 * (hh & 1), ts = swz(tkey);
    const int dsub = lane >> 4, dpos = lane & 15;
    unsigned lp[8];
#pragma unroll
    for (int i = 0; i < 8; ++i) lp[i] = (unsigned)((dpos ^ swz(4 * i + dsub)) * 16);
    const unsigned ista = (unsigned)(size_t)(LAS unsigned short*)ist;
    const unsigned idma = ista + 2u * (unsigned)dsub, ibia = ista + 8u * (unsigned)kg;
    unsigned aq0[8], aq1[8], av[16];
#pragma unroll
    for (int ks = 0; ks < 8; ++ks) { aq0[ks] = csa + (unsigned)(qk0 + (((2 * ks + qc) ^ qs0) << 4)); aq1[ks] = csa + (unsigned)(qk1 + (((2 * ks + qc) ^ qs1) << 4)); }
#pragma unroll
    for (int d = 0; d < 16; ++d) av[d] = csa + (unsigned)(tr0 + ((d ^ ts) << 4));
    for (int row = blockIdx.x * 8 + wid; row < MTOK; row += gridDim.x * 8) {
        const int t = row & (SEQ - 1);
        const size_t rowb = (size_t)(row - t);
        const int nvalid = __builtin_amdgcn_readfirstlane(t + 1 < TOPK ? t + 1 : TOPK);
        const int nchunks = __builtin_amdgcn_readfirstlane((nvalid + 31) >> 5);
        *(u32x2*)(ist + lane * 4) = *(const u32x2*)(idxg + (size_t)row * TOPK + lane * 4);
        long qlf[8];
#pragma unroll
        for (int ks = 0; ks < 8; ++ks) {
            u32x4 qv = {0u, 0u, 0u, 0u};
            if (hv) qv = *(const u32x4*)(qb + (size_t)row * NQB + hh * 256 + ks * 32 + kg * 8);
            int lo = __builtin_amdgcn_cvt_pk_fp8_f32(bflo(qv.x) * 16.f, bfhi(qv.x) * 16.f, 0, false); lo = __builtin_amdgcn_cvt_pk_fp8_f32(bflo(qv.y) * 16.f, bfhi(qv.y) * 16.f, lo, true);
            int hi2 = __builtin_amdgcn_cvt_pk_fp8_f32(bflo(qv.z) * 16.f, bfhi(qv.z) * 16.f, 0, false); hi2 = __builtin_amdgcn_cvt_pk_fp8_f32(bflo(qv.w) * 16.f, bfhi(qv.w) * 16.f, hi2, true);
            qlf[ks] = (long)(((unsigned long long)(unsigned)hi2 << 32) | (unsigned)lo);
        }
        f32x4 O[16];
#pragma unroll
        for (int d = 0; d < 16; ++d) O[d] = (f32x4){0.f, 0.f, 0.f, 0.f};
        float m = -1e30f, lsum = 0.f;
        unsigned long long gb;
        {
            const unsigned long long ga = (unsigned long long)(size_t)(ckv8 + rowb * 256);
            gb = ((unsigned long long)(unsigned)__builtin_amdgcn_readfirstlane((int)(unsigned)(ga >> 32)) << 32) | (unsigned)__builtin_amdgcn_readfirstlane((int)(unsigned)ga);
        }
#define BT_DMA(c, ldsa) do { unsigned ia_ = idma + (unsigned)(c) * 64u; asm volatile("" : "+v"(ia_)); unsigned o_[8]; \
            _Pragma("unroll") for (int i_ = 0; i_ < 8; ++i_) o_[i_] = (unsigned)*(const LAS unsigned short*)(size_t)(ia_ + 8u * i_); \
            __builtin_amdgcn_s_waitcnt(0xC07F);                   \
            _Pragma("unroll") for (int i_ = 0; i_ < 8; ++i_) o_[i_] = (o_[i_] << 8) + lp[i_]; \
            unsigned sv_; \
            asm volatile("s_mov_b32 %0, m0\n\ts_mov_b32 m0, %10\n\ts_nop 0\n\tglobal_load_lds_dwordx4 %1, %9\n\t" \
                         "s_add_u32 m0, m0, 0x400\n\ts_nop 0\n\tglobal_load_lds_dwordx4 %2, %9\n\t" \
                         "s_add_u32 m0, m0, 0x400\n\ts_nop 0\n\tglobal_load_lds_dwordx4 %3, %9\n\t" \
                         "s_add_u32 m0, m0, 0x400\n\ts_nop 0\n\tglobal_load_lds_dwordx4 %4, %9\n\t" \
                         "s_add_u32 m0, m0, 0x400\n\ts_nop 0\n\tglobal_load_lds_dwordx4 %5, %9\n\t" \
                         "s_add_u32 m0, m0, 0x400\n\ts_nop 0\n\tglobal_load_lds_dwordx4 %6, %9\n\t" \
                         "s_add_u32 m0, m0, 0x400\n\ts_nop 0\n\tglobal_load_lds_dwordx4 %7, %9\n\t" \
                         "s_add_u32 m0, m0, 0x400\n\ts_nop 0\n\tglobal_load_lds_dwordx4 %8, %9\n\t" \
                         "s_mov_b32 m0, %0" \
                         : "=&s"(sv_) : "v"(o_[0]), "v"(o_[1]), "v"(o_[2]), "v"(o_[3]), "v"(o_[4]), "v"(o_[5]), "v"(o_[6]), "v"(o_[7]), "s"(gb), "s"((unsigned)(ldsa)) : "memory", "scc"); } while (0)
        asm volatile("s_waitcnt vmcnt(0) lgkmcnt(0)" ::: "memory");
        BT_DMA(0, csa);
        float bnx[8];
#define BT_BIAS(c) do { unsigned ib_ = ibia + (unsigned)(c) * 64u; asm volatile("" : "+v"(ib_)); \
            _Pragma("unroll") for (int tt_ = 0; tt_ < 2; ++tt_) { const int slot0_ = (c) * 32 + tt_ * 16 + 4 * kg; const u32x2 iv_ = *(const LAS u32x2*)(size_t)(ib_ + 32u * tt_); \
            const unsigned ids_[4] = {iv_.x & 0xFFFFu, iv_.x >> 16, iv_.y & 0xFFFFu, iv_.y >> 16}; \
            _Pragma("unroll") for (int r_ = 0; r_ < 4; ++r_) { int dd_ = t - (int)ids_[r_]; dd_ = dd_ < 0 ? 0 : (dd_ > 127 ? 127 : dd_); \
                bnx[tt_ * 4 + r_] = lrow[dd_]; } } \
            if (nvalid < TOPK) {                                      \
                _Pragma("unroll") for (int e_ = 0; e_ < 8; ++e_) bnx[e_] = ((c) * 32 + (e_ >> 2) * 16 + 4 * kg + (e_ & 3) < nvalid) ? bnx[e_] : -__builtin_inff(); } } while (0)
        BT_BIAS(0);
#define BT_CHUNK(c, B) { \
            if ((c) + 1 < nchunks) { BT_DMA((c) + 1, csa + (1 - (B)) * BUF_BYTES); asm volatile("s_waitcnt vmcnt(8)" ::: "memory"); } \
            else asm volatile("s_waitcnt vmcnt(0)" ::: "memory"); \
            long af[16]; v2i vf[16]; \
            _Pragma("unroll") for (int ks = 0; ks < 8; ++ks) { \
                af[ks]     = *(const LAS long*)(size_t)(aq0[ks] + (B) * BUF_BYTES); \
                af[8 + ks] = *(const LAS long*)(size_t)(aq1[ks] + (B) * BUF_BYTES); } \
            __builtin_amdgcn_sched_barrier(0); \
            __builtin_amdgcn_s_waitcnt(0xC07F); \
            f32x4 s0 = {0.f, 0.f, 0.f, 0.f}, s1 = {0.f, 0.f, 0.f, 0.f}; \
            _Pragma("unroll") for (int ks = 0; ks < 8; ++ks) { \
                s0 = __builtin_amdgcn_mfma_f32_16x16x32_fp8_fp8(af[ks], qlf[ks], s0, 0, 0, 0);                \
                s1 = __builtin_amdgcn_mfma_f32_16x16x32_fp8_fp8(af[8 + ks], qlf[ks], s1, 0, 0, 0); } \
            _Pragma("unroll") for (int d = 0; d < 16; ++d) vf[d] = __builtin_amdgcn_ds_read_tr8_b64_v2i32((LAS v2i*)(size_t)(av[d] + (B) * BUF_BYTES));       \
            __builtin_amdgcn_sched_barrier(0); \
            float z[8]; \
            _Pragma("unroll") for (int r = 0; r < 4; ++r) { z[r] = fmaf(s0[r], LOG2E * (1.0f / 16.0f), bnx[r]); z[4 + r] = fmaf(s1[r], LOG2E * (1.0f / 16.0f), bnx[4 + r]); }       \
            BT_BIAS((c) + 1); \
            float pmax = fmaxf(fmaxf(fmaxf(z[0], z[1]), fmaxf(z[2], z[3])), fmaxf(fmaxf(z[4], z[5]), fmaxf(z[6], z[7]))); \
            if (!__all(pmax - m <= 8.0f)) {                             \
                pmax = fmaxf(pmax, __shfl_xor(pmax, 16, 64)); \
                pmax = fmaxf(pmax, __shfl_xor(pmax, 32, 64)); \
                const float mn = fmaxf(m, pmax); \
                const float alpha = fast_exp2(m - mn); \
                m = mn; lsum *= alpha; \
                _Pragma("unroll") for (int d = 0; d < 16; ++d) O[d] = O[d] * alpha; \
            } \
            _Pragma("unroll") for (int r = 0; r < 8; ++r) { z[r] = fast_exp2(z[r] - m); lsum += z[r]; } \
            int plo = __builtin_amdgcn_cvt_pk_fp8_f32(z[0], z[1], 0, false); plo = __builtin_amdgcn_cvt_pk_fp8_f32(z[2], z[3], plo, true); \
            int phi = __builtin_amdgcn_cvt_pk_fp8_f32(z[4], z[5], 0, false); phi = __builtin_amdgcn_cvt_pk_fp8_f32(z[6], z[7], phi, true); \
            const long pf = (long)(((unsigned long long)(unsigned)phi << 32) | (unsigned)plo); \
            __builtin_amdgcn_s_waitcnt(0xC07F); \
            _Pragma("unroll") for (int d = 0; d < 16; ++d) { \
                O[d] = __builtin_amdgcn_mfma_f32_16x16x32_fp8_fp8(__builtin_bit_cast(long, vf[d]), pf, O[d], 0, 0, 0);                     \
            } }
#pragma unroll 1
        for (int c = 0; c < nchunks; c += 2) {
            BT_CHUNK(c, 0)
            if (c + 1 < nchunks) BT_CHUNK(c + 1, 1)
        }
#undef BT_CHUNK
#undef BT_BIAS
#undef BT_DMA
        lsum += __shfl_xor(lsum, 16, 64);
        lsum += __shfl_xor(lsum, 32, 64);
        const float inv = 1.0f / lsum;
        if (hv) {
            bf16_t* orow = (bf16_t*)(p.ws + WS_OLAT) + ((size_t)hh * MTOK + row) * 256 + 4 * kg;
#pragma unroll
            for (int d = 0; d < 16; ++d) {
                u32x2 w; w.x = cvt_pk_bf16(O[d][0] * inv, O[d][1] * inv); w.y = cvt_pk_bf16(O[d][2] * inv, O[d][3] * inv);
                *(u32x2*)(orow + d * 16) = w;
            }
        }
    }
}
}


#define XB_TMO      128
#define XB_XCNT(j)  (256  + 64 * (j))
#define XB_XSUB(j)  (1280 + 64 * (j))
#define XB_XGEN(j)  (2304 + 64 * (j))
#define XB_TOP      3328
#define XB_TOPGEN   3392
#define XCD_BAR_WORDS 3456
#define XB_SPIN_CAP (1u << 18)

__device__ __forceinline__ unsigned xb_ld(unsigned* p)              { return __hip_atomic_load(p, __ATOMIC_RELAXED, __HIP_MEMORY_SCOPE_AGENT); }
__device__ __forceinline__ unsigned xb_add(unsigned* p, unsigned v) { return __hip_atomic_fetch_add(p, v, __ATOMIC_RELAXED, __HIP_MEMORY_SCOPE_AGENT); }
__device__ __forceinline__ unsigned xb_xcc_id() { return (unsigned)__builtin_amdgcn_s_getreg((3 << 11) | 20) & 0xFu; }
#define XB_SPIN(cond, bar) do { unsigned _sp = 0; while (cond) { __builtin_amdgcn_s_sleep(1); \
    if ((++_sp & 255u) == 0u) { if (xb_ld(&(bar)[XB_TMO])) break; if (_sp > XB_SPIN_CAP) { atomicAdd(&(bar)[XB_TMO], 1u); break; } } } } while (0)

struct XcdBarrier {
    unsigned* bar; unsigned x;
    volatile LAS unsigned* st;
};

__device__ __forceinline__ XcdBarrier xcd_barrier_post(unsigned* bar, volatile LAS unsigned* st) {
    XcdBarrier b; b.bar = bar; b.x = xb_xcc_id(); b.st = st;
    if (threadIdx.x == 0) (void)xb_add(&bar[XB_XCNT(b.x)], 1u);
    return b;
}
__device__ __forceinline__ void xcd_barrier_complete(unsigned* bar, unsigned x, unsigned& nloc, unsigned& nx) {
    const unsigned G = gridDim.x * gridDim.y * gridDim.z;
    unsigned sum, cnt, mine, sp = 0u;
    for (;;) {
        sum = 0u; cnt = 0u; mine = 0u;
#pragma unroll
        for (unsigned j = 0; j < 16; ++j) { const unsigned c = xb_ld(&bar[XB_XCNT(j)]); sum += c; cnt += (c > 0u) ? 1u : 0u; mine = (j == x) ? c : mine; }
        if (sum == G) break;
        __builtin_amdgcn_s_sleep(1);
        if ((++sp & 255u) == 0u) { if (xb_ld(&bar[XB_TMO])) break; if (sp > XB_SPIN_CAP) { atomicAdd(&bar[XB_TMO], 1u); break; } }
    }
    nloc = mine > 0u ? mine : 1u; nx = cnt > 0u ? cnt : 1u;
}

__device__ __forceinline__ void xcd_barrier(const XcdBarrier& b) {
    asm volatile("s_waitcnt vmcnt(0)" ::: "memory");
    __syncthreads();
    if (threadIdx.x == 0) {
        unsigned* bar = b.bar;
        __builtin_amdgcn_s_waitcnt(0);
        unsigned nloc = b.st[0], nx = b.st[1];
        if (nloc == 0u) { xcd_barrier_complete(bar, b.x, nloc, nx); b.st[0] = nloc; b.st[1] = nx; }
        const unsigned old = xb_add(&bar[XB_XSUB(b.x)], 1u);
        const unsigned gen = old / nloc;
        if (old + 1u == (gen + 1u) * nloc) {
            __builtin_amdgcn_fence(__ATOMIC_RELEASE, "agent");
            asm volatile("s_waitcnt vmcnt(0)" ::: "memory");
            const unsigned og = xb_add(&bar[XB_TOP], 1u);
            const unsigned tg = og / nx;
            if (og + 1u == (tg + 1u) * nx) xb_add(&bar[XB_TOPGEN], 1u);
            else XB_SPIN(xb_ld(&bar[XB_TOPGEN]) == tg, bar);
            __builtin_amdgcn_fence(__ATOMIC_ACQUIRE, "agent");
            xb_add(&bar[XB_XGEN(b.x)], 1u);
            asm volatile("s_waitcnt vmcnt(0)" ::: "memory");
        } else {
            XB_SPIN(xb_ld(&bar[XB_XGEN(b.x)]) == gen, bar);
            __builtin_amdgcn_fence(__ATOMIC_ACQUIRE, "agent");
            asm volatile("s_waitcnt vmcnt(0)" ::: "memory");
        }
    }
    __syncthreads();
}

enum { PH_W = 0, PH_INPROJ, PH_LAT, PH_QB_A, PH_IDX, PH_BATT, PH_UV, PH_OUT, PH_POST1, PH_XQ, PH_XATT, PH_XO, PH_POST2, PH_GU, PH_DOWN, PH_POST3, NPHASES };

template <int PH>
__device__ __forceinline__ void run_phase(const Params& p, const int l, unsigned char* smem, const int dup = 0) {
    unsigned char* ws = p.ws;
    unsigned* ctl = (unsigned*)(ws + WS_CTL);
    float* ssq = (float*)(ws + WS_SSQ);
    float* ssq_in = ssq + (size_t)(l == 0 ? 0 : 3 * l) * MTOK * 8;
    float* ssq_a = ssq + (size_t)(3 * l + 1) * MTOK * 8;
    float* ssq_b = ssq + (size_t)(3 * l + 2) * MTOK * 8;
    float* ssq_c = ssq + (size_t)(3 * l + 3) * MTOK * 8;
    const bool fused = gridDim.x == 256;
    if constexpr (PH == PH_W) {
        phase_weights(p, l, smem);
    } else if constexpr (PH == PH_INPROJ) {
        const float* rs = ssq_in;
        g8::gemm_phase((const bf16_t*)(ws + WS_H16), (const bf16_t*)(ws + W_IN), MTOK, OFF_KIDX, DM, g8::EpiBf16{(bf16_t*)(ws + WS_PROJ), NPROJ, 1 << 30, rs}, smem);
        g8::gemm_phase((const bf16_t*)(ws + WS_H16), (const bf16_t*)(ws + W_IN) + (size_t)OFF_CU * DM, MTOK, 1024, DM, g8::EpiBf16{(bf16_t*)(ws + WS_PROJ) + OFF_CU, NPROJ, 0, rs}, smem);
    } else if constexpr (PH == PH_LAT) {
        phase_latent_norms(p, l);
    } else if constexpr (PH == PH_QB_A) {
        unsigned* head = ctl + CW_QUEUE + 64 * (l * 8 + 0 + 4 * dup);
        const g8::EpiBf16 epi{(bf16_t*)(ws + WS_QB), NQB, 1 << 30, nullptr};
        const g8::EpiBf16 epik{(bf16_t*)(ws + WS_PROJ) + OFF_KIDX, NPROJ, 1 << 30, ssq_in};
        const g8::EpiBf16 epikv{(bf16_t*)(ws + WS_KVX), 1024, 1 << 30, nullptr};
        constexpr int U_ATT = 768, U_KW = U_ATT + 64, U_KV = U_KW + 16, U_QB = U_KV + 640, U_C = U_QB + 512;
        for (;;) {
            const int u = queue_next(head, smem);
            if (u >= U_C) break;
            if (u < U_ATT) { for (int rep_ = 0; rep_ < (PROBE_SUB == 5 ? 2 : 1); ++rep_) at::attnA_unit(p, u, smem); }
            else if (u < U_KW) { for (int rep_ = 0; rep_ < (PROBE_SUB == 8 ? 2 : 1); ++rep_) g8::gemm_tile((const bf16_t*)(ws + WS_H16), (const bf16_t*)(ws + W_IN) + (size_t)OFF_KIDX * DM, DM, u - U_ATT, 0, epik, smem); }
            else if (u < U_KV) { const int g = u - U_KW; g8::gemm_tile((const bf16_t*)(ws + WS_MEMN), (const bf16_t*)(ws + W_XKV), DM, g >> 2, g & 3, epikv, smem); }
            else if (u < U_QB) { const int g = u - U_KV; for (int rep_ = 0; rep_ < (PROBE_SUB == 6 ? 2 : 1); ++rep_) g8::gemm_tile((const bf16_t*)(ws + WS_CQN), (const bf16_t*)(ws + W_B), 512, g / 10, g % 10, epi, smem); }
            else { for (int rep_ = 0; rep_ < (PROBE_SUB == 7 ? 2 : 1); ++rep_) cbranch_unit(p, l, u - U_QB, smem); }
        }
    } else if constexpr (PH == PH_IDX) {
        unsigned* head = ctl + CW_QUEUE + 64 * (l * 8 + 1 + 4 * dup);
        for (;;) {
            const int u = queue_next(head, smem);
            if (u >= 256 + 1024) break;
            if (u < 256) at::attnA_combine(p, l, u);
            else { const int v = u - 256; for (int rep_ = 0; rep_ < (PROBE_SUB == 9 ? 2 : 1); ++rep_) ix::indexer_unit(p, v & 3, 255 - (v >> 2), smem); }
        }
    } else if constexpr (PH == PH_BATT) {
        bt::battn_rows(p, smem);
    } else if constexpr (PH == PH_UV) {
        for (int u = blockIdx.x; u < 384; u += gridDim.x) {
            const int pm = u & 63, h = u >> 6;
            g8::gemm_tile((const bf16_t*)(ws + WS_OLAT) + (size_t)h * MTOK * 256, (const bf16_t*)(ws + W_UVT) + (size_t)h * 128 * 256, 256, pm, 0,
                          g8::EpiHalfBf16{(bf16_t*)(ws + WS_MIX) + 768 + h * 128, NMIX}, smem);
        }
    } else if constexpr (PH == PH_OUT) {
        if (fused) g8::gemm_post_fused((const bf16_t*)(ws + WS_MIX), (const bf16_t*)(ws + W_OUT), NMIX,
                       g8::EpiFusedPost{(bf16_t*)(ws + WS_H16), nullptr, p.in[4] + (size_t)l * DM, ssq_a, (float*)(ws + WS_XBUF), ctl + CW_PANEL + ((l * 3 + 0) * 64) * 16, ctl + CW_TMO, smem}, smem);
        else g8::gemm_phase((const bf16_t*)(ws + WS_MIX), (const bf16_t*)(ws + W_OUT), MTOK, DM, NMIX, g8::EpiBf16{(bf16_t*)(ws + WS_TMP), DM, 1 << 30, nullptr}, smem);
    } else if constexpr (PH == PH_POST1) {
        phase_post((const bf16_t*)(ws + WS_TMP), l == 0 ? p.in[0] : nullptr, (bf16_t*)(ws + WS_H16), nullptr, p.in[4] + (size_t)l * DM, ssq_a);
    } else if constexpr (PH == PH_XQ) {
        unsigned* chead = ctl + CW_QUEUE + 64 * (l * 8 + 2 + 4 * dup);
        if ((int)blockIdx.x >= 128) for (;;) { const int u = queue_next(chead, smem); if (u >= 528) break; conv_run(p, l, NCONV_EARLY, NCONV, u * 4, 1, 4, opaque_tid()); }
        g8::gemm_phase((const bf16_t*)(ws + WS_H16), (const bf16_t*)(ws + W_XQ), MTOK, 512, DM, g8::EpiBf16{(bf16_t*)(ws + WS_XQ), 512, 1 << 30, ssq_a}, smem);
        if ((int)blockIdx.x < 128) for (;;) { const int u = queue_next(chead, smem); if (u >= 528) break; conv_run(p, l, NCONV_EARLY, NCONV, u * 4, 1, 4, opaque_tid()); }
    } else if constexpr (PH == PH_XATT) {
        for (int u = blockIdx.x; u < 256; u += gridDim.x) at::attnX_unit(p, u, smem);
    } else if constexpr (PH == PH_XO) {
        if (fused) g8::gemm_post_fused((const bf16_t*)(ws + WS_XO), (const bf16_t*)(ws + W_XO), 512,
                       g8::EpiFusedPost{(bf16_t*)(ws + WS_H16), nullptr, p.in[20] + (size_t)l * DM, ssq_b, (float*)(ws + WS_XBUF), ctl + CW_PANEL + ((l * 3 + 1) * 64) * 16, ctl + CW_TMO, smem}, smem);
        else g8::gemm_phase((const bf16_t*)(ws + WS_XO), (const bf16_t*)(ws + W_XO), MTOK, DM, 512, g8::EpiBf16{(bf16_t*)(ws + WS_TMP), DM, 1 << 30, nullptr}, smem);
    } else if constexpr (PH == PH_POST2) {
        phase_post((const bf16_t*)(ws + WS_TMP), nullptr, (bf16_t*)(ws + WS_H16), nullptr, p.in[20] + (size_t)l * DM, ssq_b);
    } else if constexpr (PH == PH_GU) {
        g8::gemm_phase((const bf16_t*)(ws + WS_H16), (const bf16_t*)(ws + W_GU), MTOK, 2 * FH, DM, g8::EpiSwiglu{(bf16_t*)(ws + WS_FFH), ssq_b}, smem);
    } else if constexpr (PH == PH_DOWN) {
        if (fused) g8::gemm_post_fused((const bf16_t*)(ws + WS_FFH), (const bf16_t*)(ws + W_DOWN), FH,
                       g8::EpiFusedPost{(bf16_t*)(ws + WS_H16), l + 1 < DEPTH ? nullptr : p.out, p.in[26] + (size_t)l * DM, ssq_c, (float*)(ws + WS_XBUF), ctl + CW_PANEL + ((l * 3 + 2) * 64) * 16, ctl + CW_TMO, smem}, smem);
        else g8::gemm_phase((const bf16_t*)(ws + WS_FFH), (const bf16_t*)(ws + W_DOWN), MTOK, DM, FH, g8::EpiBf16{(bf16_t*)(ws + WS_TMP), DM, 1 << 30, nullptr}, smem);
    } else if constexpr (PH == PH_POST3) {
        phase_post((const bf16_t*)(ws + WS_TMP), nullptr, (bf16_t*)(ws + WS_H16), l + 1 < DEPTH ? nullptr : p.out, p.in[26] + (size_t)l * DM, ssq_c);
    }
}

template <int PH>
__global__ void __launch_bounds__(NTHREADS, 2) k_phase(Params p) {
    extern __shared__ __attribute__((aligned(16))) unsigned char smem[];
    run_phase<PH>(p, p.layer, smem);
}

__global__ void __launch_bounds__(NTHREADS, 2) k_forward(Params p) {
    extern __shared__ __attribute__((aligned(16))) unsigned char smem[];
    if (threadIdx.x == 0) *(uint4*)(smem + LDS_CTL) = make_uint4(0u, 0u, 0u, 0u);
    __syncthreads();
    const XcdBarrier bar = xcd_barrier_post((unsigned*)(p.ws + WS_CTL) + CW_BAR, (volatile LAS unsigned*)(smem + LDS_CTL));
#define RUN(PH) do { run_phase<PH>(p, l, smem); xcd_barrier(bar); if (PROBE_DUP == PH) { run_phase<PH>(p, l, smem, 1); xcd_barrier(bar); } } while (0)
    for (int l = 0; l < DEPTH; ++l) {
        const bool fusedp = gridDim.x == 256;
        RUN(PH_W); RUN(PH_INPROJ); RUN(PH_LAT); RUN(PH_QB_A); RUN(PH_IDX); RUN(PH_BATT); RUN(PH_UV); RUN(PH_OUT); if (!fusedp) RUN(PH_POST1);
        RUN(PH_XQ); RUN(PH_XATT); RUN(PH_XO); if (!fusedp) RUN(PH_POST2); RUN(PH_GU); RUN(PH_DOWN); if (!fusedp) RUN(PH_POST3);
    }
#undef RUN
}

template <int PH>
static void launch_phase(Params& p, int grid, hipStream_t stream) {
    static bool attr = false;
    if (!attr) { (void)hipFuncSetAttribute((const void*)k_phase<PH>, hipFuncAttributeMaxDynamicSharedMemorySize, LDS_BYTES); attr = true; }
    hipLaunchKernelGGL(k_phase<PH>, dim3(grid), dim3(NTHREADS), LDS_BYTES, stream, p);
}

extern "C" void kernel_launch(void* const* d_in, const int* in_sizes, int n_in, void* d_out, int out_size, void* d_ws, size_t ws_size, hipStream_t stream) {
    if (n_in != 29 || out_size != MTOK * DM || ws_size < WS_END) {
        fprintf(stderr, "kernel_launch: unexpected problem (n_in %d, out %d, ws %zu, need %zu); nothing launched\n", n_in, out_size, ws_size, (size_t)WS_END);
        return;
    }
    static int grid = 0;
    if (!grid) {
        int dev = 0, cus = 0; (void)hipGetDevice(&dev); (void)hipDeviceGetAttribute(&cus, hipDeviceAttributeMultiprocessorCount, dev); grid = cus > 0 ? cus : 256;
#if MK_ONE_LAUNCH
        if (hipFuncSetAttribute((const void*)k_forward, hipFuncAttributeMaxDynamicSharedMemorySize, LDS_BYTES) != hipSuccess) { fprintf(stderr, "kernel_launch: hipFuncSetAttribute failed\n"); grid = -1; }
        int per_cu = 0;
        if (grid > 0 && (hipOccupancyMaxActiveBlocksPerMultiprocessor(&per_cu, (const void*)k_forward, NTHREADS, LDS_BYTES) != hipSuccess || per_cu < 1)) {
            fprintf(stderr, "kernel_launch: occupancy query reports %d workgroups per CU; nothing launched\n", per_cu); grid = -1; }
        (void)hipGetLastError();
#endif
    }
    if (grid < 0) return;
    (void)hipMemsetAsync((char*)d_ws + WS_CTL, 0, ZERO_BYTES, stream);
    Params p{};
    for (int i = 0; i < 29; ++i) p.in[i] = (const float*)d_in[i];
    p.out = (float*)d_out; p.ws = (unsigned char*)d_ws; p.layer = 0; p.phase = 0;
#if MK_ONE_LAUNCH
    hipLaunchKernelGGL(k_forward, dim3(grid), dim3(NTHREADS), LDS_BYTES, stream, p);
#else
    for (int l = 0; l < DEPTH; ++l) {
        p.layer = l;
        launch_phase<PH_W>(p, grid, stream);
        launch_phase<PH_INPROJ>(p, grid, stream);
        launch_phase<PH_LAT>(p, grid, stream);
        launch_phase<PH_QB_A>(p, grid, stream);
        launch_phase<PH_IDX>(p, grid, stream);
        launch_phase<PH_BATT>(p, grid, stream);
        launch_phase<PH_UV>(p, grid, stream);
        launch_phase<PH_OUT>(p, grid, stream);
        launch_phase<PH_POST1>(p, grid, stream);
        launch_phase<PH_XQ>(p, grid, stream);
        launch_phase<PH_XATT>(p, grid, stream);
        launch_phase<PH_XO>(p, grid, stream);
        launch_phase<PH_POST2>(p, grid, stream);
        launch_phase<PH_GU>(p, grid, stream);
        launch_phase<PH_DOWN>(p, grid, stream);
        launch_phase<PH_POST3>(p, grid, stream);
    }
#endif
}
```

```cpp
#include <hip/hip_runtime.h>
#include <stdint.h>
#include <stdio.h>

#ifndef PROBE_DUP
#define PROBE_DUP -1
#endif
#ifndef PROBE_SUB
#define PROBE_SUB 0
#endif
#ifndef IX_HIST
#define IX_HIST 3
#endif
#ifndef IX_CHECK
#define IX_CHECK 0
#endif
#ifndef PROBE_CHK
#define PROBE_CHK 0
#endif
#ifndef MK_ONE_LAUNCH
#define MK_ONE_LAUNCH 1
#endif

#define LAS __attribute__((address_space(3)))
typedef unsigned short bf16_t;
typedef short bf16x8 __attribute__((ext_vector_type(8)));
typedef short s16x4 __attribute__((ext_vector_type(4)));
typedef float f32x4 __attribute__((ext_vector_type(4)));
typedef float f32x16 __attribute__((ext_vector_type(16)));
typedef unsigned u32x4 __attribute__((ext_vector_type(4)));
typedef unsigned u32x2 __attribute__((ext_vector_type(2)));

constexpr int DM = 2048, NBATCH = 4, SEQ = 4096, MTOK = NBATCH * SEQ, DEPTH = 2;
constexpr int IN_COLS = 4176, NPROJ = 4352;
constexpr int OFF_QA = 0, OFF_KA = 768, OFF_VA = 1536, OFF_CQ = 2304, OFF_CKV = 2816, OFF_KIDX = 3072, OFF_WIDX = 3136, OFF_CU = 3328, OFF_CV = 3840;
constexpr int NQB = 2560;
constexpr int NMIX = 2048;
constexpr int FH = 5632;
constexpr int MEMLEN = 256, MEMROWS = NBATCH * MEMLEN;
constexpr int TOPK = 256;
constexpr float EPS = 1e-6f;
constexpr float LOG2E = 1.4426950408889634f;

constexpr int NTHREADS = 512;
constexpr int LDS_BYTES = 155648;
constexpr int LDS_CTL = LDS_BYTES - 256;

constexpr size_t alignup(size_t x) { return (x + 255) & ~(size_t)255; }
constexpr size_t WS_CTL = 0;
constexpr size_t CTL_BYTES = 65536;
constexpr int NSSQ = 1 + 3 * DEPTH;
constexpr size_t ZERO_BYTES = CTL_BYTES;
constexpr size_t WS_SSQ = WS_CTL + CTL_BYTES;
constexpr size_t WS_LUT = WS_SSQ + (size_t)NSSQ * MTOK * 8 * 4;
constexpr size_t WS_LAM = WS_LUT + 12 * 128 * 4;
constexpr size_t WS_XBUF = alignup(WS_LAM + 256);
constexpr size_t WS_W = WS_XBUF + (size_t)64 * 256 * 8 * 4;
constexpr size_t W_IN = WS_W;
constexpr size_t W_B = W_IN + (size_t)NPROJ * DM * 2;
constexpr size_t W_OUT = W_B + (size_t)NQB * 512 * 2;
constexpr size_t W_XQ = W_OUT + (size_t)DM * NMIX * 2;
constexpr size_t W_XKV = W_XQ + (size_t)512 * DM * 2;
constexpr size_t W_XO = W_XKV + (size_t)1024 * DM * 2;
constexpr size_t W_GU = W_XO + (size_t)DM * 512 * 2;
constexpr size_t W_DOWN = W_GU + (size_t)2 * FH * DM * 2;
constexpr size_t W_UVT = W_DOWN + (size_t)DM * FH * 2;
constexpr size_t WS_MEMN = W_UVT + (size_t)(768 + 128) * 256 * 2;
constexpr size_t WS_KVX = WS_MEMN + (size_t)MEMROWS * DM * 2;
constexpr size_t WS_H16 = alignup(WS_KVX + (size_t)MEMROWS * 1024 * 2);
constexpr size_t WS_RSTD = WS_H16 + (size_t)MTOK * DM * 2;
constexpr size_t WS_CQN = WS_RSTD + (size_t)MTOK * 4;
constexpr size_t WS_CKVN = WS_CQN + (size_t)MTOK * 512 * 2;
constexpr size_t WS_R1 = WS_CKVN + (size_t)MTOK * 256 * 2;
constexpr size_t WS_PROJ = WS_R1, WS_TMP = WS_R1, WS_OLAT = WS_R1;
constexpr size_t WS_R2 = WS_R1 + (size_t)MTOK * NPROJ * 2;
constexpr size_t WS_QB = WS_R2;
constexpr size_t WS_MIX = WS_QB + (size_t)MTOK * NQB * 2;
constexpr size_t WS_IDX = WS_MIX + (size_t)MTOK * NMIX * 2;
constexpr size_t WS_FFH = WS_R2;
constexpr size_t WS_XQ = WS_R2;
constexpr size_t WS_XO = WS_XQ + (size_t)MTOK * 512 * 2;
constexpr size_t WS_CSTAT = WS_IDX + (size_t)MTOK * TOPK * 2;
constexpr size_t WS_END_A = WS_CSTAT + (size_t)MTOK * 8, WS_END_B = WS_FFH + (size_t)MTOK * FH * 2;
constexpr size_t WS_END = WS_END_A > WS_END_B ? WS_END_A : WS_END_B;
static_assert((size_t)MTOK * DM * 4 <= (size_t)MTOK * NPROJ * 2, "tmp overlay");

constexpr int CW_QUEUE = 0;
constexpr int NQUEUES = 64;
constexpr int CW_BAR = 64 * NQUEUES;
constexpr int CW_PANEL = 8192;
constexpr int CW_TMO = CW_PANEL + DEPTH * 3 * 64 * 16;
static_assert((size_t)(CW_TMO + 16) * 4 <= 65536, "control area");

struct Params {
    const float* in[29];
    float* out;
    unsigned char* ws;
    int layer, phase;
};

__device__ __forceinline__ unsigned cvt_pk_bf16(float lo, float hi) { unsigned r; asm("v_cvt_pk_bf16_f32 %0, %1, %2" : "=v"(r) : "v"(lo), "v"(hi)); return r; }
__device__ __forceinline__ float bf2f(unsigned v) { return __uint_as_float(v << 16); }
__device__ __forceinline__ float bflo(unsigned w) { return __uint_as_float(w << 16); }
__device__ __forceinline__ float bfhi(unsigned w) { return __uint_as_float(w & 0xffff0000u); }
__device__ __forceinline__ bf16_t f2bf(float f) { return (bf16_t)(cvt_pk_bf16(f, 0.f) & 0xffffu); }
#define DPP_I(v, ctrl, rmask, bc) __builtin_amdgcn_update_dpp(0, (v), (ctrl), (rmask), 0xF, (bc))
__device__ __forceinline__ int wave_iscan_i(int v) {
    v += DPP_I(v, 0x111, 0xF, true); v += DPP_I(v, 0x112, 0xF, true); v += DPP_I(v, 0x114, 0xF, true); v += DPP_I(v, 0x118, 0xF, true);
    v += DPP_I(v, 0x142, 0xA, false); v += DPP_I(v, 0x143, 0xC, false);
    return v;
}
__device__ __forceinline__ float wave_sum(float v) {
    v += __int_as_float(DPP_I(__float_as_int(v), 0x111, 0xF, true)); v += __int_as_float(DPP_I(__float_as_int(v), 0x112, 0xF, true));
    v += __int_as_float(DPP_I(__float_as_int(v), 0x114, 0xF, true)); v += __int_as_float(DPP_I(__float_as_int(v), 0x118, 0xF, true));
    v += __int_as_float(DPP_I(__float_as_int(v), 0x142, 0xA, false)); v += __int_as_float(DPP_I(__float_as_int(v), 0x143, 0xC, false));
    return __int_as_float(__builtin_amdgcn_readlane(__float_as_int(v), 63));
}
__device__ __forceinline__ float fast_exp2(float x) { return __builtin_amdgcn_exp2f(x); }
__device__ __forceinline__ float fast_rcp(float x) { return __builtin_amdgcn_rcpf(x); }
__device__ __forceinline__ float gelu_tanh(float x) {
    const float u = x * (1.0f + 0.044715f * x * x) * (2.0f * 0.7978845608028654f);
    return x * fast_rcp(1.0f + fast_exp2(-u * LOG2E));
}
__device__ __forceinline__ float silu(float x) { return x * fast_rcp(1.0f + fast_exp2(-x * LOG2E)); }

__device__ __forceinline__ int opaque_tid() { int t = threadIdx.x; asm volatile("" : "+v"(t)); return t; }

__device__ __forceinline__ void glds16(const void* gsrc, unsigned lds_dst) {
    unsigned keep;
    asm volatile("s_mov_b32 %0, m0\n\ts_mov_b32 m0, %2\n\ts_nop 0\n\tglobal_load_lds_dwordx4 %1, off\n\ts_mov_b32 m0, %0" : "=&s"(keep) : "v"(gsrc), "s"(lds_dst) : "memory");
}

__device__ __forceinline__ int queue_next(unsigned* head, unsigned char* smem) {
    volatile LAS unsigned* slot = (volatile LAS unsigned*)(smem + LDS_CTL + 64);
    __syncthreads();
    if (threadIdx.x == 0) *slot = __hip_atomic_fetch_add(head, 1u, __ATOMIC_RELAXED, __HIP_MEMORY_SCOPE_AGENT);
    __syncthreads();
    return (int)*slot;
}

namespace g8 {
constexpr int BM = 256, BK = 64, HALF = 128, HT = HALF * BK;
__device__ __forceinline__ int lds_byte(int r, int c) { const int st = (r >> 4) * 2 + (c >> 5), rr = r & 15, cc = c & 31, ob = rr * 64 + cc * 2; return st * 1024 + (ob ^ (((ob >> 9) & 1) << 5)); }
__device__ __forceinline__ void stage_rc(int b, int& R, int& C) { const int st = b / 1024, sb = b % 1024, swz = sb ^ (((sb >> 9) & 1) << 5); R = (st >> 1) * 16 + swz / 64; C = (st & 1) * 32 + (swz % 64) / 2; }

template <class Epi>
__device__ __forceinline__ void gemm_tile(const bf16_t* __restrict__ A, const bf16_t* __restrict__ Bt, const int K, const int pm, const int pn, const Epi& epi, unsigned char* smem) {
    bf16_t* shm = (bf16_t*)smem;
#define SA(b, h) (shm + ((b) * 2 + (h)) * HT)
#define SB(b, h) (shm + (4 + (b) * 2 + (h)) * HT)
#define STAGE_X(T, P, BASE, br, kt) do { long _g = (long)(br) * K + (long)(kt) * BK; \
    for (int _i = 0; _i < 2; ++_i) { int _b = (T) * 16 + _i * 8192; int _r, _c; stage_rc(_b, _r, _c); \
      __builtin_amdgcn_global_load_lds((const unsigned*)(BASE + _g + (long)_r * K + _c), (LAS unsigned*)((char*)(P) + _b), 16, 0, 0); } } while (0)
#define STAGE(P, BASE, br, kt) STAGE_X(tz0, P, BASE, br, kt)
#define LDA(dst, b, h) for (int m = 0; m < 4; ++m) for (int k = 0; k < 2; ++k) \
    dst[m][k] = *reinterpret_cast<const bf16x8*>((char*)SA(b, h) + lds_byte(wr * 64 + m * 16 + fr, k * 32 + fq * 8))
#define LDB(dst, b, h) for (int n = 0; n < 2; ++n) for (int k = 0; k < 2; ++k) \
    dst[n][k] = *reinterpret_cast<const bf16x8*>((char*)SB(b, h) + lds_byte(wc * 32 + n * 16 + fr, k * 32 + fq * 8))
#define MMA(ai, bj, At_, Bt_) do { __builtin_amdgcn_s_setprio(1); \
    for (int m = 0; m < 4; ++m) for (int n = 0; n < 2; ++n) for (int k = 0; k < 2; ++k) \
      acc[ai][bj][m][n] = __builtin_amdgcn_mfma_f32_16x16x32_bf16(Bt_[n][k], At_[m][k], acc[ai][bj][m][n], 0, 0, 0); \
    __builtin_amdgcn_s_setprio(0); } while (0)
#define WAIT_V(n) asm volatile("s_waitcnt vmcnt(" #n ")" ::: "memory")
#define WAIT_L(n) asm volatile("s_waitcnt lgkmcnt(" #n ")" ::: "memory")
#define BAR __builtin_amdgcn_s_barrier()
#define SCHED __builtin_amdgcn_sched_barrier(0)
    const int brow = pm * BM, bcol = pn * BM;
    int tz0 = threadIdx.x; asm volatile("" : "+v"(tz0));
    int wid = tz0 >> 6, lane = tz0 & 63, wr = wid >> 2, wc = wid & 3, fr = lane & 15, fq = lane >> 4;
    f32x4 acc[2][2][4][2] = {};
    bf16x8 At[4][2], B0[2][2], B1[2][2];
    const int nt = K / BK;
    __syncthreads();
    STAGE(SB(0, 0), Bt, bcol, 0); STAGE(SA(0, 0), A, brow, 0);
    STAGE(SB(0, 1), Bt, bcol + HALF, 0); STAGE(SA(0, 1), A, brow + HALF, 0);
    if (wr == 1) BAR;
    WAIT_V(4); BAR;
    STAGE(SB(1, 0), Bt, bcol, 1); STAGE(SA(1, 0), A, brow, 1); STAGE(SB(1, 1), Bt, bcol + HALF, 1);
    WAIT_V(6); BAR;
    for (int t = 0; t < nt - 2; t += 2) {
        LDB(B0, 0, 0); SCHED; LDA(At, 0, 0); STAGE(SA(1, 1), A, brow + HALF, t + 1);
        WAIT_L(8); BAR; WAIT_L(0); MMA(0, 0, At, B0); BAR; SCHED;
        LDB(B1, 0, 1); STAGE(SB(0, 0), Bt, bcol, t + 2);
        BAR; WAIT_L(0); MMA(0, 1, At, B1); BAR;
        LDA(At, 0, 1); STAGE(SA(0, 0), A, brow, t + 2);
        BAR; WAIT_L(0); MMA(1, 0, At, B0); BAR; SCHED;
        STAGE(SB(0, 1), Bt, bcol + HALF, t + 2);
        WAIT_V(6); BAR; MMA(1, 1, At, B1); BAR;
        LDB(B0, 1, 0); SCHED; LDA(At, 1, 0); STAGE(SA(0, 1), A, brow + HALF, t + 2);
        WAIT_L(8); BAR; WAIT_L(0); MMA(0, 0, At, B0); BAR; SCHED;
        LDB(B1, 1, 1); STAGE(SB(1, 0), Bt, bcol, t + 3);
        BAR; WAIT_L(0); MMA(0, 1, At, B1); BAR;
        LDA(At, 1, 1); STAGE(SA(1, 0), A, brow, t + 3);
        BAR; WAIT_L(0); MMA(1, 0, At, B0); BAR; SCHED;
        STAGE(SB(1, 1), Bt, bcol + HALF, t + 3);
        WAIT_V(6); BAR; MMA(1, 1, At, B1); BAR;
    }
    int tz = threadIdx.x; asm volatile("" : "+v"(tz)); wid = tz >> 6; lane = tz & 63; wr = wid >> 2; wc = wid & 3; fr = lane & 15; fq = lane >> 4;
    { LDB(B0, 0, 0); WAIT_V(0); LDA(At, 0, 0); STAGE_X(tz, SA(1, 1), A, brow + HALF, nt - 1);
      BAR; WAIT_L(0); MMA(0, 0, At, B0); BAR;
      LDB(B1, 0, 1); BAR; WAIT_L(0); MMA(0, 1, At, B1); BAR;
      LDA(At, 0, 1); WAIT_V(4); BAR; WAIT_L(0); MMA(1, 0, At, B0); MMA(1, 1, At, B1); BAR; }
    { LDB(B0, 1, 0); LDA(At, 1, 0); WAIT_V(2); BAR; WAIT_L(0); MMA(0, 0, At, B0); BAR;
      LDB(B1, 1, 1); WAIT_V(0); BAR; WAIT_L(0); MMA(0, 1, At, B1); BAR;
      LDA(At, 1, 1); BAR; WAIT_L(0); MMA(1, 0, At, B0); MMA(1, 1, At, B1); BAR; }
    if (wr == 0) BAR;
    { float rsv[8]; epi.pre(pm, wr, fr, rsv); epi(acc, rsv, pm, pn, wr, wc, fr, fq); }
#undef SA
#undef SB
#undef STAGE_X
#undef STAGE
#undef LDA
#undef LDB
#undef MMA
#undef WAIT_V
#undef WAIT_L
#undef BAR
#undef SCHED
}

struct EpiBf16 {
    bf16_t* O; int ldc; int gelu_pn; const float* rs;
    static constexpr int NSTORES = 16;
    __device__ __forceinline__ void pre(int pm, int wr, int fr, float (&rsv)[8]) const {
#pragma unroll
        for (int i = 0; i < 8; ++i) {
            if (rs) { const float* q = rs + (size_t)(pm * BM + (i >> 2) * HALF + wr * 64 + (i & 3) * 16 + fr) * 8; const f32x4 a = *(const f32x4*)q, b = *(const f32x4*)(q + 4);
                      rsv[i] = rsqrtf((((a[0] + a[1]) + (a[2] + a[3])) + ((b[0] + b[1]) + (b[2] + b[3]))) * (1.0f / DM) + EPS); }
            else rsv[i] = 1.0f;
        }
    }
    __device__ __forceinline__ void operator()(const f32x4 (&acc)[2][2][4][2], const float (&rsv8)[8], int pm, int pn, int wr, int wc, int fr, int fq) const {
        const bool g = pn >= gelu_pn;
#pragma unroll
        for (int ai = 0; ai < 2; ++ai)
#pragma unroll
            for (int m = 0; m < 4; ++m) {
                const int row = pm * BM + ai * HALF + wr * 64 + m * 16 + fr;
                bf16_t* rowp = O + (size_t)row * ldc + pn * BM + wc * 32 + fq * 8;
                const float rsv = rsv8[ai * 4 + m];
#pragma unroll
                for (int bj = 0; bj < 2; ++bj) {
                    f32x4 v0 = acc[ai][bj][m][0] * rsv, v1 = acc[ai][bj][m][1] * rsv;
                    if (g) { v0[0] = gelu_tanh(v0[0]); v0[1] = gelu_tanh(v0[1]); v0[2] = gelu_tanh(v0[2]); v0[3] = gelu_tanh(v0[3]);
                             v1[0] = gelu_tanh(v1[0]); v1[1] = gelu_tanh(v1[1]); v1[2] = gelu_tanh(v1[2]); v1[3] = gelu_tanh(v1[3]); }
                    u32x4 w; w.x = cvt_pk_bf16(v0[0], v0[1]); w.y = cvt_pk_bf16(v0[2], v0[3]); w.z = cvt_pk_bf16(v1[0], v1[1]); w.w = cvt_pk_bf16(v1[2], v1[3]);
                    *(u32x4*)(rowp + bj * HALF) = w;
                }
            }
    }
};
struct EpiHalfBf16 {
    bf16_t* O; int ldc;
    static constexpr int NSTORES = 8;
    __device__ __forceinline__ void pre(int, int, int, float (&rsv)[8]) const {
#pragma unroll
        for (int i = 0; i < 8; ++i) rsv[i] = 1.0f;
    }
    __device__ __forceinline__ void operator()(const f32x4 (&acc)[2][2][4][2], const float (&)[8], int pm, int, int wr, int wc, int fr, int fq) const {
#pragma unroll
        for (int ai = 0; ai < 2; ++ai)
#pragma unroll
            for (int m = 0; m < 4; ++m) {
                const int row = pm * BM + ai * HALF + wr * 64 + m * 16 + fr;
                const f32x4 v0 = acc[ai][0][m][0], v1 = acc[ai][0][m][1];
                u32x4 w; w.x = cvt_pk_bf16(v0[0], v0[1]); w.y = cvt_pk_bf16(v0[2], v0[3]); w.z = cvt_pk_bf16(v1[0], v1[1]); w.w = cvt_pk_bf16(v1[2], v1[3]);
                *(u32x4*)(O + (size_t)row * ldc + wc * 32 + fq * 8) = w;
            }
    }
};
struct EpiF32 {
    float* O; int ldc;
    static constexpr int NSTORES = 32;
    __device__ __forceinline__ void pre(int, int, int, float (&rsv)[8]) const {
#pragma unroll
        for (int i = 0; i < 8; ++i) rsv[i] = 1.0f;
    }
    __device__ __forceinline__ void operator()(const f32x4 (&acc)[2][2][4][2], const float (&)[8], int pm, int pn, int wr, int wc, int fr, int fq) const {
#pragma unroll
        for (int ai = 0; ai < 2; ++ai)
#pragma unroll
            for (int m = 0; m < 4; ++m) {
                float* rowp = O + (size_t)(pm * BM + ai * HALF + wr * 64 + m * 16 + fr) * ldc + pn * BM + wc * 32 + fq * 8;
#pragma unroll
                for (int bj = 0; bj < 2; ++bj)
#pragma unroll
                    for (int n = 0; n < 2; ++n) *(f32x4*)(rowp + bj * HALF + n * 4) = acc[ai][bj][m][n];
            }
    }
};
struct EpiSwiglu {
    bf16_t* O; const float* rs;
    static constexpr int NSTORES = 8;
    __device__ __forceinline__ void pre(int pm, int wr, int fr, float (&rsv)[8]) const {
#pragma unroll
        for (int i = 0; i < 8; ++i) { const float* q = rs + (size_t)(pm * BM + (i >> 2) * HALF + wr * 64 + (i & 3) * 16 + fr) * 8; const f32x4 a = *(const f32x4*)q, b = *(const f32x4*)(q + 4);
            rsv[i] = rsqrtf((((a[0] + a[1]) + (a[2] + a[3])) + ((b[0] + b[1]) + (b[2] + b[3]))) * (1.0f / DM) + EPS); }
    }
    __device__ __forceinline__ void operator()(const f32x4 (&acc)[2][2][4][2], const float (&rsv8)[8], int pm, int pn, int wr, int wc, int fr, int fq) const {
#pragma unroll
        for (int ai = 0; ai < 2; ++ai)
#pragma unroll
            for (int m = 0; m < 4; ++m) {
                const int row = pm * BM + ai * HALF + wr * 64 + m * 16 + fr;
                bf16_t* rowp = O + (size_t)row * FH + pn * HALF + wc * 32 + fq * 8;
                const float rsv = rsv8[ai * 4 + m];
                u32x4 w;
                { const f32x4 gt = acc[ai][0][m][0] * rsv, up = acc[ai][1][m][0] * rsv;
                  w.x = cvt_pk_bf16(silu(gt[0]) * up[0], silu(gt[1]) * up[1]); w.y = cvt_pk_bf16(silu(gt[2]) * up[2], silu(gt[3]) * up[3]); }
                { const f32x4 gt = acc[ai][0][m][1] * rsv, up = acc[ai][1][m][1] * rsv;
                  w.z = cvt_pk_bf16(silu(gt[0]) * up[0], silu(gt[1]) * up[1]); w.w = cvt_pk_bf16(silu(gt[2]) * up[2], silu(gt[3]) * up[3]); }
                *(u32x4*)rowp = w;
            }
    }
};
__device__ __forceinline__ void unit_to_tile(int L, int nM, int nN, int& pm, int& pn) {
    const int nwg = nM * nN;
    int wgid = L;
    { const int q = nwg / 8, r = nwg % 8, xcd = L % 8, off = L / 8; wgid = (xcd < r ? xcd * (q + 1) : r * (q + 1) + (xcd - r) * q) + off; }
    const int nig = 8 * nN, gid = wgid / nig, fm = gid * 8, gsz = (nM - fm) < 8 ? (nM - fm) : 8;
    pm = fm + ((wgid % nig) % gsz); pn = (wgid % nig) / gsz;
}
struct EpiFusedPost {
    bf16_t* h16; float* out32; const float* g_post; float* ssq_next; float* xbuf; unsigned* cnt; unsigned* tmo; unsigned char* smem;
    static constexpr int NSTORES = 0;
    __device__ __forceinline__ void pre(int, int, int, float (&rsv)[8]) const {
#pragma unroll
        for (int i = 0; i < 8; ++i) rsv[i] = 1.0f;
    }
    __device__ __forceinline__ void operator()(const f32x4 (&acc)[2][2][4][2], const float (&)[8], int pm, int pn, int wr, int wc, int fr, int fq) const {
        float* P = (float*)(smem + 131072);
        float* S = P + 1024;
        const int tid = opaque_tid();
#pragma unroll
        for (int ai = 0; ai < 2; ++ai)
#pragma unroll
            for (int m = 0; m < 4; ++m) {
                float q = 0.f;
#pragma unroll
                for (int bj = 0; bj < 2; ++bj)
#pragma unroll
                    for (int n = 0; n < 2; ++n) { const f32x4 v = acc[ai][bj][m][n]; q += v[0] * v[0] + v[1] * v[1] + v[2] * v[2] + v[3] * v[3]; }
                q += __shfl_xor(q, 16, 64); q += __shfl_xor(q, 32, 64);
                if (fq == 0) P[(ai * HALF + wr * 64 + m * 16 + fr) * 4 + wc] = q;
            }
        __syncthreads();
        if (tid < 256) {
            const f32x4 pp = *(const f32x4*)(P + tid * 4);
            __hip_atomic_store(xbuf + ((size_t)pm * 256 + tid) * 8 + pn, (pp[0] + pp[1]) + (pp[2] + pp[3]), __ATOMIC_RELAXED, __HIP_MEMORY_SCOPE_AGENT);
        }
        asm volatile("s_waitcnt vmcnt(0)" ::: "memory");
        __syncthreads();
        const int wru = __builtin_amdgcn_readfirstlane(wr), wcu = __builtin_amdgcn_readfirstlane(wc);
        const size_t ubase = ((size_t)pm * BM + wru * 64) * DM + pn * BM + wcu * 32;
        const unsigned loff = (unsigned)fr * DM + fq * 8;
        u32x4 hw[2][4][2];
#pragma unroll
        for (int m = 0; m < 4; ++m)
#pragma unroll
            for (int bj = 0; bj < 2; ++bj)
                hw[0][m][bj] = *(const u32x4*)(h16 + (ubase + (size_t)(m * 16) * DM + bj * HALF) + loff);
        if (tid == 0) {
            __hip_atomic_fetch_add(cnt + pm * 16, 1u, __ATOMIC_RELAXED, __HIP_MEMORY_SCOPE_AGENT);
            unsigned spins = 0;
            while (__hip_atomic_load(cnt + pm * 16, __ATOMIC_RELAXED, __HIP_MEMORY_SCOPE_AGENT) < 8u) {
                __builtin_amdgcn_s_sleep(1);
                if (++spins > (1u << 22)) { __hip_atomic_store(tmo, 1u, __ATOMIC_RELAXED, __HIP_MEMORY_SCOPE_AGENT); break; }
            }
        }
        __syncthreads();
        if (tid < 256) {
            const unsigned long long* xp = (const unsigned long long*)(xbuf + ((size_t)pm * 256 + tid) * 8);
            f32x4 xa, xb;
            asm volatile("global_load_dwordx4 %0, %2, off sc1\n\tglobal_load_dwordx4 %1, %2, off offset:16 sc1\n\ts_waitcnt vmcnt(0)" : "=&v"(xa), "=&v"(xb) : "v"(xp) : "memory");
            const float tot = ((xa[0] + xa[1]) + (xa[2] + xa[3])) + ((xb[0] + xb[1]) + (xb[2] + xb[3]));
            S[tid] = rsqrtf(tot * (1.0f / DM) + EPS);
        }
        __syncthreads();
        f32x4 gg[2][2];
#pragma unroll
        for (int bj = 0; bj < 2; ++bj) { const float* gp = g_post + pn * BM + bj * HALF + wc * 32 + fq * 8; gg[bj][0] = *(const f32x4*)gp; gg[bj][1] = *(const f32x4*)(gp + 4); }
#pragma unroll
        for (int m = 0; m < 4; ++m)
#pragma unroll
            for (int bj = 0; bj < 2; ++bj)
                hw[1][m][bj] = *(const u32x4*)(h16 + (ubase + (size_t)(HALF + m * 16) * DM + bj * HALF) + loff);
#pragma unroll
        for (int ai = 0; ai < 2; ++ai)
#pragma unroll
            for (int m = 0; m < 4; ++m) {
                const int rl = ai * HALF + wr * 64 + m * 16 + fr;
                const float rp = S[rl];
                float s2 = 0.f;
#pragma unroll
                for (int bj = 0; bj < 2; ++bj) {
                    const size_t offu = ubase + (size_t)(ai * HALF + m * 16) * DM + bj * HALF;
                    const u32x4 hq = hw[ai][m][bj];
                    f32x4 h0 = (f32x4){bflo(hq.x), bfhi(hq.x), bflo(hq.y), bfhi(hq.y)}, h1 = (f32x4){bflo(hq.z), bfhi(hq.z), bflo(hq.w), bfhi(hq.w)};
                    h0 = h0 + acc[ai][bj][m][0] * rp * gg[bj][0];
                    h1 = h1 + acc[ai][bj][m][1] * rp * gg[bj][1];
                    if (out32) { *(f32x4*)(out32 + offu + loff) = h0; *(f32x4*)(out32 + offu + loff + 4) = h1; }
                    else {
                        u32x4 w; w.x = cvt_pk_bf16(h0[0], h0[1]); w.y = cvt_pk_bf16(h0[2], h0[3]); w.z = cvt_pk_bf16(h1[0], h1[1]); w.w = cvt_pk_bf16(h1[2], h1[3]);
                        *(u32x4*)(h16 + offu + loff) = w;
                        const float e0 = bflo(w.x), e1 = bfhi(w.x), e2 = bflo(w.y), e3 = bfhi(w.y), e4 = bflo(w.z), e5 = bfhi(w.z), e6 = bflo(w.w), e7 = bfhi(w.w);
                        s2 += (e0 * e0 + e1 * e1) + (e2 * e2 + e3 * e3) + (e4 * e4 + e5 * e5) + (e6 * e6 + e7 * e7);
                    }
                }
                if (!out32) {
                    s2 += __shfl_xor(s2, 16, 64); s2 += __shfl_xor(s2, 32, 64);
                    if (fq == 0) P[rl * 4 + wc] = s2;
                }
            }
        if (!out32) {
            __syncthreads();
            if (tid < 256) { const f32x4 pp = *(const f32x4*)(P + tid * 4); ssq_next[((size_t)pm * BM + tid) * 8 + pn] = (pp[0] + pp[1]) + (pp[2] + pp[3]); }
        }
    }
};
__device__ __forceinline__ void gemm_post_fused(const bf16_t* A, const bf16_t* Bt, int K, const EpiFusedPost& epi, unsigned char* smem) {
    const int c = blockIdx.x, x = c & 7, slot = c >> 3;
    for (int sl = 0; sl < 2; ++sl) gemm_tile(A, Bt, K, 32 * sl + 4 * x + (slot >> 3), slot & 7, epi, smem);
}

template <class Epi>
__device__ __forceinline__ void gemm_phase(const bf16_t* __restrict__ A, const bf16_t* __restrict__ Bt, const int M, const int N, const int K, const Epi& epi, unsigned char* smem) {
    bf16_t* shm = (bf16_t*)smem;
    const int LD = K;
#define SA(b, h) (shm + ((b) * 2 + (h)) * HT)
#define SB(b, h) (shm + (4 + (b) * 2 + (h)) * HT)
#define STAGE_X(T, P, BASE, br, kt) do { long _g = (long)(br) * LD + (long)(kt) * BK; \
    for (int _i = 0; _i < 2; ++_i) { int _b = (T) * 16 + _i * 8192; int _r, _c; stage_rc(_b, _r, _c); \
      __builtin_amdgcn_global_load_lds((const unsigned*)(BASE + _g + (long)_r * LD + _c), (LAS unsigned*)((char*)(P) + _b), 16, 0, 0); } } while (0)
#define STAGE(P, BASE, br, kt) STAGE_X(tz0, P, BASE, br, kt)
#define LDA(dst, b, h) for (int m = 0; m < 4; ++m) for (int k = 0; k < 2; ++k) \
    dst[m][k] = *reinterpret_cast<const bf16x8*>((char*)SA(b, h) + lds_byte(wr * 64 + m * 16 + fr, k * 32 + fq * 8))
#define LDB(dst, b, h) for (int n = 0; n < 2; ++n) for (int k = 0; k < 2; ++k) \
    dst[n][k] = *reinterpret_cast<const bf16x8*>((char*)SB(b, h) + lds_byte(wc * 32 + n * 16 + fr, k * 32 + fq * 8))
#define MMA(ai, bj, At_, Bt_) do { __builtin_amdgcn_s_setprio(1); \
    for (int m = 0; m < 4; ++m) for (int n = 0; n < 2; ++n) for (int k = 0; k < 2; ++k) \
      acc[ai][bj][m][n] = __builtin_amdgcn_mfma_f32_16x16x32_bf16(Bt_[n][k], At_[m][k], acc[ai][bj][m][n], 0, 0, 0); \
    __builtin_amdgcn_s_setprio(0); } while (0)
#define WAIT_V(n) asm volatile("s_waitcnt vmcnt(" #n ")" ::: "memory")
#define WAIT_VN(n) asm volatile("s_waitcnt vmcnt(%0)" :: "n"(n) : "memory")
#define WAIT_L(n) asm volatile("s_waitcnt lgkmcnt(" #n ")" ::: "memory")
#define BAR __builtin_amdgcn_s_barrier()
#define SCHED __builtin_amdgcn_sched_barrier(0)
    const int nM = M / BM, nN = N / BM, nu = nM * nN, nt = K / BK;
    int u = blockIdx.x;
    if (u >= nu) return;
    int pm, pn; unit_to_tile(u, nM, nN, pm, pn);
    int tz0 = opaque_tid();
    int wid = tz0 >> 6, lane = tz0 & 63, wr = wid >> 2, wc = wid & 3, fr = lane & 15, fq = lane >> 4;
    __syncthreads();
    {
        const int brow = pm * BM, bcol = pn * BM;
        STAGE(SB(0, 0), Bt, bcol, 0); STAGE(SA(0, 0), A, brow, 0);
        STAGE(SB(0, 1), Bt, bcol + HALF, 0); STAGE(SA(0, 1), A, brow + HALF, 0);
        if (wr == 1) BAR;
        WAIT_V(4); BAR;
        STAGE(SB(1, 0), Bt, bcol, 1); STAGE(SA(1, 0), A, brow, 1); STAGE(SB(1, 1), Bt, bcol + HALF, 1);
        WAIT_V(6); BAR;
    }
    for (;;) {
        const int brow = pm * BM, bcol = pn * BM;
        f32x4 acc[2][2][4][2] = {};
        bf16x8 At[4][2], B0[2][2], B1[2][2];
        for (int t = 0; t < nt - 2; t += 2) {
            LDB(B0, 0, 0); SCHED; LDA(At, 0, 0); STAGE(SA(1, 1), A, brow + HALF, t + 1);
            WAIT_L(8); BAR; WAIT_L(0); MMA(0, 0, At, B0); BAR; SCHED;
            LDB(B1, 0, 1); STAGE(SB(0, 0), Bt, bcol, t + 2);
            BAR; WAIT_L(0); MMA(0, 1, At, B1); BAR;
            LDA(At, 0, 1); STAGE(SA(0, 0), A, brow, t + 2);
            BAR; WAIT_L(0); MMA(1, 0, At, B0); BAR; SCHED;
            STAGE(SB(0, 1), Bt, bcol + HALF, t + 2);
            WAIT_V(6); BAR; MMA(1, 1, At, B1); BAR;
            LDB(B0, 1, 0); SCHED; LDA(At, 1, 0); STAGE(SA(0, 1), A, brow + HALF, t + 2);
            WAIT_L(8); BAR; WAIT_L(0); MMA(0, 0, At, B0); BAR; SCHED;
            LDB(B1, 1, 1); STAGE(SB(1, 0), Bt, bcol, t + 3);
            BAR; WAIT_L(0); MMA(0, 1, At, B1); BAR;
            LDA(At, 1, 1); STAGE(SA(1, 0), A, brow, t + 3);
            BAR; WAIT_L(0); MMA(1, 0, At, B0); BAR; SCHED;
            STAGE(SB(1, 1), Bt, bcol + HALF, t + 3);
            WAIT_V(6); BAR; MMA(1, 1, At, B1); BAR;
        }
        tz0 = opaque_tid(); wid = tz0 >> 6; lane = tz0 & 63; wr = wid >> 2; wc = wid & 3; fr = lane & 15; fq = lane >> 4;
        { LDB(B0, 0, 0); WAIT_V(0); LDA(At, 0, 0); STAGE(SA(1, 1), A, brow + HALF, nt - 1);
          BAR; WAIT_L(0); MMA(0, 0, At, B0); BAR;
          LDB(B1, 0, 1); BAR; WAIT_L(0); MMA(0, 1, At, B1); BAR;
          LDA(At, 0, 1); WAIT_V(4); BAR; WAIT_L(0); MMA(1, 0, At, B0); MMA(1, 1, At, B1); BAR; }
        { LDB(B0, 1, 0); LDA(At, 1, 0); WAIT_V(2); BAR; WAIT_L(0); MMA(0, 0, At, B0); BAR;
          LDB(B1, 1, 1); WAIT_V(0); BAR; WAIT_L(0); MMA(0, 1, At, B1); BAR;
          LDA(At, 1, 1); BAR; WAIT_L(0); MMA(1, 0, At, B0); MMA(1, 1, At, B1); BAR; }
        if (wr == 0) BAR;
        float rsv[8];
        epi.pre(pm, wr, fr, rsv);
        const bool has_next = u + (int)gridDim.x < nu;
        int pm2 = pm, pn2 = pn;
        if (has_next) {
            unit_to_tile(u + gridDim.x, nM, nN, pm2, pn2);
            const int nbrow = pm2 * BM, nbcol = pn2 * BM;
            STAGE(SB(0, 0), Bt, nbcol, 0); STAGE(SA(0, 0), A, nbrow, 0);
            STAGE(SB(0, 1), Bt, nbcol + HALF, 0); STAGE(SA(0, 1), A, nbrow + HALF, 0);
        }
        epi(acc, rsv, pm, pn, wr, wc, fr, fq);
        if (!has_next) break;
        {
            const int nbrow = pm2 * BM, nbcol = pn2 * BM;
            if (wr == 1) BAR;
            WAIT_VN(4 + Epi::NSTORES); BAR;
            STAGE(SB(1, 0), Bt, nbcol, 1); STAGE(SA(1, 0), A, nbrow, 1); STAGE(SB(1, 1), Bt, nbcol + HALF, 1);
            WAIT_VN(6 + Epi::NSTORES); BAR;
        }
        u += gridDim.x; pm = pm2; pn = pn2;
    }
#undef SA
#undef SB
#undef STAGE_X
#undef STAGE
#undef LDA
#undef LDB
#undef MMA
#undef WAIT_V
#undef WAIT_VN
#undef WAIT_L
#undef BAR
#undef SCHED
}
}

__host__ __device__ __forceinline__ int perm32(int rho) { return 8 * ((rho >> 2) & 3) + 4 * (rho >> 4) + (rho & 3); }
__host__ __device__ __forceinline__ int perm32_inv(int a) { return 16 * ((a >> 2) & 1) + 4 * (a >> 3) + (a & 3); }
struct ConvJob { const float* src; int src_ld; bf16_t* dst; int dst_ld; int K, N; int map; float scale; const float* kscale; };
__device__ __forceinline__ int conv_col(int map, int n) {
    if (map == 1) return n < 3152 ? n : (n < OFF_CU ? -1 : n - (OFF_CU - 3152));
    if (map == 2) { const int j = n >> 8, r = n & 255; return (r < 128 ? 0 : FH) + j * 128 + (r & 127); }
    return n;
}
__device__ __forceinline__ ConvJob conv_job(const Params& p, int l, int j) {
    ConvJob c; c.map = 0; c.scale = 1.0f; c.kscale = nullptr;
    unsigned char* ws = p.ws;
    switch (j) {
    case 0: c.src = p.in[5] + (size_t)l * DM * IN_COLS; c.src_ld = IN_COLS; c.dst = (bf16_t*)(ws + W_IN); c.dst_ld = DM; c.K = DM; c.N = NPROJ; c.map = 1; c.kscale = p.in[3] + (size_t)l * DM; break;
    case 1: c.src = p.in[12] + (size_t)l * 512 * 1024; c.src_ld = 1024; c.dst = (bf16_t*)(ws + W_B) + (size_t)1536 * 512; c.dst_ld = 512; c.K = 512; c.N = 1024; c.scale = 1.0f / 32.0f; break;
    case 2: c.src = p.in[6] + (size_t)l * DM * DM; c.src_ld = DM; c.dst = (bf16_t*)(ws + W_OUT); c.dst_ld = NMIX; c.K = DM; c.N = DM; break;
    case 3: c.src = p.in[14] + (size_t)l * 256 * 768; c.src_ld = 768; c.dst = (bf16_t*)(ws + W_UVT); c.dst_ld = 256; c.K = 256; c.N = 768; break;
    case 4: c.src = p.in[22] + (size_t)l * DM * 512; c.src_ld = 512; c.dst = (bf16_t*)(ws + W_XQ); c.dst_ld = DM; c.K = DM; c.N = 512; c.kscale = p.in[19] + (size_t)l * DM; break;
    case 5: c.src = p.in[23] + (size_t)l * DM * 1024; c.src_ld = 1024; c.dst = (bf16_t*)(ws + W_XKV); c.dst_ld = DM; c.K = DM; c.N = 1024; break;
    case 6: c.src = p.in[24] + (size_t)l * 512 * DM; c.src_ld = DM; c.dst = (bf16_t*)(ws + W_XO); c.dst_ld = 512; c.K = 512; c.N = DM; break;
    case 7: c.src = p.in[27] + (size_t)l * DM * 2 * FH; c.src_ld = 2 * FH; c.dst = (bf16_t*)(ws + W_GU); c.dst_ld = DM; c.K = DM; c.N = 2 * FH; c.map = 2; c.kscale = p.in[25] + (size_t)l * DM; break;
    default: c.src = p.in[28] + (size_t)l * FH * DM; c.src_ld = DM; c.dst = (bf16_t*)(ws + W_DOWN); c.dst_ld = FH; c.K = FH; c.N = DM; break;
    }
    return c;
}
constexpr int NCONV = 9;

struct ConvRegs { f32x4 r[8]; };
__device__ __forceinline__ void conv_load(const ConvJob& c, int kt, int nt, int tid, ConvRegs& R) {
    const int n = nt * 128 + (tid & 31) * 4, k = kt * 128 + (tid >> 5) * 8;
    const int col = conv_col(c.map, (n & ~31) | perm32(n & 31));
    if (col >= 0) {
        const float* sp = c.src + (size_t)k * c.src_ld + col;
#pragma unroll
        for (int i = 0; i < 8; ++i) R.r[i] = *(const f32x4*)(sp + (size_t)i * c.src_ld);
    } else {
#pragma unroll
        for (int i = 0; i < 8; ++i) R.r[i] = (f32x4){0.f, 0.f, 0.f, 0.f};
    }
}
__device__ __forceinline__ void conv_stage(const ConvJob& c, int kt, int tid, const ConvRegs& R, unsigned char* buf) {
    const int k = kt * 128 + (tid >> 5) * 8, n4 = tid & 31, kg = tid >> 5;
    float sc[8];
    if (c.kscale) { const f32x4 g0 = *(const f32x4*)(c.kscale + k), g1 = *(const f32x4*)(c.kscale + k + 4);
        sc[0] = g0[0]; sc[1] = g0[1]; sc[2] = g0[2]; sc[3] = g0[3]; sc[4] = g1[0]; sc[5] = g1[1]; sc[6] = g1[2]; sc[7] = g1[3]; }
    else {
#pragma unroll
        for (int i = 0; i < 8; ++i) sc[i] = c.scale;
    }
#pragma unroll
    for (int j = 0; j < 4; ++j) {
        u32x4 w;
        w.x = cvt_pk_bf16(R.r[0][j] * sc[0], R.r[1][j] * sc[1]); w.y = cvt_pk_bf16(R.r[2][j] * sc[2], R.r[3][j] * sc[3]);
        w.z = cvt_pk_bf16(R.r[4][j] * sc[4], R.r[5][j] * sc[5]); w.w = cvt_pk_bf16(R.r[6][j] * sc[6], R.r[7][j] * sc[7]);
        *(u32x4*)(buf + (n4 * 4 + j) * 256 + ((kg ^ (n4 & 15)) << 4)) = w;
    }
}
__device__ __forceinline__ void conv_flush(const ConvJob& c, int kt, int nt, int tid, const unsigned char* buf) {
    const int k16 = tid & 15;
#pragma unroll
    for (int i = 0; i < 4; ++i) {
        const int n = (tid >> 4) + 32 * i;
        const u32x4 w = *(const u32x4*)(buf + n * 256 + ((k16 ^ ((n >> 2) & 15)) << 4));
        *(u32x4*)(c.dst + (size_t)(nt * 128 + n) * c.dst_ld + kt * 128 + k16 * 8) = w;
    }
}
constexpr int NCONV_EARLY = 7;
__device__ __forceinline__ bool conv_locate(const Params& p, int l, int g, int j0, int j1, ConvJob& c, int& kt, int& nt) {
    for (int j = j0; j < j1; ++j) {
        c = conv_job(p, l, j);
        const int nk = c.K / 128, n = nk * (c.N / 128);
        if (g < n) { kt = g % nk; nt = g / nk; return true; }
        g -= n;
    }
    return false;
}

__device__ void combo_tile(const float* Ap, int a_i, int a_d, const float* Bp, int b_j, bf16_t* dst, int ldc, float scale, unsigned char* smem) {
    constexpr int S = 132;
    float* As = (float*)smem; float* Bs = As + 64 * S;
    const int tid = opaque_tid();
    __syncthreads();
#pragma unroll
    for (int q = 0; q < 4; ++q) {
        const int idx = tid + 512 * q;
        { const int j = idx >> 5, d4 = (idx & 31) * 4; *(f32x4*)(Bs + j * S + d4) = *(const f32x4*)(Bp + (size_t)j * b_j + d4); }
        if (a_d == 1) { const int i = idx >> 5, d4 = (idx & 31) * 4; *(f32x4*)(As + i * S + d4) = *(const f32x4*)(Ap + (size_t)i * a_i + d4); }
        else { const int e = idx >> 4, i4 = (idx & 15) * 4; const f32x4 v = *(const f32x4*)(Ap + (size_t)e * a_d + i4);
               As[(i4 + 0) * S + e] = v[0]; As[(i4 + 1) * S + e] = v[1]; As[(i4 + 2) * S + e] = v[2]; As[(i4 + 3) * S + e] = v[3]; }
    }
    __syncthreads();
    const int ty = tid >> 4, tx = tid & 15;
    float acc[2][4] = {{0.f, 0.f, 0.f, 0.f}, {0.f, 0.f, 0.f, 0.f}};
#pragma unroll 4
    for (int d4 = 0; d4 < 128; d4 += 4) {
        const f32x4 a0 = *(const f32x4*)(As + (2 * ty) * S + d4), a1 = *(const f32x4*)(As + (2 * ty + 1) * S + d4);
#pragma unroll
        for (int c = 0; c < 4; ++c) {
            const f32x4 b = *(const f32x4*)(Bs + (tx + 16 * c) * S + d4);
            acc[0][c] += a0[0] * b[0] + a0[1] * b[1] + a0[2] * b[2] + a0[3] * b[3];
            acc[1][c] += a1[0] * b[0] + a1[1] * b[1] + a1[2] * b[2] + a1[3] * b[3];
        }
    }
#pragma unroll
    for (int r = 0; r < 2; ++r) {
        const int i = 2 * ty + r, ip = (i & ~31) | perm32_inv(i & 31);
#pragma unroll
        for (int c = 0; c < 4; ++c) dst[(size_t)ip * ldc + tx + 16 * c] = f2bf(acc[r][c] * scale);
    }
}

__device__ __forceinline__ void rownorm_to_bf16(const float* src, const float* g, bf16_t* dst, int lane) {
    f32x4 v[8]; float ss = 0.f;
#pragma unroll
    for (int i = 0; i < 8; ++i) { v[i] = *(const f32x4*)(src + (i * 64 + lane) * 4); ss += v[i][0] * v[i][0] + v[i][1] * v[i][1] + v[i][2] * v[i][2] + v[i][3] * v[i][3]; }
    ss = wave_sum(ss);
    const float r = rsqrtf(ss * (1.0f / DM) + EPS);
#pragma unroll
    for (int i = 0; i < 8; ++i) {
        const f32x4 gg = *(const f32x4*)(g + (i * 64 + lane) * 4);
        u32x2 w; w.x = cvt_pk_bf16(v[i][0] * r * gg[0], v[i][1] * r * gg[1]); w.y = cvt_pk_bf16(v[i][2] * r * gg[2], v[i][3] * r * gg[3]);
        *(u32x2*)(dst + (i * 64 + lane) * 4) = w;
    }
}

__device__ __forceinline__ int rel_bucket(int n) {
    if (n < 16) return n;
    const int b = 16 + (int)(logf((float)n / 16.0f) / 2.0794415416798357f * 16.0f);
    return b < 31 ? b : 31;
}

__device__ __forceinline__ void conv_run(const Params& p, int l, int j0, int j1, int g0, int stride, int cnt, int tid, unsigned char* smem) {
    ConvJob c0, c1; int kt0 = 0, nt0 = 0, kt1 = 0, nt1 = 0;
    ConvRegs R0, R1;
    int g = g0;
    __syncthreads();
    bool v0 = cnt > 0 && conv_locate(p, l, g, j0, j1, c0, kt0, nt0);
    if (v0) conv_load(c0, kt0, nt0, tid, R0);
    while (v0) {
        const bool v1 = cnt > 1 && conv_locate(p, l, g + stride, j0, j1, c1, kt1, nt1);
        if (v1) conv_load(c1, kt1, nt1, tid, R1);
        conv_stage(c0, kt0, tid, R0, smem);
        __syncthreads();
        conv_flush(c0, kt0, nt0, tid, smem);
        if (!v1) break;
        g += 2 * stride; cnt -= 2;
        v0 = cnt > 0 && conv_locate(p, l, g, j0, j1, c0, kt0, nt0);
        if (v0) conv_load(c0, kt0, nt0, tid, R0);
        conv_stage(c1, kt1, tid, R1, smem + 32768);
        __syncthreads();
        conv_flush(c1, kt1, nt1, tid, smem + 32768);
    }
}

__device__ void phase_weights(const Params& p, int l, unsigned char* smem) {
    const int tid = opaque_tid(), wid = tid >> 6, lane = tid & 63;
    const int gtid = blockIdx.x * NTHREADS + tid, gthreads = gridDim.x * NTHREADS;
    unsigned char* ws = p.ws;
    conv_run(p, l, 0, NCONV_EARLY, blockIdx.x, gridDim.x, 1 << 30, tid, smem);
    {
        const float* uq = p.in[11] + (size_t)l * 512 * 768;
        const float* uk = p.in[13] + (size_t)l * 256 * 768;
        const float* uv = p.in[14] + (size_t)l * 256 * 768;
        const float* wo = p.in[6] + (size_t)l * DM * DM;
        for (int t = blockIdx.x; t < 192; t += gridDim.x) {
            {
                const int it = t >> 3, jt = t & 7, n0 = it * 64, h = n0 >> 8, rkv0 = n0 & 255;
                combo_tile(uk + (size_t)rkv0 * 768 + h * 128, 768, 1, uq + (size_t)(jt * 64) * 768 + h * 128, 768,
                           (bf16_t*)(ws + W_B) + (size_t)n0 * 512 + jt * 64, 512, 0.08838834764831845f, smem);
            }
        }
    }
    for (int r = blockIdx.x * 8 + wid; r < MEMROWS; r += gridDim.x * 8)
        rownorm_to_bf16(p.in[1] + (size_t)r * DM, p.in[21] + (size_t)l * DM, (bf16_t*)(ws + WS_MEMN) + (size_t)r * DM, lane);
    if (l == 0) {
        {
            const int stride = gridDim.x * 8;
            int r = blockIdx.x * 8 + wid;
            f32x4 nx[8];
            if (r < MTOK) {
#pragma unroll
                for (int i = 0; i < 8; ++i) nx[i] = *(const f32x4*)(p.in[0] + (size_t)r * DM + (i * 64 + lane) * 4);
            }
            for (; r < MTOK; r += stride) {
                bf16_t* dst = (bf16_t*)(ws + WS_H16) + (size_t)r * DM;
                f32x4 v[8];
#pragma unroll
                for (int i = 0; i < 8; ++i) v[i] = nx[i];
                if (r + stride < MTOK) {
#pragma unroll
                    for (int i = 0; i < 8; ++i) nx[i] = *(const f32x4*)(p.in[0] + (size_t)(r + stride) * DM + (i * 64 + lane) * 4);
                }
                float ss = 0.f;
#pragma unroll
                for (int i = 0; i < 8; ++i) { ss += v[i][0] * v[i][0] + v[i][1] * v[i][1] + v[i][2] * v[i][2] + v[i][3] * v[i][3];
                    u32x2 w; w.x = cvt_pk_bf16(v[i][0], v[i][1]); w.y = cvt_pk_bf16(v[i][2], v[i][3]); *(u32x2*)(dst + (i * 64 + lane) * 4) = w; }
                ss = wave_sum(ss);
                if (lane < 8) ((float*)(ws + WS_SSQ))[(size_t)r * 8 + lane] = lane == 0 ? ss : 0.f;
            }
        }
        float* lut = (float*)(ws + WS_LUT);
        for (int o = gtid; o < 12 * 128; o += gthreads) { const int h = o >> 7, d = o & 127; lut[o] = p.in[2][rel_bucket(d) * 12 + h] * LOG2E; }
    }
    if (blockIdx.x == 0 && wid == 0) {
        bool ok = true;
#if PROBE_CHK
        {
            typedef int v2i __attribute__((ext_vector_type(2)));
            unsigned char* tb = smem + 100000;
            const int g = lane >> 4, i = lane & 15;
#if PROBE_CHK & 1
            for (int e = lane; e < 512; e += 64) { const int gg = e >> 7, rr = (e >> 4) & 7, cc = e & 15; tb[e] = (unsigned char)((rr * 16 + cc + 37 * gg) & 255); }
            asm volatile("s_waitcnt lgkmcnt(0)" ::: "memory");
            const v2i r = __builtin_amdgcn_ds_read_tr8_b64_v2i32((LAS v2i*)(tb + g * 128 + (i >> 1) * 16 + (i & 1) * 8));
            unsigned long long got = ((unsigned long long)(unsigned)r.y << 32) | (unsigned)r.x, want = 0ull;
            for (int e = 0; e < 8; ++e) want |= (unsigned long long)((e * 16 + i + 37 * g) & 255) << (8 * e);
            ok = ok && __all(got == want);
#endif
#if PROBE_CHK & 2
            unsigned long long av = 0ull, bv = 0ull;
            for (int e = 0; e < 8; e += 2) {
                const int k0 = 8 * g + e;
                const int pa = __builtin_amdgcn_cvt_pk_fp8_f32((float)((i + 2 * k0) % 5), (float)((i + 2 * (k0 + 1)) % 5), 0, false);
                const int pb = __builtin_amdgcn_cvt_pk_fp8_f32((float)((3 * i + k0) % 7), (float)((3 * i + k0 + 1) % 7), 0, false);
                av |= (unsigned long long)(pa & 0xFFFF) << (8 * e); bv |= (unsigned long long)(pb & 0xFFFF) << (8 * e);
            }
            f32x4 acc = {0.f, 0.f, 0.f, 0.f};
            acc = __builtin_amdgcn_mfma_f32_16x16x32_fp8_fp8((long)av, (long)bv, acc, 0, 0, 0);
            bool good = true;
            for (int r = 0; r < 4; ++r) { const int ii = 4 * g + r, jj = i; float want2 = 0.f; for (int k = 0; k < 32; ++k) want2 += (float)(((ii + 2 * k) % 5) * ((3 * jj + k) % 7)); good = good && (acc[r] == want2); }
            ok = ok && __all(good);
#endif
        }
#endif
        const float* lp = p.in[7] + (size_t)l * 256;
        float a = lp[lane] * lp[64 + lane], b = lp[128 + lane] * lp[192 + lane];
        a = wave_sum(a); b = wave_sum(b);
        if (lane == 0) ((float*)(ws + WS_LAM))[l] = ok ? expf(a) - expf(b) + (0.8f - 0.6f * expf(-0.3f * (float)l)) : __builtin_nanf("");
    }
}

__device__ void phase_post(const bf16_t* tmp, const float* hold32, bf16_t* h16, float* out32, const float* g_post, float* rstd) {
    const int tid = opaque_tid(), wid = tid >> 6, lane = tid & 63;
    f32x4 gg[8];
#pragma unroll
    for (int i = 0; i < 4; ++i) { gg[2 * i] = *(const f32x4*)(g_post + (i * 64 + lane) * 8); gg[2 * i + 1] = *(const f32x4*)(g_post + (i * 64 + lane) * 8 + 4); }
    const int stride = gridDim.x * 8;
    u32x4 tw[4], hw[4]; f32x4 hf[8];
#define PP_LOAD(r_) do { _Pragma("unroll") for (int i_ = 0; i_ < 4; ++i_) { \
        tw[i_] = *(const u32x4*)(tmp + (size_t)(r_) * DM + (i_ * 64 + lane) * 8); \
        if (hold32) { hf[2 * i_] = *(const f32x4*)(hold32 + (size_t)(r_) * DM + (i_ * 64 + lane) * 8); hf[2 * i_ + 1] = *(const f32x4*)(hold32 + (size_t)(r_) * DM + (i_ * 64 + lane) * 8 + 4); } \
        else hw[i_] = *(const u32x4*)(h16 + (size_t)(r_) * DM + (i_ * 64 + lane) * 8); } } while (0)
    int r = blockIdx.x * 8 + wid;
    if (r < MTOK) PP_LOAD(r);
    for (; r < MTOK; r += stride) {
        bf16_t* hr = h16 + (size_t)r * DM;
        f32x4 v[8], hv[8]; float ss = 0.f;
#pragma unroll
        for (int i = 0; i < 4; ++i) {
            v[2 * i] = (f32x4){bflo(tw[i].x), bfhi(tw[i].x), bflo(tw[i].y), bfhi(tw[i].y)}; v[2 * i + 1] = (f32x4){bflo(tw[i].z), bfhi(tw[i].z), bflo(tw[i].w), bfhi(tw[i].w)};
            if (hold32) { hv[2 * i] = hf[2 * i]; hv[2 * i + 1] = hf[2 * i + 1]; }
            else { hv[2 * i] = (f32x4){bflo(hw[i].x), bfhi(hw[i].x), bflo(hw[i].y), bfhi(hw[i].y)}; hv[2 * i + 1] = (f32x4){bflo(hw[i].z), bfhi(hw[i].z), bflo(hw[i].w), bfhi(hw[i].w)}; }
        }
#pragma unroll
        for (int i = 0; i < 8; ++i) ss += v[i][0] * v[i][0] + v[i][1] * v[i][1] + v[i][2] * v[i][2] + v[i][3] * v[i][3];
        if (r + stride < MTOK) PP_LOAD(r + stride);
        ss = wave_sum(ss);
        const float rr = rsqrtf(ss * (1.0f / DM) + EPS);
        float s2 = 0.f;
#pragma unroll
        for (int i = 0; i < 8; ++i) hv[i] = hv[i] + v[i] * rr * gg[i];
#pragma unroll
        for (int i = 0; i < 4; ++i) {
            if (out32) { *(f32x4*)(out32 + (size_t)r * DM + (i * 64 + lane) * 8) = hv[2 * i]; *(f32x4*)(out32 + (size_t)r * DM + (i * 64 + lane) * 8 + 4) = hv[2 * i + 1]; }
            else {
                u32x4 w; w.x = cvt_pk_bf16(hv[2 * i][0], hv[2 * i][1]); w.y = cvt_pk_bf16(hv[2 * i][2], hv[2 * i][3]); w.z = cvt_pk_bf16(hv[2 * i + 1][0], hv[2 * i + 1][1]); w.w = cvt_pk_bf16(hv[2 * i + 1][2], hv[2 * i + 1][3]);
                *(u32x4*)(hr + (i * 64 + lane) * 8) = w;
                const float e0 = bflo(w.x), e1 = bfhi(w.x), e2 = bflo(w.y), e3 = bfhi(w.y), e4 = bflo(w.z), e5 = bfhi(w.z), e6 = bflo(w.w), e7 = bfhi(w.w);
                s2 += e0 * e0 + e1 * e1 + e2 * e2 + e3 * e3 + e4 * e4 + e5 * e5 + e6 * e6 + e7 * e7;
            }
        }
        if (!out32) { s2 = wave_sum(s2); if (lane < 8) rstd[(size_t)r * 8 + lane] = lane == 0 ? s2 : 0.f; }
    }
#undef PP_LOAD
}

__device__ void phase_latent_norms(const Params& p, int l) {
    const int tid = opaque_tid(), wid = tid >> 6, lane = tid & 63;
    const bf16_t* proj = (const bf16_t*)(p.ws + WS_PROJ);
    bf16_t* cqn = (bf16_t*)(p.ws + WS_CQN); unsigned char* ckv8 = p.ws + WS_CKVN;
    float* cstat = (float*)(p.ws + WS_CSTAT);
    const float* gq = p.in[9] + (size_t)l * 512; const float* gkv = p.in[10] + (size_t)l * 256;
    const f32x4 g0 = *(const f32x4*)(gq + lane * 8), g1 = *(const f32x4*)(gq + lane * 8 + 4), g2 = *(const f32x4*)(gkv + lane * 4);
    const int stride = gridDim.x * 8;
    int r = blockIdx.x * 8 + wid;
    u32x4 na = {0u, 0u, 0u, 0u}, ncv = {0u, 0u, 0u, 0u}; u32x2 nb = {0u, 0u};
    if (r < MTOK) { na = *(const u32x4*)(proj + (size_t)r * NPROJ + OFF_CQ + lane * 8); nb = *(const u32x2*)(proj + (size_t)r * NPROJ + OFF_CKV + lane * 4); ncv = *(const u32x4*)(proj + (size_t)r * NPROJ + OFF_CV + lane * 8); }
    for (; r < MTOK; r += stride) {
        const u32x4 a = na; const u32x2 b = nb; const u32x4 cvv = ncv;
        if (r + stride < MTOK) { const size_t rn = (size_t)(r + stride);
            na = *(const u32x4*)(proj + rn * NPROJ + OFF_CQ + lane * 8); nb = *(const u32x2*)(proj + rn * NPROJ + OFF_CKV + lane * 4); ncv = *(const u32x4*)(proj + rn * NPROJ + OFF_CV + lane * 8); }
        float x[8] = {bflo(a.x), bfhi(a.x), bflo(a.y), bfhi(a.y), bflo(a.z), bfhi(a.z), bflo(a.w), bfhi(a.w)};
        float y[4] = {bflo(b.x), bfhi(b.x), bflo(b.y), bfhi(b.y)};
        float z[8] = {bflo(cvv.x), bfhi(cvv.x), bflo(cvv.y), bfhi(cvv.y), bflo(cvv.z), bfhi(cvv.z), bflo(cvv.w), bfhi(cvv.w)};
        float sa = 0.f, sb = 0.f, sc = 0.f, sd = 0.f;
#pragma unroll
        for (int i = 0; i < 8; ++i) { sa += x[i] * x[i]; sc += z[i]; sd += z[i] * z[i]; }
#pragma unroll
        for (int i = 0; i < 4; ++i) sb += y[i] * y[i];
        sa = wave_sum(sa); sb = wave_sum(sb); sc = wave_sum(sc); sd = wave_sum(sd);
        const float ra = rsqrtf(sa * (1.0f / 512.0f) + EPS), rb = rsqrtf(sb * (1.0f / 256.0f) + EPS);
        const float mu = sc * (1.0f / 512.0f), var = fmaxf(sd * (1.0f / 512.0f) - mu * mu, 0.f);
        u32x4 wa; wa.x = cvt_pk_bf16(x[0] * ra * g0[0], x[1] * ra * g0[1]); wa.y = cvt_pk_bf16(x[2] * ra * g0[2], x[3] * ra * g0[3]);
        wa.z = cvt_pk_bf16(x[4] * ra * g1[0], x[5] * ra * g1[1]); wa.w = cvt_pk_bf16(x[6] * ra * g1[2], x[7] * ra * g1[3]);
        int wb = __builtin_amdgcn_cvt_pk_fp8_f32(y[0] * rb * g2[0], y[1] * rb * g2[1], 0, false);
        wb = __builtin_amdgcn_cvt_pk_fp8_f32(y[2] * rb * g2[2], y[3] * rb * g2[3], wb, true);
        *(u32x4*)(cqn + (size_t)r * 512 + lane * 8) = wa;
        *(int*)(ckv8 + (size_t)r * 256 + lane * 4) = wb;
        if (lane == 0) { cstat[2 * (size_t)r] = mu; cstat[2 * (size_t)r + 1] = rsqrtf(var + EPS); }
    }
}

__device__ void cbranch_unit(const Params& p, int l, int unit, unsigned char* smem) {
    constexpr int LS = 136;
    bf16_t* Ws = (bf16_t*)smem;
    bf16_t* Vs = Ws + 128 * LS;
    const int tid = opaque_tid(), wid = tid >> 6, lane = tid & 63;
    const int chunk = unit >> 2, g = unit & 3, r0 = chunk * 128;
    const bf16_t* proj = (const bf16_t*)(p.ws + WS_PROJ);
    const float* cstat = (const float*)(p.ws + WS_CSTAT);
    bf16_t* mix = (bf16_t*)(p.ws + WS_MIX);
    __syncthreads();
    {
        const int c8 = (tid & 15) * 8;
        const float* lg = p.in[15] + (size_t)l * 512 + g * 128 + c8;
        const float* lb = p.in[16] + (size_t)l * 512 + g * 128 + c8;
        const f32x4 lg0 = *(const f32x4*)lg, lg1 = *(const f32x4*)(lg + 4), lb0 = *(const f32x4*)lb, lb1 = *(const f32x4*)(lb + 4);
#pragma unroll
        for (int i = 0; i < 4; ++i) {
            const int sr = (tid >> 4) + 32 * i;
            const u32x4 a = *(const u32x4*)(proj + (size_t)(r0 + sr) * NPROJ + OFF_CV + g * 128 + c8);
            const float mu = cstat[2 * (size_t)(r0 + sr)], rs = cstat[2 * (size_t)(r0 + sr) + 1];
            u32x4 o;
            o.x = cvt_pk_bf16((bflo(a.x) - mu) * rs * lg0[0] + lb0[0], (bfhi(a.x) - mu) * rs * lg0[1] + lb0[1]);
            o.y = cvt_pk_bf16((bflo(a.y) - mu) * rs * lg0[2] + lb0[2], (bfhi(a.y) - mu) * rs * lg0[3] + lb0[3]);
            o.z = cvt_pk_bf16((bflo(a.z) - mu) * rs * lg1[0] + lb1[0], (bfhi(a.z) - mu) * rs * lg1[1] + lb1[1]);
            o.w = cvt_pk_bf16((bflo(a.w) - mu) * rs * lg1[2] + lb1[2], (bfhi(a.w) - mu) * rs * lg1[3] + lb1[3]);
            *(u32x4*)(Vs + sr * LS + c8) = o;
        }
        const float* wsrc = p.in[17] + ((size_t)l * 4 + g) * 128 * 128;
        const int s4 = (tid & 31) * 4;
#pragma unroll
        for (int i = 0; i < 8; ++i) {
            const int tr = (tid >> 5) + 16 * i;
            const f32x4 w = *(const f32x4*)(wsrc + (size_t)tr * 128 + s4);
            u32x2 o; o.x = cvt_pk_bf16(s4 <= tr ? w[0] : 0.f, s4 + 1 <= tr ? w[1] : 0.f); o.y = cvt_pk_bf16(s4 + 2 <= tr ? w[2] : 0.f, s4 + 3 <= tr ? w[3] : 0.f);
            *(u32x2*)(Ws + tr * LS + s4) = o;
        }
    }
    __syncthreads();
    const int fr = lane & 15, fq = lane >> 4, q4 = fr >> 2, p4 = lane & 3;
    const int t = wid * 16 + fr;
    const float bs = p.in[18][((size_t)l * 4 + g) * 128 + t];
    bf16x8 bw[4];
#pragma unroll
    for (int ks = 0; ks < 4; ++ks) bw[ks] = *(const bf16x8*)(Ws + t * LS + ks * 32 + fq * 8);
    const unsigned char* vtr = (const unsigned char*)Vs + ((8 * fq + q4) * LS + 4 * p4) * 2;
    u32x2 uu[8];
#pragma unroll
    for (int ct = 0; ct < 8; ++ct) uu[ct] = *(const u32x2*)(proj + (size_t)(r0 + t) * NPROJ + OFF_CU + g * 128 + ct * 16 + fq * 4);
#pragma unroll
    for (int ct = 0; ct < 8; ++ct) {
        f32x4 acc = {0.f, 0.f, 0.f, 0.f};
        s16x4 lo[4], hi[4];
#pragma unroll
        for (int ks = 0; ks < 4; ++ks) {
            lo[ks] = __builtin_amdgcn_ds_read_tr16_b64_v4i16((LAS s16x4*)(vtr + (32 * ks) * LS * 2 + ct * 32));
            hi[ks] = __builtin_amdgcn_ds_read_tr16_b64_v4i16((LAS s16x4*)(vtr + (32 * ks + 4) * LS * 2 + ct * 32));
        }
#pragma unroll
        for (int ks = 0; ks < 4; ++ks) {
            const bf16x8 af = __builtin_shufflevector(lo[ks], hi[ks], 0, 1, 2, 3, 4, 5, 6, 7);
            acc = __builtin_amdgcn_mfma_f32_16x16x32_bf16(af, bw[ks], acc, 0, 0, 0);
        }
        const int c = ct * 16 + fq * 4;
        const u32x2 u = uu[ct];
        u32x2 o; o.x = cvt_pk_bf16(bflo(u.x) * (acc[0] + bs), bfhi(u.x) * (acc[1] + bs)); o.y = cvt_pk_bf16(bflo(u.y) * (acc[2] + bs), bfhi(u.y) * (acc[3] + bs));
        *(u32x2*)(mix + (size_t)(r0 + t) * NMIX + 1536 + g * 128 + c) = o;
    }
}

namespace at {
constexpr int VS = 320;
__device__ __forceinline__ int crow(int r, int hi) { return (r & 3) + 8 * (r >> 2) + 4 * hi; }

template <int DQK, bool CAUSAL>
__device__ __forceinline__ void attn_pass(const bf16_t* __restrict__ Qp, const int ldq, const bf16_t* __restrict__ Kp, const int ldk,
                                          const bf16_t* __restrict__ Vp, const int ldv, const int q0, const int ntiles, const float c2,
                                          const float* lutp, f32x16 (&O)[4], float& lsum_out, unsigned char* smem) {
    constexpr int KS = DQK * 2 + 16, KB = 64 * KS, BUF = KB + 64 * VS, NKC = DQK / 64, NKS = DQK / 16;
    const int tid = opaque_tid(), wid = tid >> 6, lane = tid & 63, l31 = lane & 31, hi = lane >> 5;
    const int krow = (DQK == 64) ? (tid >> 3) : (tid >> 4), kch = (DQK == 64) ? (tid & 7) : (tid & 15);
    const int vrow = tid >> 4, vch = tid & 15;
    u32x4 kr[NKC], vr[2];
#define AT_GLOAD(j) do { const int k0_ = (j) * 64; \
        for (int i_ = 0; i_ < NKC; ++i_) kr[i_] = *(const u32x4*)(Kp + (size_t)(k0_ + krow + 32 * i_) * ldk + kch * 8); \
        for (int i_ = 0; i_ < 2; ++i_) vr[i_] = *(const u32x4*)(Vp + (size_t)(k0_ + vrow + 32 * i_) * ldv + vch * 8); } while (0)
#define AT_LSTORE(buf) do { \
        for (int i_ = 0; i_ < NKC; ++i_) *(u32x4*)((buf) + (krow + 32 * i_) * KS + kch * 16) = kr[i_]; \
        for (int i_ = 0; i_ < 2; ++i_) *(u32x4*)((buf) + KB + (vrow + 32 * i_) * VS + vch * 16) = vr[i_]; } while (0)
    bf16x8 qf[NKS];
#pragma unroll
    for (int ks = 0; ks < NKS; ++ks) qf[ks] = *(const bf16x8*)(Qp + (size_t)(wid * 32 + l31) * ldq + ks * 16 + hi * 8);
#pragma unroll
    for (int d = 0; d < 4; ++d)
#pragma unroll
        for (int r = 0; r < 16; ++r) O[d][r] = 0.f;
    float m = -1e30f, lsum = 0.f;
    const int qw0 = q0 + wid * 32;
    const int q4 = (lane & 15) >> 2, p4 = lane & 3, blk = (lane >> 4) & 1;
    const int vtr = (4 * hi + q4) * VS + (16 * blk + 4 * p4) * 2;
    __syncthreads();
    AT_GLOAD(0);
    AT_LSTORE(smem);
    __syncthreads();
    const float lut127 = CAUSAL ? lutp[127] : 0.f;
#pragma unroll 1
    for (int j = 0; j < ntiles; ++j) {
        unsigned char* buf = smem + (j & 1) * BUF;
        if (j + 1 < ntiles) AT_GLOAD(j + 1);
        const int k0 = j * 64;
        if (!CAUSAL || k0 <= qw0 + 31) {
            f32x16 st[2];
#pragma unroll
            for (int kt = 0; kt < 2; ++kt)
#pragma unroll
                for (int r = 0; r < 16; ++r) st[kt][r] = 0.f;
            if (DQK == 64) {
                bf16x8 kf[2][NKS];
#pragma unroll
                for (int kt = 0; kt < 2; ++kt)
#pragma unroll
                    for (int ks = 0; ks < NKS; ++ks) kf[kt][ks] = *(const bf16x8*)(buf + (kt * 32 + l31) * KS + (ks * 16 + hi * 8) * 2);
                __builtin_amdgcn_sched_barrier(0);
#pragma unroll
                for (int ks = 0; ks < NKS; ++ks)
#pragma unroll
                    for (int kt = 0; kt < 2; ++kt) st[kt] = __builtin_amdgcn_mfma_f32_32x32x16_bf16(kf[kt][ks], qf[ks], st[kt], 0, 0, 0);
                __builtin_amdgcn_sched_barrier(0);
            } else {
#pragma unroll
                for (int kt = 0; kt < 2; ++kt) {
                    bf16x8 kf[NKS];
#pragma unroll
                    for (int ks = 0; ks < NKS; ++ks) kf[ks] = *(const bf16x8*)(buf + (kt * 32 + l31) * KS + (ks * 16 + hi * 8) * 2);
                    __builtin_amdgcn_sched_barrier(0);
#pragma unroll
                    for (int ks = 0; ks < NKS; ++ks) st[kt] = __builtin_amdgcn_mfma_f32_32x32x16_bf16(kf[ks], qf[ks], st[kt], 0, 0, 0);
                    __builtin_amdgcn_sched_barrier(0);
                }
            }
            const bool unif = !CAUSAL || (qw0 - (k0 + 63) >= 127);
            float pmax;
            if (unif) {
                pmax = st[0][0];
#pragma unroll
                for (int r = 1; r < 16; ++r) pmax = fmaxf(pmax, st[0][r]);
#pragma unroll
                for (int r = 0; r < 16; ++r) pmax = fmaxf(pmax, st[1][r]);
                pmax = fmaf(pmax, c2, lut127);
            } else {
                const int tq = qw0 + l31;
                pmax = -__builtin_inff();
                float bias[2][16];
#pragma unroll
                for (int kt = 0; kt < 2; ++kt)
#pragma unroll
                    for (int r = 0; r < 16; ++r) {
                        const int dd = tq - (k0 + 32 * kt + crow(r, hi));
                        bias[kt][r] = lutp[dd < 0 ? 0 : (dd > 127 ? 127 : dd)];
                    }
                __builtin_amdgcn_sched_barrier(0);
#pragma unroll
                for (int kt = 0; kt < 2; ++kt)
#pragma unroll
                    for (int r = 0; r < 16; ++r) {
                        const int dd = tq - (k0 + 32 * kt + crow(r, hi));
                        st[kt][r] = dd < 0 ? -__builtin_inff() : fmaf(st[kt][r], c2, bias[kt][r]);
                        pmax = fmaxf(pmax, st[kt][r]);
                    }
            }
            pmax = fmaxf(pmax, __shfl_xor(pmax, 32, 64));
            if (!__all(pmax - m <= 8.0f)) {
                const float mn = fmaxf(m, pmax);
                const float alpha = fast_exp2(m - mn);
                m = mn;
                lsum *= alpha;
#pragma unroll
                for (int d = 0; d < 4; ++d)
#pragma unroll
                    for (int r = 0; r < 16; ++r) O[d][r] *= alpha;
            }
            typedef float f32x2_ __attribute__((ext_vector_type(2)));
            f32x2_ ps2 = {0.f, 0.f};
            const float off = unif ? lut127 - m : -m, csc = unif ? c2 : 1.0f;
            const f32x2_ off2 = {off, off}, csc2 = {csc, csc};
            bf16x8 pf[2][2];
#define AT_EXP(kt) do { _Pragma("unroll") for (int r = 0; r < 16; r += 2) { f32x2_ z_ = {st[kt][r], st[kt][r + 1]}; z_ = __builtin_elementwise_fma(z_, csc2, off2); \
                    f32x2_ e_ = {fast_exp2(z_.x), fast_exp2(z_.y)}; st[kt][r] = e_.x; st[kt][r + 1] = e_.y; ps2 += e_; } \
                _Pragma("unroll") for (int s_ = 0; s_ < 2; ++s_) { \
                    u32x4 w; w.x = cvt_pk_bf16(st[kt][8 * s_ + 0], st[kt][8 * s_ + 1]); w.y = cvt_pk_bf16(st[kt][8 * s_ + 2], st[kt][8 * s_ + 3]); \
                    w.z = cvt_pk_bf16(st[kt][8 * s_ + 4], st[kt][8 * s_ + 5]); w.w = cvt_pk_bf16(st[kt][8 * s_ + 6], st[kt][8 * s_ + 7]); \
                    pf[kt][s_] = *reinterpret_cast<bf16x8*>(&w); } } while (0)
            const unsigned char* vb = buf + KB + vtr;
#define AT_LOADV(dst, q_) do { _Pragma("unroll") for (int d_ = 0; d_ < 4; ++d_) { \
                dst[2 * d_]     = __builtin_amdgcn_ds_read_tr16_b64_v4i16((LAS s16x4*)(vb + (16 * (q_)) * VS + d_ * 64)); \
                dst[2 * d_ + 1] = __builtin_amdgcn_ds_read_tr16_b64_v4i16((LAS s16x4*)(vb + (16 * (q_) + 8) * VS + d_ * 64)); } } while (0)
#define AT_PV(src, q_) do { _Pragma("unroll") for (int d_ = 0; d_ < 4; ++d_) { \
                const bf16x8 vf_ = __builtin_shufflevector(src[2 * d_], src[2 * d_ + 1], 0, 1, 2, 3, 4, 5, 6, 7); \
                O[d_] = __builtin_amdgcn_mfma_f32_32x32x16_bf16(vf_, pf[(q_) >> 1][(q_) & 1], O[d_], 0, 0, 0); } } while (0)
            s16x4 va[8], vc[8];
            AT_LOADV(va, 0); AT_LOADV(vc, 1);
            AT_EXP(0);
            __builtin_amdgcn_sched_barrier(0);
            __builtin_amdgcn_s_waitcnt(0xC07F);
            AT_PV(va, 0); AT_PV(vc, 1);
            AT_EXP(1);
#pragma unroll
            for (int i_ = 0; i_ < 8; ++i_) { __builtin_amdgcn_sched_group_barrier(0x008, 1, 0); __builtin_amdgcn_sched_group_barrier(0x002, 7, 0); }
            __builtin_amdgcn_sched_barrier(0);
            lsum += ps2.x + ps2.y;
            AT_LOADV(va, 2); AT_LOADV(vc, 3); __builtin_amdgcn_sched_barrier(0);
            AT_PV(va, 2);    __builtin_amdgcn_sched_barrier(0);
            AT_PV(vc, 3);    __builtin_amdgcn_sched_barrier(0);
#undef AT_EXP
#undef AT_LOADV
#undef AT_PV
        }
        if (j + 1 < ntiles) AT_LSTORE(smem + ((j + 1) & 1) * BUF);
        __syncthreads();
    }
    lsum_out = lsum + __shfl_xor(lsum, 32, 64);
#undef AT_GLOAD
#undef AT_LSTORE
}
constexpr int LDS_LUT_A = 2 * (64 * (64 * 2 + 16) + 64 * VS);

__device__ void attnA_unit(const Params& p, int unit, unsigned char* smem) {
    const int qblk = 15 - unit / 48, rem = unit % 48, bh = rem >> 1, map = rem & 1, b = bh / 6, h = bh % 6;
    const int tid = opaque_tid(), wid = tid >> 6, lane = tid & 63, l31 = lane & 31, hi = lane >> 5;
    const bf16_t* proj = (const bf16_t*)(p.ws + WS_PROJ);
    const size_t rowb = (size_t)b * SEQ;
    const int q0 = qblk * 256;
    float* lut = (float*)(smem + LDS_LUT_A);
    __syncthreads();
    if (tid < 128) lut[tid] = ((const float*)(p.ws + WS_LUT))[h * 128 + tid];
    f32x16 O[4]; float lsum;
    attn_pass<64, true>(proj + (rowb + q0) * NPROJ + OFF_QA + h * 128 + map * 64, NPROJ, proj + rowb * NPROJ + OFF_KA + h * 128 + map * 64, NPROJ,
                        proj + rowb * NPROJ + OFF_VA + h * 128, NPROJ, q0, 4 * (qblk + 1), 0.125f * LOG2E, lut, O, lsum, smem);
    const float inv = 1.0f / lsum;
    bf16_t* orow = map == 0 ? (bf16_t*)(p.ws + WS_MIX) + (rowb + q0 + wid * 32 + l31) * NMIX + h * 128
                            : (bf16_t*)p.out + (rowb + q0 + wid * 32 + l31) * 768 + h * 128;
#pragma unroll
    for (int d = 0; d < 4; ++d)
#pragma unroll
        for (int g = 0; g < 4; ++g) {
            const int dv0 = 32 * d + 8 * g + 4 * hi;
            u32x2 w; w.x = cvt_pk_bf16(O[d][4 * g] * inv, O[d][4 * g + 1] * inv); w.y = cvt_pk_bf16(O[d][4 * g + 2] * inv, O[d][4 * g + 3] * inv);
            *(u32x2*)(orow + dv0) = w;
        }
}
__device__ void attnA_combine(const Params& p, int l, int unit) {
    const int tid = opaque_tid(), sub = tid & 15, grp = tid >> 4;
    const float lam = ((const float*)(p.ws + WS_LAM))[l];
    const float lam_init = 0.8f - 0.6f * expf(-0.3f * (float)l);
    const float* sg = p.in[8] + (size_t)l * 128 + sub * 8;
    const f32x4 g0 = *(const f32x4*)sg, g1 = *(const f32x4*)(sg + 4);
    bf16_t* mix = (bf16_t*)(p.ws + WS_MIX); const bf16_t* oa1 = (const bf16_t*)p.out;
    constexpr int NPAIR = 64 * 6;
    u32x4 na, nc;
    { const size_t row = (size_t)unit * 64 + grp / 6; const int h = grp % 6; na = *(const u32x4*)(mix + row * NMIX + h * 128 + sub * 8); nc = *(const u32x4*)(oa1 + row * 768 + h * 128 + sub * 8); }
    for (int pr = grp; pr < NPAIR; pr += 32) {
        const size_t row = (size_t)unit * 64 + pr / 6; const int h = pr % 6;
        bf16_t* mp = mix + row * NMIX + h * 128 + sub * 8;
        const u32x4 a = na, c = nc;
        if (pr + 32 < NPAIR) { const size_t row2 = (size_t)unit * 64 + (pr + 32) / 6; const int h2 = (pr + 32) % 6;
            na = *(const u32x4*)(mix + row2 * NMIX + h2 * 128 + sub * 8); nc = *(const u32x4*)(oa1 + row2 * 768 + h2 * 128 + sub * 8); }
        float o[8] = {bflo(a.x) - lam * bflo(c.x), bfhi(a.x) - lam * bfhi(c.x), bflo(a.y) - lam * bflo(c.y), bfhi(a.y) - lam * bfhi(c.y),
                      bflo(a.z) - lam * bflo(c.z), bfhi(a.z) - lam * bfhi(c.z), bflo(a.w) - lam * bflo(c.w), bfhi(a.w) - lam * bfhi(c.w)};
        float ss = 0.f;
#pragma unroll
        for (int i = 0; i < 8; ++i) ss += o[i] * o[i];
        ss += __shfl_xor(ss, 1, 64); ss += __shfl_xor(ss, 2, 64); ss += __shfl_xor(ss, 4, 64); ss += __shfl_xor(ss, 8, 64);
        const float rn = rsqrtf(ss * (1.0f / 128.0f) + EPS) * (1.0f - lam_init);
        u32x4 w; w.x = cvt_pk_bf16(o[0] * rn * g0[0], o[1] * rn * g0[1]); w.y = cvt_pk_bf16(o[2] * rn * g0[2], o[3] * rn * g0[3]);
        w.z = cvt_pk_bf16(o[4] * rn * g1[0], o[5] * rn * g1[1]); w.w = cvt_pk_bf16(o[6] * rn * g1[2], o[7] * rn * g1[3]);
        *(u32x4*)mp = w;
    }
}

__device__ void attnX_unit(const Params& p, int unit, unsigned char* smem) {
    const int qblk = unit & 15, bh = unit >> 4, b = bh >> 2, h = bh & 3;
    const int tid = opaque_tid(), wid = tid >> 6, lane = tid & 63, l31 = lane & 31, hi = lane >> 5;
    const bf16_t* xq = (const bf16_t*)(p.ws + WS_XQ);
    const bf16_t* kvx = (const bf16_t*)(p.ws + WS_KVX);
    const size_t row0 = (size_t)b * SEQ + qblk * 256;
    f32x16 O[4]; float lsum;
    attn_pass<128, false>(xq + row0 * 512 + h * 128, 512, kvx + (size_t)b * MEMLEN * 1024 + h * 128, 1024, kvx + (size_t)b * MEMLEN * 1024 + 512 + h * 128, 1024,
                          0, 4, 0.08838834764831845f * LOG2E, nullptr, O, lsum, smem);
    const float inv = 1.0f / lsum;
    bf16_t* orow = (bf16_t*)(p.ws + WS_XO) + (row0 + wid * 32 + l31) * 512 + h * 128;
#pragma unroll
    for (int d = 0; d < 4; ++d)
#pragma unroll
        for (int g = 0; g < 4; ++g) {
            const int dv0 = 32 * d + 8 * g + 4 * hi;
            u32x2 w; w.x = cvt_pk_bf16(O[d][4 * g] * inv, O[d][4 * g + 1] * inv); w.y = cvt_pk_bf16(O[d][4 * g + 2] * inv, O[d][4 * g + 3] * inv);
            *(u32x2*)(orow + dv0) = w;
        }
}
}

namespace ix {
constexpr int RS = 8208;
constexpr int LDS_STAGE = 16 * RS;
constexpr int LDS_HIST = LDS_STAGE + 8 * 512;
constexpr int HS = 257;
constexpr int LDS_DUMMY = LDS_HIST + 16 * HS * 4;
static_assert(LDS_DUMMY + 8 * 256 <= LDS_CTL, "indexer LDS");
__device__ __forceinline__ unsigned wave_sum_u(unsigned v) { return (unsigned)__builtin_amdgcn_readlane(wave_iscan_i((int)v), 63); }
__device__ __forceinline__ unsigned wave_excl_scan(unsigned v, int lane) { return (unsigned)wave_iscan_i((int)v) - v; }
__device__ void indexer_unit(const Params& p, int b, int qt, unsigned char* smem) {
    const int tid = opaque_tid(), wid = tid >> 6, lane = tid & 63, fr = lane & 15, fq = lane >> 4;
    const int q0 = qt * 16;
    const size_t rowb = (size_t)b * SEQ;
    unsigned short* idxg = (unsigned short*)(p.ws + WS_IDX);
    __syncthreads();
    if (qt < 16) {
        for (int e = tid; e < 16 * 128; e += NTHREADS) { const int r = e >> 7, c = (e & 127) * 2; *(unsigned*)(idxg + (rowb + q0 + r) * TOPK + c) = (unsigned)c | ((unsigned)(c + 1) << 16); }
        return;
    }
    const bf16_t* proj = (const bf16_t*)(p.ws + WS_PROJ);
    const bf16_t* qb = (const bf16_t*)(p.ws + WS_QB);
    const int nkt = qt + 1;
    unsigned* hist = (unsigned*)(smem + LDS_HIST);
#if IX_HIST & 1
    for (int e = tid; e < 16 * HS; e += NTHREADS) hist[e] = 0u;
    __syncthreads();
#endif
    {
        bf16x8 qf[16][2];
        const bf16_t* qrow = qb + (rowb + q0 + fr) * NQB + 1536 + fq * 8;
#pragma unroll
        for (int g = 0; g < 16; ++g)
#pragma unroll
            for (int ks = 0; ks < 2; ++ks) qf[g][ks] = *(const bf16x8*)(qrow + g * 64 + ks * 32);
        unsigned wp[8];
        {
            const u32x4 a = *(const u32x4*)(proj + (rowb + q0 + fr) * NPROJ + OFF_WIDX), c = *(const u32x4*)(proj + (rowb + q0 + fr) * NPROJ + OFF_WIDX + 8);
            wp[0] = a.x; wp[1] = a.y; wp[2] = a.z; wp[3] = a.w; wp[4] = c.x; wp[5] = c.y; wp[6] = c.z; wp[7] = c.w;
        }
        bf16x8 qc[2];
#pragma unroll
        for (int ks = 0; ks < 2; ++ks) {
            float a8[8] = {0.f, 0.f, 0.f, 0.f, 0.f, 0.f, 0.f, 0.f};
#pragma unroll
            for (int g = 0; g < 16; ++g) {
                const float wg = (g & 1) ? bfhi(wp[g >> 1]) : bflo(wp[g >> 1]);
                const u32x4 qv = *reinterpret_cast<const u32x4*>(&qf[g][ks]);
                a8[0] = fmaf(wg, bflo(qv.x), a8[0]); a8[1] = fmaf(wg, bfhi(qv.x), a8[1]); a8[2] = fmaf(wg, bflo(qv.y), a8[2]); a8[3] = fmaf(wg, bfhi(qv.y), a8[3]);
                a8[4] = fmaf(wg, bflo(qv.z), a8[4]); a8[5] = fmaf(wg, bfhi(qv.z), a8[5]); a8[6] = fmaf(wg, bflo(qv.w), a8[6]); a8[7] = fmaf(wg, bfhi(qv.w), a8[7]);
            }
            u32x4 o4; o4.x = cvt_pk_bf16(a8[0], a8[1]); o4.y = cvt_pk_bf16(a8[2], a8[3]); o4.z = cvt_pk_bf16(a8[4], a8[5]); o4.w = cvt_pk_bf16(a8[6], a8[7]);
            qc[ks] = *reinterpret_cast<bf16x8*>(&o4);
        }
        const bf16_t* kbase = proj + (rowb + fr) * NPROJ + OFF_KIDX + fq * 8;
        bf16x8 af0, af1;
        for (int rep_ = 0; rep_ < (PROBE_SUB == 1 ? 2 : 1); ++rep_) {
        bf16x8 ag0 = af0, ag1 = af1;
        if (wid < nkt) { af0 = *(const bf16x8*)(kbase + (size_t)wid * 16 * NPROJ); af1 = *(const bf16x8*)(kbase + (size_t)wid * 16 * NPROJ + 32); }
        if (wid + 8 < nkt) { ag0 = *(const bf16x8*)(kbase + (size_t)(wid + 8) * 16 * NPROJ); ag1 = *(const bf16x8*)(kbase + (size_t)(wid + 8) * 16 * NPROJ + 32); }
        for (int kt = wid; kt < nkt; kt += 8) {
            const bf16x8 a0 = af0, a1 = af1;
            af0 = ag0; af1 = ag1;
            if (kt + 16 < nkt) { ag0 = *(const bf16x8*)(kbase + (size_t)(kt + 16) * 16 * NPROJ); ag1 = *(const bf16x8*)(kbase + (size_t)(kt + 16) * 16 * NPROJ + 32); }
            f32x4 sc = {0.f, 0.f, 0.f, 0.f};
            sc = __builtin_amdgcn_mfma_f32_16x16x32_bf16(a0, qc[0], sc, 0, 0, 0);
            sc = __builtin_amdgcn_mfma_f32_16x16x32_bf16(a1, qc[1], sc, 0, 0, 0);
            f32x4 dc = {0.f, 0.f, 0.f, 0.f};
            dc = __builtin_amdgcn_mfma_f32_16x16x32_bf16(a0, qf[0][0], dc, 0, 0, 0);
            dc = __builtin_amdgcn_mfma_f32_16x16x32_bf16(a1, qf[0][1], dc, 0, 0, 0);
            __builtin_amdgcn_sched_barrier(0);
#pragma unroll
            for (int g = 0; g < 16; ++g) {
                f32x4 dn = {0.f, 0.f, 0.f, 0.f};
                if (g < 15) {
                    dn = __builtin_amdgcn_mfma_f32_16x16x32_bf16(a0, qf[g + 1][0], dn, 0, 0, 0);
                    dn = __builtin_amdgcn_mfma_f32_16x16x32_bf16(a1, qf[g + 1][1], dn, 0, 0, 0);
                }
                __builtin_amdgcn_sched_barrier(0);
                const float wg = (g & 1) ? bfhi(wp[g >> 1]) : bflo(wp[g >> 1]);
                if (g < 15) {
                    asm volatile("v_fma_f32 %0, %4, |%5|, %0\n\tv_fma_f32 %1, %4, |%6|, %1\n\tv_fma_f32 %2, %4, |%7|, %2\n\tv_fma_f32 %3, %4, |%8|, %3"
                                 : "+v"(sc[0]), "+v"(sc[1]), "+v"(sc[2]), "+v"(sc[3]) : "v"(wg), "v"(dc[0]), "v"(dc[1]), "v"(dc[2]), "v"(dc[3]));
                } else {
                    asm volatile("s_nop 7\n\ts_nop 7\n\tv_fma_f32 %0, %4, |%5|, %0\n\tv_fma_f32 %1, %4, |%6|, %1\n\tv_fma_f32 %2, %4, |%7|, %2\n\tv_fma_f32 %3, %4, |%8|, %3"
                                 : "+v"(sc[0]), "+v"(sc[1]), "+v"(sc[2]), "+v"(sc[3]) : "v"(wg), "v"(dc[0]), "v"(dc[1]), "v"(dc[2]), "v"(dc[3]));
                }
                __builtin_amdgcn_sched_barrier(0);
                dc = dn;
            }
            if (kt == qt) {
#pragma unroll
                for (int r = 0; r < 4; ++r) if (4 * fq + r > fr) sc[r] = -__builtin_inff();
            }
            unsigned x0 = __builtin_bit_cast(unsigned, __builtin_amdgcn_cvt_pkrtz(sc[0], sc[1]));
            unsigned x1 = __builtin_bit_cast(unsigned, __builtin_amdgcn_cvt_pkrtz(sc[2], sc[3]));
            x0 ^= (((x0 >> 15) & 0x00010001u) * 0xFFFFu) | 0x80008000u; x1 ^= (((x1 >> 15) & 0x00010001u) * 0xFFFFu) | 0x80008000u;
            u32x2 o; o.x = (x0 >> 1) & 0x7FFF7FFFu; o.y = (x1 >> 1) & 0x7FFF7FFFu;
            *(u32x2*)(smem + fr * RS + (kt * 16 + 4 * fq) * 2) = o;
#if IX_HIST & 2
            {
                unsigned* hq = hist + fr * HS;
                unsigned one;
                asm volatile("v_mov_b32 %0, 1" : "=v"(one));
                __hip_atomic_fetch_add(hq + ((o.x >> 7) & 0xFFu), one, __ATOMIC_RELAXED, __HIP_MEMORY_SCOPE_WORKGROUP);
                __hip_atomic_fetch_add(hq + (o.x >> 23), one, __ATOMIC_RELAXED, __HIP_MEMORY_SCOPE_WORKGROUP);
                __hip_atomic_fetch_add(hq + ((o.y >> 7) & 0xFFu), one, __ATOMIC_RELAXED, __HIP_MEMORY_SCOPE_WORKGROUP);
                __hip_atomic_fetch_add(hq + (o.y >> 23), one, __ATOMIC_RELAXED, __HIP_MEMORY_SCOPE_WORKGROUP);
            }
#endif
        }
        }
    }
    __syncthreads();
    unsigned short* stage = (unsigned short*)(smem + LDS_STAGE + wid * 512);
    for (int rr = 0; rr < (PROBE_SUB == 2 ? 4 : 2); ++rr) {
        const int qi = wid * 2 + (rr & 1);
        const unsigned char* rowp = smem + qi * RS;
        const int nch = nkt * 4;
        const int nsl = __builtin_amdgcn_readfirstlane((nch + 63) >> 6);
        unsigned kreg[32];
#pragma unroll
        for (int i = 0; i < 16; ++i) {
            const int c = lane + 64 * i;
            const u32x2 v = *(const u32x2*)(rowp + c * 8);
            const bool ok = c < nch;
            kreg[2 * i] = ok ? v.x : 0u; kreg[2 * i + 1] = ok ? v.y : 0u;
        }
        unsigned T;
        {
            const unsigned* hp = hist + qi * HS + lane * 4;
            u32x4 hv; hv.x = hp[0]; hv.y = hp[1]; hv.z = hp[2]; hv.w = hp[3];
            const unsigned s4 = (hv.x + hv.y) + (hv.z + hv.w);
            const unsigned pin = (unsigned)wave_iscan_i((int)s4);
            const unsigned tot = (unsigned)__builtin_amdgcn_readlane((int)pin, 63);
            const unsigned above = tot - pin;
            const unsigned long long mk = __builtin_amdgcn_ballot_w64(above + s4 >= (unsigned)TOPK);
            const int L = 63 - __builtin_clzll(mk);
            const unsigned a3 = above + hv.w, a2 = a3 + hv.z, a1 = a2 + hv.y;
            const unsigned bo = a3 >= (unsigned)TOPK ? 3u : (a2 >= (unsigned)TOPK ? 2u : (a1 >= (unsigned)TOPK ? 1u : 0u));
            T = ((unsigned)(4 * L) + (unsigned)__builtin_amdgcn_readlane((int)bo, L)) << 7;
#if IX_CHECK & 1
            if (tot != (unsigned)(16 * nkt)) *(unsigned short*)(p.ws + WS_H16) = 0x7FC0;
#endif
        }
        const int ngr = nsl > 12 ? 16 : (nsl > 8 ? 12 : 8);
        const int ntot = ngr * 256;
#define IX_G4(B, g) { B(4 * (g)) B(4 * (g) + 1) B(4 * (g) + 2) B(4 * (g) + 3) }
#define IX_SW(B) { IX_G4(B, 0) IX_G4(B, 1) if (nsl > 8) { asm volatile(""); IX_G4(B, 2) if (nsl > 12) { asm volatile(""); IX_G4(B, 3) } } }
#define IX_SAD(i) { f0 = __builtin_amdgcn_sad_u16(kreg[2 * (i)], c0, f0); f1 = __builtin_amdgcn_sad_u16(kreg[2 * (i)], c1, f1); \
                    f0 = __builtin_amdgcn_sad_u16(kreg[2 * (i) + 1], c0, f0); f1 = __builtin_amdgcn_sad_u16(kreg[2 * (i) + 1], c1, f1); }
#pragma unroll 1
        for (int bit = 6; bit >= 0; --bit) {
            const unsigned cand = T | (1u << bit);
            const unsigned c1 = cand * 0x10001u, c0 = (cand - 1u) * 0x10001u;
            unsigned f0 = 0, f1 = 0;
            IX_SW(IX_SAD)
            const int dsum = __builtin_amdgcn_readlane(wave_iscan_i((int)f0 - (int)f1), 63);
            if (ntot + dsum >= 2 * TOPK) T = cand;
        }
        unsigned cg, ce;
        {
            const unsigned c0 = (T - 1u) * 0x10001u, c1 = T * 0x10001u, c2 = (T + 1u) * 0x10001u;
            unsigned f0 = 0, f1 = 0, f2 = 0;
#define IX_SAD3(i) { f0 = __builtin_amdgcn_sad_u16(kreg[2 * (i)], c0, f0); f1 = __builtin_amdgcn_sad_u16(kreg[2 * (i)], c1, f1); f2 = __builtin_amdgcn_sad_u16(kreg[2 * (i)], c2, f2); \
                     f0 = __builtin_amdgcn_sad_u16(kreg[2 * (i) + 1], c0, f0); f1 = __builtin_amdgcn_sad_u16(kreg[2 * (i) + 1], c1, f1); f2 = __builtin_amdgcn_sad_u16(kreg[2 * (i) + 1], c2, f2); }
            IX_SW(IX_SAD3)
            cg = (unsigned)(ngr * 4 + (int)f1 - (int)f2) >> 1;
            ce = ((unsigned)(ngr * 4 + (int)f0 - (int)f1) >> 1) - cg;
        }
        const unsigned cgt = wave_sum_u(cg);
        unsigned pg = wave_excl_scan(cg, lane);
        unsigned pe = wave_excl_scan(ce, lane);
        const unsigned need = (unsigned)TOPK - cgt;
        const unsigned didx = (unsigned)((LDS_DUMMY + wid * 256) - (LDS_STAGE + wid * 512)) / 2u + 2u * (unsigned)lane;
#define IX_PUT(i) { _Pragma("unroll") for (int e = 0; e < 4; ++e) { \
                    const unsigned w2 = kreg[2 * (i) + (e >> 1)]; const unsigned k15 = (e & 1) ? (w2 >> 16) : (w2 & 0xFFFFu); \
                    const bool gt = k15 > T, eq = k15 == T; \
                    const unsigned te = eq ? pe : ~0u; \
                    const unsigned ix = gt ? pg : (te < need ? cgt + pe : didx); \
                    stage[ix] = (unsigned short)(lane * 4 + (i) * 256 + e); \
                    pg += gt ? 1u : 0u; pe += eq ? 1u : 0u; } }
        IX_SW(IX_PUT)
#undef IX_SAD3
#undef IX_PUT
#undef IX_SW
#undef IX_G4
#undef IX_SAD
        asm volatile("s_waitcnt lgkmcnt(0)" ::: "memory");
        const u32x2 o = *(const u32x2*)(stage + lane * 4);
        *(u32x2*)(idxg + (rowb + q0 + qi) * TOPK + lane * 4) = o;
        asm volatile("s_waitcnt lgkmcnt(0)" ::: "memory");
    }
}
}

namespace bt {
constexpr int BUF_BYTES = 32 * 256;
constexpr int WAVE_BYTES = 2 * BUF_BYTES;
constexpr int LDS_IST = 8 * WAVE_BYTES;
constexpr int LDS_LUT = LDS_IST + 8 * 512;
typedef int v2i __attribute__((ext_vector_type(2)));
__device__ __forceinline__ int swz(int k) { return (k & 15) ^ (8 * (k >> 4)); }
__device__ void battn_rows(const Params& p, unsigned char* smem) {
    const int tid = opaque_tid(), wid = tid >> 6, lane = tid & 63, hh = lane & 15, kg = lane >> 4;
    const bool hv = hh < 6;
    const bf16_t* qb = (const bf16_t*)(p.ws + WS_QB);
    const unsigned char* ckv8 = p.ws + WS_CKVN;
    const unsigned short* idxg = (const unsigned short*)(p.ws + WS_IDX);
    bf16_t* mix = (bf16_t*)(p.ws + WS_MIX);
    unsigned char* cs = smem + wid * WAVE_BYTES;
    const unsigned csa = (unsigned)__builtin_amdgcn_readfirstlane((int)(unsigned)(size_t)(LAS unsigned char*)cs);
    unsigned short* ist = (unsigned short*)(smem + LDS_IST + wid * 512);
    float* lut = (float*)(smem + LDS_LUT);
    __syncthreads();
    for (int e = tid; e < 6 * 128; e += NTHREADS) lut[e] = ((const float*)(p.ws + WS_LUT))[6 * 128 + e];
    __syncthreads();
    const float* lrow = lut + (hv ? hh : 0) * 128;
    const int qk0 = hh * 256 + 8 * (kg & 1), qk1 = (16 + hh) * 256 + 8 * (kg & 1), qs0 = swz(hh), qs1 = swz(16 + hh), qc = kg >> 1;
    const int tq = hh >> 1, tkey = tq < 4 ? 4 * kg + tq : 16 + 4 * kg + (tq - 4), tr0 = tkey * 256 + 8 * (hh & 1), ts = swz(tkey);
    const int dsub = lane >> 4, dpos = lane & 15;
    unsigned lp[8];
#pragma unroll
    for (int i = 0; i < 8; ++i) lp[i] = (unsigned)((dpos ^ swz(4 * i + dsub)) * 16);
    const unsigned ista = (unsigned)(size_t)(LAS unsigned short*)ist;
    const unsigned idma = ista + 2u * (unsigned)dsub, ibia = ista + 8u * (unsigned)kg;
    unsigned aq0[8], aq1[8], av[16];
#pragma unroll
    for (int ks = 0; ks < 8; ++ks) { aq0[ks] = csa + (unsigned)(qk0 + (((2 * ks + qc) ^ qs0) << 4)); aq1[ks] = csa + (unsigned)(qk1 + (((2 * ks + qc) ^ qs1) << 4)); }
#pragma unroll
    for (int d = 0; d < 16; ++d) av[d] = csa + (unsigned)(tr0 + ((d ^ ts) << 4));
    for (int row = blockIdx.x * 8 + wid; row < MTOK; row += gridDim.x * 8) {
        const int t = row & (SEQ - 1);
        const size_t rowb = (size_t)(row - t);
        const int nvalid = __builtin_amdgcn_readfirstlane(t + 1 < TOPK ? t + 1 : TOPK);
        const int nchunks = __builtin_amdgcn_readfirstlane((nvalid + 31) >> 5);
        *(u32x2*)(ist + lane * 4) = *(const u32x2*)(idxg + (size_t)row * TOPK + lane * 4);
        long qlf[8];
#pragma unroll
        for (int ks = 0; ks < 8; ++ks) {
            u32x4 qv = {0u, 0u, 0u, 0u};
            if (hv) qv = *(const u32x4*)(qb + (size_t)row * NQB + hh * 256 + ks * 32 + kg * 8);
            int lo = __builtin_amdgcn_cvt_pk_fp8_f32(bflo(qv.x) * 16.f, bfhi(qv.x) * 16.f, 0, false); lo = __builtin_amdgcn_cvt_pk_fp8_f32(bflo(qv.y) * 16.f, bfhi(qv.y) * 16.f, lo, true);
            int hi2 = __builtin_amdgcn_cvt_pk_fp8_f32(bflo(qv.z) * 16.f, bfhi(qv.z) * 16.f, 0, false); hi2 = __builtin_amdgcn_cvt_pk_fp8_f32(bflo(qv.w) * 16.f, bfhi(qv.w) * 16.f, hi2, true);
            qlf[ks] = (long)(((unsigned long long)(unsigned)hi2 << 32) | (unsigned)lo);
        }
        f32x4 O[16];
#pragma unroll
        for (int d = 0; d < 16; ++d) O[d] = (f32x4){0.f, 0.f, 0.f, 0.f};
        float m = -1e30f, lsum = 0.f;
        unsigned long long gb;
        {
            const unsigned long long ga = (unsigned long long)(size_t)(ckv8 + rowb * 256);
            gb = ((unsigned long long)(unsigned)__builtin_amdgcn_readfirstlane((int)(unsigned)(ga >> 32)) << 32) | (unsigned)__builtin_amdgcn_readfirstlane((int)(unsigned)ga);
        }
#define BT_DMA(c, ldsa) do { unsigned ia_ = idma + (unsigned)(c) * 64u; asm volatile("" : "+v"(ia_)); unsigned o_[8]; \
            _Pragma("unroll") for (int i_ = 0; i_ < 8; ++i_) o_[i_] = (unsigned)*(const LAS unsigned short*)(size_t)(ia_ + 8u * i_); \
            __builtin_amdgcn_s_waitcnt(0xC07F);                   \
            _Pragma("unroll") for (int i_ = 0; i_ < 8; ++i_) o_[i_] = (o_[i_] << 8) + lp[i_]; \
            unsigned sv_; \
            asm volatile("s_mov_b32 %0, m0\n\ts_mov_b32 m0, %10\n\ts_nop 0\n\tglobal_load_lds_dwordx4 %1, %9\n\t" \
                         "s_add_u32 m0, m0, 0x400\n\ts_nop 0\n\tglobal_load_lds_dwordx4 %2, %9\n\t" \
                         "s_add_u32 m0, m0, 0x400\n\ts_nop 0\n\tglobal_load_lds_dwordx4 %3, %9\n\t" \
                         "s_add_u32 m0, m0, 0x400\n\ts_nop 0\n\tglobal_load_lds_dwordx4 %4, %9\n\t" \
                         "s_add_u32 m0, m0, 0x400\n\ts_nop 0\n\tglobal_load_lds_dwordx4 %5, %9\n\t" \
                         "s_add_u32 m0, m0, 0x400\n\ts_nop 0\n\tglobal_load_lds_dwordx4 %6, %9\n\t" \
                         "s_add_u32 m0, m0, 0x400\n\ts_nop 0\n\tglobal_load_lds_dwordx4 %7, %9\n\t" \
                         "s_add_u32 m0, m0, 0x400\n\ts_nop 0\n\tglobal_load_lds_dwordx4 %8, %9\n\t" \
                         "s_mov_b32 m0, %0" \
                         : "=&s"(sv_) : "v"(o_[0]), "v"(o_[1]), "v"(o_[2]), "v"(o_[3]), "v"(o_[4]), "v"(o_[5]), "v"(o_[6]), "v"(o_[7]), "s"(gb), "s"((unsigned)(ldsa)) : "memory", "scc"); } while (0)
        asm volatile("s_waitcnt vmcnt(0) lgkmcnt(0)" ::: "memory");
        BT_DMA(0, csa);
        float bnx[8];
#define BT_BIAS(c) do { unsigned ib_ = ibia + (unsigned)(c) * 64u; asm volatile("" : "+v"(ib_)); \
            _Pragma("unroll") for (int tt_ = 0; tt_ < 2; ++tt_) { const int slot0_ = (c) * 32 + tt_ * 16 + 4 * kg; const u32x2 iv_ = *(const LAS u32x2*)(size_t)(ib_ + 32u * tt_); \
            const unsigned ids_[4] = {iv_.x & 0xFFFFu, iv_.x >> 16, iv_.y & 0xFFFFu, iv_.y >> 16}; \
            _Pragma("unroll") for (int r_ = 0; r_ < 4; ++r_) { int dd_ = t - (int)ids_[r_]; dd_ = dd_ < 0 ? 0 : (dd_ > 127 ? 127 : dd_); \
                bnx[tt_ * 4 + r_] = lrow[dd_]; } } \
            if (nvalid < TOPK) {                                      \
                _Pragma("unroll") for (int e_ = 0; e_ < 8; ++e_) bnx[e_] = ((c) * 32 + (e_ >> 2) * 16 + 4 * kg + (e_ & 3) < nvalid) ? bnx[e_] : -__builtin_inff(); } } while (0)
        BT_BIAS(0);
#define BT_CHUNK(c, B) { \
            if ((c) + 1 < nchunks) { BT_DMA((c) + 1, csa + (1 - (B)) * BUF_BYTES); asm volatile("s_waitcnt vmcnt(8)" ::: "memory"); } \
            else asm volatile("s_waitcnt vmcnt(0)" ::: "memory"); \
            long af[16]; v2i vf[16]; \
            _Pragma("unroll") for (int ks = 0; ks < 8; ++ks) { \
                af[ks]     = *(const LAS long*)(size_t)(aq0[ks] + (B) * BUF_BYTES); \
                af[8 + ks] = *(const LAS long*)(size_t)(aq1[ks] + (B) * BUF_BYTES); } \
            __builtin_amdgcn_sched_barrier(0); \
            __builtin_amdgcn_s_waitcnt(0xC07F); \
            f32x4 s0 = {0.f, 0.f, 0.f, 0.f}, s1 = {0.f, 0.f, 0.f, 0.f}; \
            _Pragma("unroll") for (int ks = 0; ks < 8; ++ks) { \
                s0 = __builtin_amdgcn_mfma_f32_16x16x32_fp8_fp8(af[ks], qlf[ks], s0, 0, 0, 0);                \
                s1 = __builtin_amdgcn_mfma_f32_16x16x32_fp8_fp8(af[8 + ks], qlf[ks], s1, 0, 0, 0); } \
            _Pragma("unroll") for (int d = 0; d < 16; ++d) vf[d] = __builtin_amdgcn_ds_read_tr8_b64_v2i32((LAS v2i*)(size_t)(av[d] + (B) * BUF_BYTES));       \
            __builtin_amdgcn_sched_barrier(0); \
            float z[8]; \
            _Pragma("unroll") for (int r = 0; r < 4; ++r) { z[r] = fmaf(s0[r], LOG2E * (1.0f / 16.0f), bnx[r]); z[4 + r] = fmaf(s1[r], LOG2E * (1.0f / 16.0f), bnx[4 + r]); }       \
            BT_BIAS((c) + 1); \
            float pmax = fmaxf(fmaxf(fmaxf(z[0], z[1]), fmaxf(z[2], z[3])), fmaxf(fmaxf(z[4], z[5]), fmaxf(z[6], z[7]))); \
            if (!__all(pmax - m <= 8.0f)) {                             \
                pmax = fmaxf(pmax, __shfl_xor(pmax, 16, 64)); \
                pmax = fmaxf(pmax, __shfl_xor(pmax, 32, 64)); \
                const float mn = fmaxf(m, pmax); \
                const float alpha = fast_exp2(m - mn); \
                m = mn; lsum *= alpha; \
                _Pragma("unroll") for (int d = 0; d < 16; ++d) O[d] = O[d] * alpha; \
            } \
            _Pragma("unroll") for (int r = 0; r < 8; ++r) { z[r] = fast_exp2(z[r] - m); lsum += z[r]; } \
            int plo = __builtin_amdgcn_cvt_pk_fp8_f32(z[0], z[1], 0, false); plo = __builtin_amdgcn_cvt_pk_fp8_f32(z[2], z[3], plo, true); \
            int phi = __builtin_amdgcn_cvt_pk_fp8_f32(z[4], z[5], 0, false); phi = __builtin_amdgcn_cvt_pk_fp8_f32(z[6], z[7], phi, true); \
            const long pf = (long)(((unsigned long long)(unsigned)phi << 32) | (unsigned)plo); \
            __builtin_amdgcn_s_waitcnt(0xC07F); \
            _Pragma("unroll") for (int d = 0; d < 16; ++d) { \
                O[d] = __builtin_amdgcn_mfma_f32_16x16x32_fp8_fp8(__builtin_bit_cast(long, vf[d]), pf, O[d], 0, 0, 0);                     \
            } }
#pragma unroll 1
        for (int c = 0; c < nchunks; c += 2) {
            BT_CHUNK(c, 0)
            if (c + 1 < nchunks) BT_CHUNK(c + 1, 1)
        }
#undef BT_CHUNK
#undef BT_BIAS
#undef BT_DMA
        lsum += __shfl_xor(lsum, 16, 64);
        lsum += __shfl_xor(lsum, 32, 64);
        const float inv = 1.0f / lsum;
        if (hv) {
            bf16_t* orow = (bf16_t*)(p.ws + WS_OLAT) + ((size_t)hh * MTOK + row) * 256 + 4 * kg;
#pragma unroll
            for (int d = 0; d < 16; ++d) {
                u32x2 w; w.x = cvt_pk_bf16(O[d][0] * inv, O[d][1] * inv); w.y = cvt_pk_bf16(O[d][2] * inv, O[d][3] * inv);
                *(u32x2*)(orow + d * 16) = w;
            }
        }
    }
}
}


#define XB_TMO      128
#define XB_XCNT(j)  (256  + 64 * (j))
#define XB_XSUB(j)  (1280 + 64 * (j))
#define XB_XGEN(j)  (2304 + 64 * (j))
#define XB_TOP      3328
#define XB_TOPGEN   3392
#define XCD_BAR_WORDS 3456
#define XB_SPIN_CAP (1u << 18)

__device__ __forceinline__ unsigned xb_ld(unsigned* p)              { return __hip_atomic_load(p, __ATOMIC_RELAXED, __HIP_MEMORY_SCOPE_AGENT); }
__device__ __forceinline__ unsigned xb_add(unsigned* p, unsigned v) { return __hip_atomic_fetch_add(p, v, __ATOMIC_RELAXED, __HIP_MEMORY_SCOPE_AGENT); }
__device__ __forceinline__ unsigned xb_xcc_id() { return (unsigned)__builtin_amdgcn_s_getreg((3 << 11) | 20) & 0xFu; }
#define XB_SPIN(cond, bar) do { unsigned _sp = 0; while (cond) { __builtin_amdgcn_s_sleep(1); \
    if ((++_sp & 255u) == 0u) { if (xb_ld(&(bar)[XB_TMO])) break; if (_sp > XB_SPIN_CAP) { atomicAdd(&(bar)[XB_TMO], 1u); break; } } } } while (0)

struct XcdBarrier {
    unsigned* bar; unsigned x;
    volatile LAS unsigned* st;
};

__device__ __forceinline__ XcdBarrier xcd_barrier_post(unsigned* bar, volatile LAS unsigned* st) {
    XcdBarrier b; b.bar = bar; b.x = xb_xcc_id(); b.st = st;
    if (threadIdx.x == 0) (void)xb_add(&bar[XB_XCNT(b.x)], 1u);
    return b;
}
__device__ __forceinline__ void xcd_barrier_complete(unsigned* bar, unsigned x, unsigned& nloc, unsigned& nx) {
    const unsigned G = gridDim.x * gridDim.y * gridDim.z;
    unsigned sum, cnt, mine, sp = 0u;
    for (;;) {
        sum = 0u; cnt = 0u; mine = 0u;
#pragma unroll
        for (unsigned j = 0; j < 16; ++j) { const unsigned c = xb_ld(&bar[XB_XCNT(j)]); sum += c; cnt += (c > 0u) ? 1u : 0u; mine = (j == x) ? c : mine; }
        if (sum == G) break;
        __builtin_amdgcn_s_sleep(1);
        if ((++sp & 255u) == 0u) { if (xb_ld(&bar[XB_TMO])) break; if (sp > XB_SPIN_CAP) { atomicAdd(&bar[XB_TMO], 1u); break; } }
    }
    nloc = mine > 0u ? mine : 1u; nx = cnt > 0u ? cnt : 1u;
}

__device__ __forceinline__ void xcd_barrier(const XcdBarrier& b) {
    asm volatile("s_waitcnt vmcnt(0)" ::: "memory");
    __syncthreads();
    if (threadIdx.x == 0) {
        unsigned* bar = b.bar;
        __builtin_amdgcn_s_waitcnt(0);
        unsigned nloc = b.st[0], nx = b.st[1];
        if (nloc == 0u) { xcd_barrier_complete(bar, b.x, nloc, nx); b.st[0] = nloc; b.st[1] = nx; }
        const unsigned old = xb_add(&bar[XB_XSUB(b.x)], 1u);
        const unsigned gen = old / nloc;
        if (old + 1u == (gen + 1u) * nloc) {
            __builtin_amdgcn_fence(__ATOMIC_RELEASE, "agent");
            asm volatile("s_waitcnt vmcnt(0)" ::: "memory");
            const unsigned og = xb_add(&bar[XB_TOP], 1u);
            const unsigned tg = og / nx;
            if (og + 1u == (tg + 1u) * nx) xb_add(&bar[XB_TOPGEN], 1u);
            else XB_SPIN(xb_ld(&bar[XB_TOPGEN]) == tg, bar);
            __builtin_amdgcn_fence(__ATOMIC_ACQUIRE, "agent");
            xb_add(&bar[XB_XGEN(b.x)], 1u);
            asm volatile("s_waitcnt vmcnt(0)" ::: "memory");
        } else {
            XB_SPIN(xb_ld(&bar[XB_XGEN(b.x)]) == gen, bar);
            __builtin_amdgcn_fence(__ATOMIC_ACQUIRE, "agent");
            asm volatile("s_waitcnt vmcnt(0)" ::: "memory");
        }
    }
    __syncthreads();
}

enum { PH_W = 0, PH_INPROJ, PH_LAT, PH_QB_A, PH_IDX, PH_BATT, PH_UV, PH_OUT, PH_POST1, PH_XQ, PH_XATT, PH_XO, PH_POST2, PH_GU, PH_DOWN, PH_POST3, NPHASES };

template <int PH>
__device__ __forceinline__ void run_phase(const Params& p, const int l, unsigned char* smem, const int dup = 0) {
    unsigned char* ws = p.ws;
    unsigned* ctl = (unsigned*)(ws + WS_CTL);
    float* ssq = (float*)(ws + WS_SSQ);
    float* ssq_in = ssq + (size_t)(l == 0 ? 0 : 3 * l) * MTOK * 8;
    float* ssq_a = ssq + (size_t)(3 * l + 1) * MTOK * 8;
    float* ssq_b = ssq + (size_t)(3 * l + 2) * MTOK * 8;
    float* ssq_c = ssq + (size_t)(3 * l + 3) * MTOK * 8;
    const bool fused = gridDim.x == 256;
    if constexpr (PH == PH_W) {
        phase_weights(p, l, smem);
    } else if constexpr (PH == PH_INPROJ) {
        const float* rs = ssq_in;
        g8::gemm_phase((const bf16_t*)(ws + WS_H16), (const bf16_t*)(ws + W_IN), MTOK, OFF_KIDX, DM, g8::EpiBf16{(bf16_t*)(ws + WS_PROJ), NPROJ, 1 << 30, rs}, smem);
        g8::gemm_phase((const bf16_t*)(ws + WS_H16), (const bf16_t*)(ws + W_IN) + (size_t)OFF_CU * DM, MTOK, 1024, DM, g8::EpiBf16{(bf16_t*)(ws + WS_PROJ) + OFF_CU, NPROJ, 0, rs}, smem);
    } else if constexpr (PH == PH_LAT) {
        phase_latent_norms(p, l);
    } else if constexpr (PH == PH_QB_A) {
        unsigned* head = ctl + CW_QUEUE + 64 * (l * 8 + 0 + 4 * dup);
        const g8::EpiBf16 epi{(bf16_t*)(ws + WS_QB), NQB, 1 << 30, nullptr};
        const g8::EpiBf16 epik{(bf16_t*)(ws + WS_PROJ) + OFF_KIDX, NPROJ, 1 << 30, ssq_in};
        const g8::EpiBf16 epikv{(bf16_t*)(ws + WS_KVX), 1024, 1 << 30, nullptr};
        constexpr int U_ATT = 768, U_KW = U_ATT + 64, U_KV = U_KW + 16, U_QB = U_KV + 640, U_C = U_QB + 512;
        for (;;) {
            const int u = queue_next(head, smem);
            if (u >= U_C) break;
            if (u < U_ATT) { for (int rep_ = 0; rep_ < (PROBE_SUB == 5 ? 2 : 1); ++rep_) at::attnA_unit(p, u, smem); }
            else if (u < U_KW) { for (int rep_ = 0; rep_ < (PROBE_SUB == 8 ? 2 : 1); ++rep_) g8::gemm_tile((const bf16_t*)(ws + WS_H16), (const bf16_t*)(ws + W_IN) + (size_t)OFF_KIDX * DM, DM, u - U_ATT, 0, epik, smem); }
            else if (u < U_KV) { const int g = u - U_KW; g8::gemm_tile((const bf16_t*)(ws + WS_MEMN), (const bf16_t*)(ws + W_XKV), DM, g >> 2, g & 3, epikv, smem); }
            else if (u < U_QB) { const int g = u - U_KV; for (int rep_ = 0; rep_ < (PROBE_SUB == 6 ? 2 : 1); ++rep_) g8::gemm_tile((const bf16_t*)(ws + WS_CQN), (const bf16_t*)(ws + W_B), 512, g / 10, g % 10, epi, smem); }
            else { for (int rep_ = 0; rep_ < (PROBE_SUB == 7 ? 2 : 1); ++rep_) cbranch_unit(p, l, u - U_QB, smem); }
        }
    } else if constexpr (PH == PH_IDX) {
        unsigned* head = ctl + CW_QUEUE + 64 * (l * 8 + 1 + 4 * dup);
        for (;;) {
            const int u = queue_next(head, smem);
            if (u >= 256 + 1024) break;
            if (u < 256) at::attnA_combine(p, l, u);
            else { const int v = u - 256; for (int rep_ = 0; rep_ < (PROBE_SUB == 9 ? 2 : 1); ++rep_) ix::indexer_unit(p, v & 3, 255 - (v >> 2), smem); }
        }
    } else if constexpr (PH == PH_BATT) {
        bt::battn_rows(p, smem);
    } else if constexpr (PH == PH_UV) {
        for (int u = blockIdx.x; u < 384; u += gridDim.x) {
            const int pm = u & 63, h = u >> 6;
            g8::gemm_tile((const bf16_t*)(ws + WS_OLAT) + (size_t)h * MTOK * 256, (const bf16_t*)(ws + W_UVT) + (size_t)h * 128 * 256, 256, pm, 0,
                          g8::EpiHalfBf16{(bf16_t*)(ws + WS_MIX) + 768 + h * 128, NMIX}, smem);
        }
    } else if constexpr (PH == PH_OUT) {
        if (fused) g8::gemm_post_fused((const bf16_t*)(ws + WS_MIX), (const bf16_t*)(ws + W_OUT), NMIX,
                       g8::EpiFusedPost{(bf16_t*)(ws + WS_H16), nullptr, p.in[4] + (size_t)l * DM, ssq_a, (float*)(ws + WS_XBUF), ctl + CW_PANEL + ((l * 3 + 0) * 64) * 16, ctl + CW_TMO, smem}, smem);
        else g8::gemm_phase((const bf16_t*)(ws + WS_MIX), (const bf16_t*)(ws + W_OUT), MTOK, DM, NMIX, g8::EpiBf16{(bf16_t*)(ws + WS_TMP), DM, 1 << 30, nullptr}, smem);
    } else if constexpr (PH == PH_POST1) {
        phase_post((const bf16_t*)(ws + WS_TMP), l == 0 ? p.in[0] : nullptr, (bf16_t*)(ws + WS_H16), nullptr, p.in[4] + (size_t)l * DM, ssq_a);
    } else if constexpr (PH == PH_XQ) {
        unsigned* chead = ctl + CW_QUEUE + 64 * (l * 8 + 2 + 4 * dup);
        if ((int)blockIdx.x >= 128) for (;;) { const int u = queue_next(chead, smem); if (u >= 528) break; conv_run(p, l, NCONV_EARLY, NCONV, u * 4, 1, 4, opaque_tid(), smem); }
        g8::gemm_phase((const bf16_t*)(ws + WS_H16), (const bf16_t*)(ws + W_XQ), MTOK, 512, DM, g8::EpiBf16{(bf16_t*)(ws + WS_XQ), 512, 1 << 30, ssq_a}, smem);
        if ((int)blockIdx.x < 128) for (;;) { const int u = queue_next(chead, smem); if (u >= 528) break; conv_run(p, l, NCONV_EARLY, NCONV, u * 4, 1, 4, opaque_tid(), smem); }
    } else if constexpr (PH == PH_XATT) {
        for (int u = blockIdx.x; u < 256; u += gridDim.x) at::attnX_unit(p, u, smem);
    } else if constexpr (PH == PH_XO) {
        if (fused) g8::gemm_post_fused((const bf16_t*)(ws + WS_XO), (const bf16_t*)(ws + W_XO), 512,
                       g8::EpiFusedPost{(bf16_t*)(ws + WS_H16), nullptr, p.in[20] + (size_t)l * DM, ssq_b, (float*)(ws + WS_XBUF), ctl + CW_PANEL + ((l * 3 + 1) * 64) * 16, ctl + CW_TMO, smem}, smem);
        else g8::gemm_phase((const bf16_t*)(ws + WS_XO), (const bf16_t*)(ws + W_XO), MTOK, DM, 512, g8::EpiBf16{(bf16_t*)(ws + WS_TMP), DM, 1 << 30, nullptr}, smem);
    } else if constexpr (PH == PH_POST2) {
        phase_post((const bf16_t*)(ws + WS_TMP), nullptr, (bf16_t*)(ws + WS_H16), nullptr, p.in[20] + (size_t)l * DM, ssq_b);
    } else if constexpr (PH == PH_GU) {
        g8::gemm_phase((const bf16_t*)(ws + WS_H16), (const bf16_t*)(ws + W_GU), MTOK, 2 * FH, DM, g8::EpiSwiglu{(bf16_t*)(ws + WS_FFH), ssq_b}, smem);
    } else if constexpr (PH == PH_DOWN) {
        if (fused) g8::gemm_post_fused((const bf16_t*)(ws + WS_FFH), (const bf16_t*)(ws + W_DOWN), FH,
                       g8::EpiFusedPost{(bf16_t*)(ws + WS_H16), l + 1 < DEPTH ? nullptr : p.out, p.in[26] + (size_t)l * DM, ssq_c, (float*)(ws + WS_XBUF), ctl + CW_PANEL + ((l * 3 + 2) * 64) * 16, ctl + CW_TMO, smem}, smem);
        else g8::gemm_phase((const bf16_t*)(ws + WS_FFH), (const bf16_t*)(ws + W_DOWN), MTOK, DM, FH, g8::EpiBf16{(bf16_t*)(ws + WS_TMP), DM, 1 << 30, nullptr}, smem);
    } else if constexpr (PH == PH_POST3) {
        phase_post((const bf16_t*)(ws + WS_TMP), nullptr, (bf16_t*)(ws + WS_H16), l + 1 < DEPTH ? nullptr : p.out, p.in[26] + (size_t)l * DM, ssq_c);
    }
}

template <int PH>
__global__ void __launch_bounds__(NTHREADS, 2) k_phase(Params p) {
    extern __shared__ __attribute__((aligned(16))) unsigned char smem[];
    run_phase<PH>(p, p.layer, smem);
}

__global__ void __launch_bounds__(NTHREADS, 2) k_forward(Params p) {
    extern __shared__ __attribute__((aligned(16))) unsigned char smem[];
    if (threadIdx.x == 0) *(uint4*)(smem + LDS_CTL) = make_uint4(0u, 0u, 0u, 0u);
    __syncthreads();
    const XcdBarrier bar = xcd_barrier_post((unsigned*)(p.ws + WS_CTL) + CW_BAR, (volatile LAS unsigned*)(smem + LDS_CTL));
#define RUN(PH) do { run_phase<PH>(p, l, smem); xcd_barrier(bar); if (PROBE_DUP == PH) { run_phase<PH>(p, l, smem, 1); xcd_barrier(bar); } } while (0)
    for (int l = 0; l < DEPTH; ++l) {
        const bool fusedp = gridDim.x == 256;
        RUN(PH_W); RUN(PH_INPROJ); RUN(PH_LAT); RUN(PH_QB_A); RUN(PH_IDX); RUN(PH_BATT); RUN(PH_UV); RUN(PH_OUT); if (!fusedp) RUN(PH_POST1);
        RUN(PH_XQ); RUN(PH_XATT); RUN(PH_XO); if (!fusedp) RUN(PH_POST2); RUN(PH_GU); RUN(PH_DOWN); if (!fusedp) RUN(PH_POST3);
    }
#undef RUN
}

template <int PH>
static void launch_phase(Params& p, int grid, hipStream_t stream) {
    static bool attr = false;
    if (!attr) { (void)hipFuncSetAttribute((const void*)k_phase<PH>, hipFuncAttributeMaxDynamicSharedMemorySize, LDS_BYTES); attr = true; }
    hipLaunchKernelGGL(k_phase<PH>, dim3(grid), dim3(NTHREADS), LDS_BYTES, stream, p);
}

extern "C" void kernel_launch(void* const* d_in, const int* in_sizes, int n_in, void* d_out, int out_size, void* d_ws, size_t ws_size, hipStream_t stream) {
    if (n_in != 29 || out_size != MTOK * DM || ws_size < WS_END) {
        fprintf(stderr, "kernel_launch: unexpected problem (n_in %d, out %d, ws %zu, need %zu); nothing launched\n", n_in, out_size, ws_size, (size_t)WS_END);
        return;
    }
    static int grid = 0;
    if (!grid) {
        int dev = 0, cus = 0; (void)hipGetDevice(&dev); (void)hipDeviceGetAttribute(&cus, hipDeviceAttributeMultiprocessorCount, dev); grid = cus > 0 ? cus : 256;
#if MK_ONE_LAUNCH
        if (hipFuncSetAttribute((const void*)k_forward, hipFuncAttributeMaxDynamicSharedMemorySize, LDS_BYTES) != hipSuccess) { fprintf(stderr, "kernel_launch: hipFuncSetAttribute failed\n"); grid = -1; }
        int per_cu = 0;
        if (grid > 0 && (hipOccupancyMaxActiveBlocksPerMultiprocessor(&per_cu, (const void*)k_forward, NTHREADS, LDS_BYTES) != hipSuccess || per_cu < 1)) {
            fprintf(stderr, "kernel_launch: occupancy query reports %d workgroups per CU; nothing launched\n", per_cu); grid = -1; }
        (void)hipGetLastError();
#endif
    }
    if (grid < 0) return;
    (void)hipMemsetAsync((char*)d_ws + WS_CTL, 0, ZERO_BYTES, stream);
    Params p{};
    for (int i = 0; i < 29; ++i) p.in[i] = (const float*)d_in[i];
    p.out = (float*)d_out; p.ws = (unsigned char*)d_ws; p.layer = 0; p.phase = 0;
#if MK_ONE_LAUNCH
    hipLaunchKernelGGL(k_forward, dim3(grid), dim3(NTHREADS), LDS_BYTES, stream, p);
#else
    for (int l = 0; l < DEPTH; ++l) {
        p.layer = l;
        launch_phase<PH_W>(p, grid, stream);
        launch_phase<PH_INPROJ>(p, grid, stream);
        launch_phase<PH_LAT>(p, grid, stream);
        launch_phase<PH_QB_A>(p, grid, stream);
        launch_phase<PH_IDX>(p, grid, stream);
        launch_phase<PH_BATT>(p, grid, stream);
        launch_phase<PH_UV>(p, grid, stream);
        launch_phase<PH_OUT>(p, grid, stream);
        launch_phase<PH_POST1>(p, grid, stream);
        launch_phase<PH_XQ>(p, grid, stream);
        launch_phase<PH_XATT>(p, grid, stream);
        launch_phase<PH_XO>(p, grid, stream);
        launch_phase<PH_POST2>(p, grid, stream);
        launch_phase<PH_GU>(p, grid, stream);
        launch_phase<PH_DOWN>(p, grid, stream);
        launch_phase<PH_POST3>(p, grid, stream);
    }
#endif
}
```

```cpp
#include <hip/hip_runtime.h>
#include <stdint.h>
#include <stdio.h>

#ifndef PROBE_DUP
#define PROBE_DUP -1
#endif
#ifndef PROBE_SUB
#define PROBE_SUB 0
#endif
#ifndef IX_HIST
#define IX_HIST 3
#endif
#ifndef IX_CHECK
#define IX_CHECK 0
#endif
#ifndef PROBE_CHK
#define PROBE_CHK 0
#endif
#ifndef MK_ONE_LAUNCH
#define MK_ONE_LAUNCH 1
#endif

#define LAS __attribute__((address_space(3)))
typedef unsigned short bf16_t;
typedef short bf16x8 __attribute__((ext_vector_type(8)));
typedef short s16x4 __attribute__((ext_vector_type(4)));
typedef float f32x4 __attribute__((ext_vector_type(4)));
typedef float f32x16 __attribute__((ext_vector_type(16)));
typedef unsigned u32x4 __attribute__((ext_vector_type(4)));
typedef unsigned u32x2 __attribute__((ext_vector_type(2)));

constexpr int DM = 2048, NBATCH = 4, SEQ = 4096, MTOK = NBATCH * SEQ, DEPTH = 2;
constexpr int IN_COLS = 4176, NPROJ = 4352;
constexpr int OFF_QA = 0, OFF_KA = 768, OFF_VA = 1536, OFF_CQ = 2304, OFF_CKV = 2816, OFF_KIDX = 3072, OFF_WIDX = 3136, OFF_CU = 3328, OFF_CV = 3840;
constexpr int NQB = 2560;
constexpr int NMIX = 2048;
constexpr int FH = 5632;
constexpr int MEMLEN = 256, MEMROWS = NBATCH * MEMLEN;
constexpr int TOPK = 256;
constexpr float EPS = 1e-6f;
constexpr float LOG2E = 1.4426950408889634f;

constexpr int NTHREADS = 512;
constexpr int LDS_BYTES = 155648;
constexpr int LDS_CTL = LDS_BYTES - 256;

constexpr size_t alignup(size_t x) { return (x + 255) & ~(size_t)255; }
constexpr size_t WS_CTL = 0;
constexpr size_t CTL_BYTES = 65536;
constexpr int NSSQ = 1 + 3 * DEPTH;
constexpr size_t ZERO_BYTES = CTL_BYTES;
constexpr size_t WS_SSQ = WS_CTL + CTL_BYTES;
constexpr size_t WS_LUT = WS_SSQ + (size_t)NSSQ * MTOK * 8 * 4;
constexpr size_t WS_LAM = WS_LUT + 12 * 128 * 4;
constexpr size_t WS_XBUF = alignup(WS_LAM + 256);
constexpr size_t WS_W = WS_XBUF + (size_t)64 * 256 * 8 * 4;
constexpr size_t W_IN = WS_W;
constexpr size_t W_B = W_IN + (size_t)NPROJ * DM * 2;
constexpr size_t W_OUT = W_B + (size_t)NQB * 512 * 2;
constexpr size_t W_XQ = W_OUT + (size_t)DM * NMIX * 2;
constexpr size_t W_XKV = W_XQ + (size_t)512 * DM * 2;
constexpr size_t W_XO = W_XKV + (size_t)1024 * DM * 2;
constexpr size_t W_GU = W_XO + (size_t)DM * 512 * 2;
constexpr size_t W_DOWN = W_GU + (size_t)2 * FH * DM * 2;
constexpr size_t W_UVT = W_DOWN + (size_t)DM * FH * 2;
constexpr size_t WS_MEMN = W_UVT + (size_t)(768 + 128) * 256 * 2;
constexpr size_t WS_KVX = WS_MEMN + (size_t)MEMROWS * DM * 2;
constexpr size_t WS_H16 = alignup(WS_KVX + (size_t)MEMROWS * 1024 * 2);
constexpr size_t WS_RSTD = WS_H16 + (size_t)MTOK * DM * 2;
constexpr size_t WS_CQN = WS_RSTD + (size_t)MTOK * 4;
constexpr size_t WS_CKVN = WS_CQN + (size_t)MTOK * 512 * 2;
constexpr size_t WS_R1 = WS_CKVN + (size_t)MTOK * 256 * 2;
constexpr size_t WS_PROJ = WS_R1, WS_TMP = WS_R1, WS_OLAT = WS_R1;
constexpr size_t WS_R2 = WS_R1 + (size_t)MTOK * NPROJ * 2;
constexpr size_t WS_QB = WS_R2;
constexpr size_t WS_MIX = WS_QB + (size_t)MTOK * NQB * 2;
constexpr size_t WS_IDX = WS_MIX + (size_t)MTOK * NMIX * 2;
constexpr size_t WS_FFH = WS_R2;
constexpr size_t WS_XQ = WS_R2;
constexpr size_t WS_XO = WS_XQ + (size_t)MTOK * 512 * 2;
constexpr size_t WS_CSTAT = WS_IDX + (size_t)MTOK * TOPK * 2;
constexpr size_t WS_END_A = WS_CSTAT + (size_t)MTOK * 8, WS_END_B = WS_FFH + (size_t)MTOK * FH * 2;
constexpr size_t WS_END = WS_END_A > WS_END_B ? WS_END_A : WS_END_B;
static_assert((size_t)MTOK * DM * 4 <= (size_t)MTOK * NPROJ * 2, "tmp overlay");

constexpr int CW_QUEUE = 0;
constexpr int NQUEUES = 64;
constexpr int CW_BAR = 64 * NQUEUES;
constexpr int CW_PANEL = 8192;
constexpr int CW_TMO = CW_PANEL + DEPTH * 3 * 64 * 16;
static_assert((size_t)(CW_TMO + 16) * 4 <= 65536, "control area");

struct Params {
    const float* in[29];
    float* out;
    unsigned char* ws;
    int layer, phase;
};

__device__ __forceinline__ unsigned cvt_pk_bf16(float lo, float hi) { unsigned r; asm("v_cvt_pk_bf16_f32 %0, %1, %2" : "=v"(r) : "v"(lo), "v"(hi)); return r; }
__device__ __forceinline__ float bf2f(unsigned v) { return __uint_as_float(v << 16); }
__device__ __forceinline__ float bflo(unsigned w) { return __uint_as_float(w << 16); }
__device__ __forceinline__ float bfhi(unsigned w) { return __uint_as_float(w & 0xffff0000u); }
__device__ __forceinline__ bf16_t f2bf(float f) { return (bf16_t)(cvt_pk_bf16(f, 0.f) & 0xffffu); }
#define DPP_I(v, ctrl, rmask, bc) __builtin_amdgcn_update_dpp(0, (v), (ctrl), (rmask), 0xF, (bc))
__device__ __forceinline__ int wave_iscan_i(int v) {
    v += DPP_I(v, 0x111, 0xF, true); v += DPP_I(v, 0x112, 0xF, true); v += DPP_I(v, 0x114, 0xF, true); v += DPP_I(v, 0x118, 0xF, true);
    v += DPP_I(v, 0x142, 0xA, false); v += DPP_I(v, 0x143, 0xC, false);
    return v;
}
__device__ __forceinline__ float wave_sum(float v) {
    v += __int_as_float(DPP_I(__float_as_int(v), 0x111, 0xF, true)); v += __int_as_float(DPP_I(__float_as_int(v), 0x112, 0xF, true));
    v += __int_as_float(DPP_I(__float_as_int(v), 0x114, 0xF, true)); v += __int_as_float(DPP_I(__float_as_int(v), 0x118, 0xF, true));
    v += __int_as_float(DPP_I(__float_as_int(v), 0x142, 0xA, false)); v += __int_as_float(DPP_I(__float_as_int(v), 0x143, 0xC, false));
    return __int_as_float(__builtin_amdgcn_readlane(__float_as_int(v), 63));
}
__device__ __forceinline__ float fast_exp2(float x) { return __builtin_amdgcn_exp2f(x); }
__device__ __forceinline__ float fast_rcp(float x) { return __builtin_amdgcn_rcpf(x); }
__device__ __forceinline__ float gelu_tanh(float x) {
    const float u = x * (1.0f + 0.044715f * x * x) * (2.0f * 0.7978845608028654f);
    return x * fast_rcp(1.0f + fast_exp2(-u * LOG2E));
}
__device__ __forceinline__ float silu(float x) { return x * fast_rcp(1.0f + fast_exp2(-x * LOG2E)); }

__device__ __forceinline__ int opaque_tid() { int t = threadIdx.x; asm volatile("" : "+v"(t)); return t; }

__device__ __forceinline__ void glds16(const void* gsrc, unsigned lds_dst) {
    unsigned keep;
    asm volatile("s_mov_b32 %0, m0\n\ts_mov_b32 m0, %2\n\ts_nop 0\n\tglobal_load_lds_dwordx4 %1, off\n\ts_mov_b32 m0, %0" : "=&s"(keep) : "v"(gsrc), "s"(lds_dst) : "memory");
}

__device__ __forceinline__ int queue_next(unsigned* head, unsigned char* smem) {
    volatile LAS unsigned* slot = (volatile LAS unsigned*)(smem + LDS_CTL + 64);
    __syncthreads();
    if (threadIdx.x == 0) *slot = __hip_atomic_fetch_add(head, 1u, __ATOMIC_RELAXED, __HIP_MEMORY_SCOPE_AGENT);
    __syncthreads();
    return (int)*slot;
}

namespace g8 {
constexpr int BM = 256, BK = 64, HALF = 128, HT = HALF * BK;
__device__ __forceinline__ int lds_byte(int r, int c) { const int st = (r >> 4) * 2 + (c >> 5), rr = r & 15, cc = c & 31, ob = rr * 64 + cc * 2; return st * 1024 + (ob ^ (((ob >> 9) & 1) << 5)); }
__device__ __forceinline__ void stage_rc(int b, int& R, int& C) { const int st = b / 1024, sb = b % 1024, swz = sb ^ (((sb >> 9) & 1) << 5); R = (st >> 1) * 16 + swz / 64; C = (st & 1) * 32 + (swz % 64) / 2; }

template <class Epi>
__device__ __forceinline__ void gemm_tile(const bf16_t* __restrict__ A, const bf16_t* __restrict__ Bt, const int K, const int pm, const int pn, const Epi& epi, unsigned char* smem) {
    bf16_t* shm = (bf16_t*)smem;
#define SA(b, h) (shm + ((b) * 2 + (h)) * HT)
#define SB(b, h) (shm + (4 + (b) * 2 + (h)) * HT)
#define STAGE_X(T, P, BASE, br, kt) do { long _g = (long)(br) * K + (long)(kt) * BK; \
    for (int _i = 0; _i < 2; ++_i) { int _b = (T) * 16 + _i * 8192; int _r, _c; stage_rc(_b, _r, _c); \
      __builtin_amdgcn_global_load_lds((const unsigned*)(BASE + _g + (long)_r * K + _c), (LAS unsigned*)((char*)(P) + _b), 16, 0, 0); } } while (0)
#define STAGE(P, BASE, br, kt) STAGE_X(tz0, P, BASE, br, kt)
#define LDA(dst, b, h) for (int m = 0; m < 4; ++m) for (int k = 0; k < 2; ++k) \
    dst[m][k] = *reinterpret_cast<const bf16x8*>((char*)SA(b, h) + lds_byte(wr * 64 + m * 16 + fr, k * 32 + fq * 8))
#define LDB(dst, b, h) for (int n = 0; n < 2; ++n) for (int k = 0; k < 2; ++k) \
    dst[n][k] = *reinterpret_cast<const bf16x8*>((char*)SB(b, h) + lds_byte(wc * 32 + n * 16 + fr, k * 32 + fq * 8))
#define MMA(ai, bj, At_, Bt_) do { __builtin_amdgcn_s_setprio(1); \
    for (int m = 0; m < 4; ++m) for (int n = 0; n < 2; ++n) for (int k = 0; k < 2; ++k) \
      acc[ai][bj][m][n] = __builtin_amdgcn_mfma_f32_16x16x32_bf16(Bt_[n][k], At_[m][k], acc[ai][bj][m][n], 0, 0, 0); \
    __builtin_amdgcn_s_setprio(0); } while (0)
#define WAIT_V(n) asm volatile("s_waitcnt vmcnt(" #n ")" ::: "memory")
#define WAIT_L(n) asm volatile("s_waitcnt lgkmcnt(" #n ")" ::: "memory")
#define BAR __builtin_amdgcn_s_barrier()
#define SCHED __builtin_amdgcn_sched_barrier(0)
    const int brow = pm * BM, bcol = pn * BM;
    int tz0 = threadIdx.x; asm volatile("" : "+v"(tz0));
    int wid = tz0 >> 6, lane = tz0 & 63, wr = wid >> 2, wc = wid & 3, fr = lane & 15, fq = lane >> 4;
    f32x4 acc[2][2][4][2] = {};
    bf16x8 At[4][2], B0[2][2], B1[2][2];
    const int nt = K / BK;
    __syncthreads();
    STAGE(SB(0, 0), Bt, bcol, 0); STAGE(SA(0, 0), A, brow, 0);
    STAGE(SB(0, 1), Bt, bcol + HALF, 0); STAGE(SA(0, 1), A, brow + HALF, 0);
    if (wr == 1) BAR;
    WAIT_V(4); BAR;
    STAGE(SB(1, 0), Bt, bcol, 1); STAGE(SA(1, 0), A, brow, 1); STAGE(SB(1, 1), Bt, bcol + HALF, 1);
    WAIT_V(6); BAR;
    for (int t = 0; t < nt - 2; t += 2) {
        LDB(B0, 0, 0); SCHED; LDA(At, 0, 0); STAGE(SA(1, 1), A, brow + HALF, t + 1);
        WAIT_L(8); BAR; WAIT_L(0); MMA(0, 0, At, B0); BAR; SCHED;
        LDB(B1, 0, 1); STAGE(SB(0, 0), Bt, bcol, t + 2);
        BAR; WAIT_L(0); MMA(0, 1, At, B1); BAR;
        LDA(At, 0, 1); STAGE(SA(0, 0), A, brow, t + 2);
        BAR; WAIT_L(0); MMA(1, 0, At, B0); BAR; SCHED;
        STAGE(SB(0, 1), Bt, bcol + HALF, t + 2);
        WAIT_V(6); BAR; MMA(1, 1, At, B1); BAR;
        LDB(B0, 1, 0); SCHED; LDA(At, 1, 0); STAGE(SA(0, 1), A, brow + HALF, t + 2);
        WAIT_L(8); BAR; WAIT_L(0); MMA(0, 0, At, B0); BAR; SCHED;
        LDB(B1, 1, 1); STAGE(SB(1, 0), Bt, bcol, t + 3);
        BAR; WAIT_L(0); MMA(0, 1, At, B1); BAR;
        LDA(At, 1, 1); STAGE(SA(1, 0), A, brow, t + 3);
        BAR; WAIT_L(0); MMA(1, 0, At, B0); BAR; SCHED;
        STAGE(SB(1, 1), Bt, bcol + HALF, t + 3);
        WAIT_V(6); BAR; MMA(1, 1, At, B1); BAR;
    }
    int tz = threadIdx.x; asm volatile("" : "+v"(tz)); wid = tz >> 6; lane = tz & 63; wr = wid >> 2; wc = wid & 3; fr = lane & 15; fq = lane >> 4;
    { LDB(B0, 0, 0); WAIT_V(0); LDA(At, 0, 0); STAGE_X(tz, SA(1, 1), A, brow + HALF, nt - 1);
      BAR; WAIT_L(0); MMA(0, 0, At, B0); BAR;
      LDB(B1, 0, 1); BAR; WAIT_L(0); MMA(0, 1, At, B1); BAR;
      LDA(At, 0, 1); WAIT_V(4); BAR; WAIT_L(0); MMA(1, 0, At, B0); MMA(1, 1, At, B1); BAR; }
    { LDB(B0, 1, 0); LDA(At, 1, 0); WAIT_V(2); BAR; WAIT_L(0); MMA(0, 0, At, B0); BAR;
      LDB(B1, 1, 1); WAIT_V(0); BAR; WAIT_L(0); MMA(0, 1, At, B1); BAR;
      LDA(At, 1, 1); BAR; WAIT_L(0); MMA(1, 0, At, B0); MMA(1, 1, At, B1); BAR; }
    if (wr == 0) BAR;
    { float rsv[8]; epi.pre(pm, wr, fr, rsv); epi(acc, rsv, pm, pn, wr, wc, fr, fq); }
#undef SA
#undef SB
#undef STAGE_X
#undef STAGE
#undef LDA
#undef LDB
#undef MMA
#undef WAIT_V
#undef WAIT_L
#undef BAR
#undef SCHED
}

struct EpiBf16 {
    bf16_t* O; int ldc; int gelu_pn; const float* rs;
    static constexpr int NSTORES = 16;
    __device__ __forceinline__ void pre(int pm, int wr, int fr, float (&rsv)[8]) const {
#pragma unroll
        for (int i = 0; i < 8; ++i) {
            if (rs) { const float* q = rs + (size_t)(pm * BM + (i >> 2) * HALF + wr * 64 + (i & 3) * 16 + fr) * 8; const f32x4 a = *(const f32x4*)q, b = *(const f32x4*)(q + 4);
                      rsv[i] = rsqrtf((((a[0] + a[1]) + (a[2] + a[3])) + ((b[0] + b[1]) + (b[2] + b[3]))) * (1.0f / DM) + EPS); }
            else rsv[i] = 1.0f;
        }
    }
    __device__ __forceinline__ void operator()(const f32x4 (&acc)[2][2][4][2], const float (&rsv8)[8], int pm, int pn, int wr, int wc, int fr, int fq) const {
        const bool g = pn >= gelu_pn;
#pragma unroll
        for (int ai = 0; ai < 2; ++ai)
#pragma unroll
            for (int m = 0; m < 4; ++m) {
                const int row = pm * BM + ai * HALF + wr * 64 + m * 16 + fr;
                bf16_t* rowp = O + (size_t)row * ldc + pn * BM + wc * 32 + fq * 8;
                const float rsv = rsv8[ai * 4 + m];
#pragma unroll
                for (int bj = 0; bj < 2; ++bj) {
                    f32x4 v0 = acc[ai][bj][m][0] * rsv, v1 = acc[ai][bj][m][1] * rsv;
                    if (g) { v0[0] = gelu_tanh(v0[0]); v0[1] = gelu_tanh(v0[1]); v0[2] = gelu_tanh(v0[2]); v0[3] = gelu_tanh(v0[3]);
                             v1[0] = gelu_tanh(v1[0]); v1[1] = gelu_tanh(v1[1]); v1[2] = gelu_tanh(v1[2]); v1[3] = gelu_tanh(v1[3]); }
                    u32x4 w; w.x = cvt_pk_bf16(v0[0], v0[1]); w.y = cvt_pk_bf16(v0[2], v0[3]); w.z = cvt_pk_bf16(v1[0], v1[1]); w.w = cvt_pk_bf16(v1[2], v1[3]);
                    *(u32x4*)(rowp + bj * HALF) = w;
                }
            }
    }
};
struct EpiHalfBf16 {
    bf16_t* O; int ldc;
    static constexpr int NSTORES = 8;
    __device__ __forceinline__ void pre(int, int, int, float (&rsv)[8]) const {
#pragma unroll
        for (int i = 0; i < 8; ++i) rsv[i] = 1.0f;
    }
    __device__ __forceinline__ void operator()(const f32x4 (&acc)[2][2][4][2], const float (&)[8], int pm, int, int wr, int wc, int fr, int fq) const {
#pragma unroll
        for (int ai = 0; ai < 2; ++ai)
#pragma unroll
            for (int m = 0; m < 4; ++m) {
                const int row = pm * BM + ai * HALF + wr * 64 + m * 16 + fr;
                const f32x4 v0 = acc[ai][0][m][0], v1 = acc[ai][0][m][1];
                u32x4 w; w.x = cvt_pk_bf16(v0[0], v0[1]); w.y = cvt_pk_bf16(v0[2], v0[3]); w.z = cvt_pk_bf16(v1[0], v1[1]); w.w = cvt_pk_bf16(v1[2], v1[3]);
                *(u32x4*)(O + (size_t)row * ldc + wc * 32 + fq * 8) = w;
            }
    }
};
struct EpiF32 {
    float* O; int ldc;
    static constexpr int NSTORES = 32;
    __device__ __forceinline__ void pre(int, int, int, float (&rsv)[8]) const {
#pragma unroll
        for (int i = 0; i < 8; ++i) rsv[i] = 1.0f;
    }
    __device__ __forceinline__ void operator()(const f32x4 (&acc)[2][2][4][2], const float (&)[8], int pm, int pn, int wr, int wc, int fr, int fq) const {
#pragma unroll
        for (int ai = 0; ai < 2; ++ai)
#pragma unroll
            for (int m = 0; m < 4; ++m) {
                float* rowp = O + (size_t)(pm * BM + ai * HALF + wr * 64 + m * 16 + fr) * ldc + pn * BM + wc * 32 + fq * 8;
#pragma unroll
                for (int bj = 0; bj < 2; ++bj)
#pragma unroll
                    for (int n = 0; n < 2; ++n) *(f32x4*)(rowp + bj * HALF + n * 4) = acc[ai][bj][m][n];
            }
    }
};
struct EpiSwiglu {
    bf16_t* O; const float* rs;
    static constexpr int NSTORES = 8;
    __device__ __forceinline__ void pre(int pm, int wr, int fr, float (&rsv)[8]) const {
#pragma unroll
        for (int i = 0; i < 8; ++i) { const float* q = rs + (size_t)(pm * BM + (i >> 2) * HALF + wr * 64 + (i & 3) * 16 + fr) * 8; const f32x4 a = *(const f32x4*)q, b = *(const f32x4*)(q + 4);
            rsv[i] = rsqrtf((((a[0] + a[1]) + (a[2] + a[3])) + ((b[0] + b[1]) + (b[2] + b[3]))) * (1.0f / DM) + EPS); }
    }
    __device__ __forceinline__ void operator()(const f32x4 (&acc)[2][2][4][2], const float (&rsv8)[8], int pm, int pn, int wr, int wc, int fr, int fq) const {
#pragma unroll
        for (int ai = 0; ai < 2; ++ai)
#pragma unroll
            for (int m = 0; m < 4; ++m) {
                const int row = pm * BM + ai * HALF + wr * 64 + m * 16 + fr;
                bf16_t* rowp = O + (size_t)row * FH + pn * HALF + wc * 32 + fq * 8;
                const float rsv = rsv8[ai * 4 + m];
                u32x4 w;
                { const f32x4 gt = acc[ai][0][m][0] * rsv, up = acc[ai][1][m][0] * rsv;
                  w.x = cvt_pk_bf16(silu(gt[0]) * up[0], silu(gt[1]) * up[1]); w.y = cvt_pk_bf16(silu(gt[2]) * up[2], silu(gt[3]) * up[3]); }
                { const f32x4 gt = acc[ai][0][m][1] * rsv, up = acc[ai][1][m][1] * rsv;
                  w.z = cvt_pk_bf16(silu(gt[0]) * up[0], silu(gt[1]) * up[1]); w.w = cvt_pk_bf16(silu(gt[2]) * up[2], silu(gt[3]) * up[3]); }
                *(u32x4*)rowp = w;
            }
    }
};
__device__ __forceinline__ void unit_to_tile(int L, int nM, int nN, int& pm, int& pn) {
    const int nwg = nM * nN;
    int wgid = L;
    { const int q = nwg / 8, r = nwg % 8, xcd = L % 8, off = L / 8; wgid = (xcd < r ? xcd * (q + 1) : r * (q + 1) + (xcd - r) * q) + off; }
    const int nig = 8 * nN, gid = wgid / nig, fm = gid * 8, gsz = (nM - fm) < 8 ? (nM - fm) : 8;
    pm = fm + ((wgid % nig) % gsz); pn = (wgid % nig) / gsz;
}
struct EpiFusedPost {
    bf16_t* h16; float* out32; const float* g_post; float* ssq_next; float* xbuf; unsigned* cnt; unsigned* tmo; unsigned char* smem;
    static constexpr int NSTORES = 0;
    __device__ __forceinline__ void pre(int, int, int, float (&rsv)[8]) const {
#pragma unroll
        for (int i = 0; i < 8; ++i) rsv[i] = 1.0f;
    }
    __device__ __forceinline__ void operator()(const f32x4 (&acc)[2][2][4][2], const float (&)[8], int pm, int pn, int wr, int wc, int fr, int fq) const {
        float* P = (float*)(smem + 131072);
        float* S = P + 1024;
        const int tid = opaque_tid();
#pragma unroll
        for (int ai = 0; ai < 2; ++ai)
#pragma unroll
            for (int m = 0; m < 4; ++m) {
                float q = 0.f;
#pragma unroll
                for (int bj = 0; bj < 2; ++bj)
#pragma unroll
                    for (int n = 0; n < 2; ++n) { const f32x4 v = acc[ai][bj][m][n]; q += v[0] * v[0] + v[1] * v[1] + v[2] * v[2] + v[3] * v[3]; }
                q += __shfl_xor(q, 16, 64); q += __shfl_xor(q, 32, 64);
                if (fq == 0) P[(ai * HALF + wr * 64 + m * 16 + fr) * 4 + wc] = q;
            }
        __syncthreads();
        if (tid < 256) {
            const f32x4 pp = *(const f32x4*)(P + tid * 4);
            __hip_atomic_store(xbuf + ((size_t)pm * 256 + tid) * 8 + pn, (pp[0] + pp[1]) + (pp[2] + pp[3]), __ATOMIC_RELAXED, __HIP_MEMORY_SCOPE_AGENT);
        }
        asm volatile("s_waitcnt vmcnt(0)" ::: "memory");
        __syncthreads();
        const int wru = __builtin_amdgcn_readfirstlane(wr), wcu = __builtin_amdgcn_readfirstlane(wc);
        const size_t ubase = ((size_t)pm * BM + wru * 64) * DM + pn * BM + wcu * 32;
        const unsigned loff = (unsigned)fr * DM + fq * 8;
        u32x4 hw[2][4][2];
#pragma unroll
        for (int m = 0; m < 4; ++m)
#pragma unroll
            for (int bj = 0; bj < 2; ++bj)
                hw[0][m][bj] = *(const u32x4*)(h16 + (ubase + (size_t)(m * 16) * DM + bj * HALF) + loff);
        if (tid == 0) {
            __hip_atomic_fetch_add(cnt + pm * 16, 1u, __ATOMIC_RELAXED, __HIP_MEMORY_SCOPE_AGENT);
            unsigned spins = 0;
            while (__hip_atomic_load(cnt + pm * 16, __ATOMIC_RELAXED, __HIP_MEMORY_SCOPE_AGENT) < 8u) {
                __builtin_amdgcn_s_sleep(1);
                if (++spins > (1u << 22)) { __hip_atomic_store(tmo, 1u, __ATOMIC_RELAXED, __HIP_MEMORY_SCOPE_AGENT); break; }
            }
        }
        __syncthreads();
        if (tid < 256) {
            const unsigned long long* xp = (const unsigned long long*)(xbuf + ((size_t)pm * 256 + tid) * 8);
            f32x4 xa, xb;
            asm volatile("global_load_dwordx4 %0, %2, off sc1\n\tglobal_load_dwordx4 %1, %2, off offset:16 sc1\n\ts_waitcnt vmcnt(0)" : "=&v"(xa), "=&v"(xb) : "v"(xp) : "memory");
            const float tot = ((xa[0] + xa[1]) + (xa[2] + xa[3])) + ((xb[0] + xb[1]) + (xb[2] + xb[3]));
            S[tid] = rsqrtf(tot * (1.0f / DM) + EPS);
        }
        __syncthreads();
        f32x4 gg[2][2];
#pragma unroll
        for (int bj = 0; bj < 2; ++bj) { const float* gp = g_post + pn * BM + bj * HALF + wc * 32 + fq * 8; gg[bj][0] = *(const f32x4*)gp; gg[bj][1] = *(const f32x4*)(gp + 4); }
#pragma unroll
        for (int m = 0; m < 4; ++m)
#pragma unroll
            for (int bj = 0; bj < 2; ++bj)
                hw[1][m][bj] = *(const u32x4*)(h16 + (ubase + (size_t)(HALF + m * 16) * DM + bj * HALF) + loff);
#pragma unroll
        for (int ai = 0; ai < 2; ++ai)
#pragma unroll
            for (int m = 0; m < 4; ++m) {
                const int rl = ai * HALF + wr * 64 + m * 16 + fr;
                const float rp = S[rl];
                float s2 = 0.f;
#pragma unroll
                for (int bj = 0; bj < 2; ++bj) {
                    const size_t offu = ubase + (size_t)(ai * HALF + m * 16) * DM + bj * HALF;
                    const u32x4 hq = hw[ai][m][bj];
                    f32x4 h0 = (f32x4){bflo(hq.x), bfhi(hq.x), bflo(hq.y), bfhi(hq.y)}, h1 = (f32x4){bflo(hq.z), bfhi(hq.z), bflo(hq.w), bfhi(hq.w)};
                    h0 = h0 + acc[ai][bj][m][0] * rp * gg[bj][0];
                    h1 = h1 + acc[ai][bj][m][1] * rp * gg[bj][1];
                    if (out32) { *(f32x4*)(out32 + offu + loff) = h0; *(f32x4*)(out32 + offu + loff + 4) = h1; }
                    else {
                        u32x4 w; w.x = cvt_pk_bf16(h0[0], h0[1]); w.y = cvt_pk_bf16(h0[2], h0[3]); w.z = cvt_pk_bf16(h1[0], h1[1]); w.w = cvt_pk_bf16(h1[2], h1[3]);
                        *(u32x4*)(h16 + offu + loff) = w;
                        const float e0 = bflo(w.x), e1 = bfhi(w.x), e2 = bflo(w.y), e3 = bfhi(w.y), e4 = bflo(w.z), e5 = bfhi(w.z), e6 = bflo(w.w), e7 = bfhi(w.w);
                        s2 += (e0 * e0 + e1 * e1) + (e2 * e2 + e3 * e3) + (e4 * e4 + e5 * e5) + (e6 * e6 + e7 * e7);
                    }
                }
                if (!out32) {
                    s2 += __shfl_xor(s2, 16, 64); s2 += __shfl_xor(s2, 32, 64);
                    if (fq == 0) P[rl * 4 + wc] = s2;
                }
            }
        if (!out32) {
            __syncthreads();
            if (tid < 256) { const f32x4 pp = *(const f32x4*)(P + tid * 4); ssq_next[((size_t)pm * BM + tid) * 8 + pn] = (pp[0] + pp[1]) + (pp[2] + pp[3]); }
        }
    }
};
__device__ __forceinline__ void gemm_post_fused(const bf16_t* A, const bf16_t* Bt, int K, const EpiFusedPost& epi, unsigned char* smem) {
    const int c = blockIdx.x, x = c & 7, slot = c >> 3;
    for (int sl = 0; sl < 2; ++sl) gemm_tile(A, Bt, K, 32 * sl + 4 * x + (slot >> 3), slot & 7, epi, smem);
}

template <class Epi>
__device__ __forceinline__ void gemm_phase(const bf16_t* __restrict__ A, const bf16_t* __restrict__ Bt, const int M, const int N, const int K, const Epi& epi, unsigned char* smem) {
    bf16_t* shm = (bf16_t*)smem;
    const int LD = K;
#define SA(b, h) (shm + ((b) * 2 + (h)) * HT)
#define SB(b, h) (shm + (4 + (b) * 2 + (h)) * HT)
#define STAGE_X(T, P, BASE, br, kt) do { long _g = (long)(br) * LD + (long)(kt) * BK; \
    for (int _i = 0; _i < 2; ++_i) { int _b = (T) * 16 + _i * 8192; int _r, _c; stage_rc(_b, _r, _c); \
      __builtin_amdgcn_global_load_lds((const unsigned*)(BASE + _g + (long)_r * LD + _c), (LAS unsigned*)((char*)(P) + _b), 16, 0, 0); } } while (0)
#define STAGE(P, BASE, br, kt) STAGE_X(tz0, P, BASE, br, kt)
#define LDA(dst, b, h) for (int m = 0; m < 4; ++m) for (int k = 0; k < 2; ++k) \
    dst[m][k] = *reinterpret_cast<const bf16x8*>((char*)SA(b, h) + lds_byte(wr * 64 + m * 16 + fr, k * 32 + fq * 8))
#define LDB(dst, b, h) for (int n = 0; n < 2; ++n) for (int k = 0; k < 2; ++k) \
    dst[n][k] = *reinterpret_cast<const bf16x8*>((char*)SB(b, h) + lds_byte(wc * 32 + n * 16 + fr, k * 32 + fq * 8))
#define MMA(ai, bj, At_, Bt_) do { __builtin_amdgcn_s_setprio(1); \
    for (int m = 0; m < 4; ++m) for (int n = 0; n < 2; ++n) for (int k = 0; k < 2; ++k) \
      acc[ai][bj][m][n] = __builtin_amdgcn_mfma_f32_16x16x32_bf16(Bt_[n][k], At_[m][k], acc[ai][bj][m][n], 0, 0, 0); \
    __builtin_amdgcn_s_setprio(0); } while (0)
#define WAIT_V(n) asm volatile("s_waitcnt vmcnt(" #n ")" ::: "memory")
#define WAIT_VN(n) asm volatile("s_waitcnt vmcnt(%0)" :: "n"(n) : "memory")
#define WAIT_L(n) asm volatile("s_waitcnt lgkmcnt(" #n ")" ::: "memory")
#define BAR __builtin_amdgcn_s_barrier()
#define SCHED __builtin_amdgcn_sched_barrier(0)
    const int nM = M / BM, nN = N / BM, nu = nM * nN, nt = K / BK;
    int u = blockIdx.x;
    if (u >= nu) return;
    int pm, pn; unit_to_tile(u, nM, nN, pm, pn);
    int tz0 = opaque_tid();
    int wid = tz0 >> 6, lane = tz0 & 63, wr = wid >> 2, wc = wid & 3, fr = lane & 15, fq = lane >> 4;
    __syncthreads();
    {
        const int brow = pm * BM, bcol = pn * BM;
        STAGE(SB(0, 0), Bt, bcol, 0); STAGE(SA(0, 0), A, brow, 0);
        STAGE(SB(0, 1), Bt, bcol + HALF, 0); STAGE(SA(0, 1), A, brow + HALF, 0);
        if (wr == 1) BAR;
        WAIT_V(4); BAR;
        STAGE(SB(1, 0), Bt, bcol, 1); STAGE(SA(1, 0), A, brow, 1); STAGE(SB(1, 1), Bt, bcol + HALF, 1);
        WAIT_V(6); BAR;
    }
    for (;;) {
        const int brow = pm * BM, bcol = pn * BM;
        f32x4 acc[2][2][4][2] = {};
        bf16x8 At[4][2], B0[2][2], B1[2][2];
        for (int t = 0; t < nt - 2; t += 2) {
            LDB(B0, 0, 0); SCHED; LDA(At, 0, 0); STAGE(SA(1, 1), A, brow + HALF, t + 1);
            WAIT_L(8); BAR; WAIT_L(0); MMA(0, 0, At, B0); BAR; SCHED;
            LDB(B1, 0, 1); STAGE(SB(0, 0), Bt, bcol, t + 2);
            BAR; WAIT_L(0); MMA(0, 1, At, B1); BAR;
            LDA(At, 0, 1); STAGE(SA(0, 0), A, brow, t + 2);
            BAR; WAIT_L(0); MMA(1, 0, At, B0); BAR; SCHED;
            STAGE(SB(0, 1), Bt, bcol + HALF, t + 2);
            WAIT_V(6); BAR; MMA(1, 1, At, B1); BAR;
            LDB(B0, 1, 0); SCHED; LDA(At, 1, 0); STAGE(SA(0, 1), A, brow + HALF, t + 2);
            WAIT_L(8); BAR; WAIT_L(0); MMA(0, 0, At, B0); BAR; SCHED;
            LDB(B1, 1, 1); STAGE(SB(1, 0), Bt, bcol, t + 3);
            BAR; WAIT_L(0); MMA(0, 1, At, B1); BAR;
            LDA(At, 1, 1); STAGE(SA(1, 0), A, brow, t + 3);
            BAR; WAIT_L(0); MMA(1, 0, At, B0); BAR; SCHED;
            STAGE(SB(1, 1), Bt, bcol + HALF, t + 3);
            WAIT_V(6); BAR; MMA(1, 1, At, B1); BAR;
        }
        tz0 = opaque_tid(); wid = tz0 >> 6; lane = tz0 & 63; wr = wid >> 2; wc = wid & 3; fr = lane & 15; fq = lane >> 4;
        { LDB(B0, 0, 0); WAIT_V(0); LDA(At, 0, 0); STAGE(SA(1, 1), A, brow + HALF, nt - 1);
          BAR; WAIT_L(0); MMA(0, 0, At, B0); BAR;
          LDB(B1, 0, 1); BAR; WAIT_L(0); MMA(0, 1, At, B1); BAR;
          LDA(At, 0, 1); WAIT_V(4); BAR; WAIT_L(0); MMA(1, 0, At, B0); MMA(1, 1, At, B1); BAR; }
        { LDB(B0, 1, 0); LDA(At, 1, 0); WAIT_V(2); BAR; WAIT_L(0); MMA(0, 0, At, B0); BAR;
          LDB(B1, 1, 1); WAIT_V(0); BAR; WAIT_L(0); MMA(0, 1, At, B1); BAR;
          LDA(At, 1, 1); BAR; WAIT_L(0); MMA(1, 0, At, B0); MMA(1, 1, At, B1); BAR; }
        if (wr == 0) BAR;
        float rsv[8];
        epi.pre(pm, wr, fr, rsv);
        const bool has_next = u + (int)gridDim.x < nu;
        int pm2 = pm, pn2 = pn;
        if (has_next) {
            unit_to_tile(u + gridDim.x, nM, nN, pm2, pn2);
            const int nbrow = pm2 * BM, nbcol = pn2 * BM;
            STAGE(SB(0, 0), Bt, nbcol, 0); STAGE(SA(0, 0), A, nbrow, 0);
            STAGE(SB(0, 1), Bt, nbcol + HALF, 0); STAGE(SA(0, 1), A, nbrow + HALF, 0);
        }
        epi(acc, rsv, pm, pn, wr, wc, fr, fq);
        if (!has_next) break;
        {
            const int nbrow = pm2 * BM, nbcol = pn2 * BM;
            if (wr == 1) BAR;
            WAIT_VN(4 + Epi::NSTORES); BAR;
            STAGE(SB(1, 0), Bt, nbcol, 1); STAGE(SA(1, 0), A, nbrow, 1); STAGE(SB(1, 1), Bt, nbcol + HALF, 1);
            WAIT_VN(6 + Epi::NSTORES); BAR;
        }
        u += gridDim.x; pm = pm2; pn = pn2;
    }
#undef SA
#undef SB
#undef STAGE_X
#undef STAGE
#undef LDA
#undef LDB
#undef MMA
#undef WAIT_V
#undef WAIT_VN
#undef WAIT_L
#undef BAR
#undef SCHED
}
}

__host__ __device__ __forceinline__ int perm32(int rho) { return 8 * ((rho >> 2) & 3) + 4 * (rho >> 4) + (rho & 3); }
__host__ __device__ __forceinline__ int perm32_inv(int a) { return 16 * ((a >> 2) & 1) + 4 * (a >> 3) + (a & 3); }
struct ConvJob { const float* src; int src_ld; bf16_t* dst; int dst_ld; int K, N; int map; float scale; const float* kscale; };
__device__ __forceinline__ int conv_col(int map, int n) {
    if (map == 1) return n < 3152 ? n : (n < OFF_CU ? -1 : n - (OFF_CU - 3152));
    if (map == 2) { const int j = n >> 8, r = n & 255; return (r < 128 ? 0 : FH) + j * 128 + (r & 127); }
    return n;
}
__device__ __forceinline__ ConvJob conv_job(const Params& p, int l, int j) {
    ConvJob c; c.map = 0; c.scale = 1.0f; c.kscale = nullptr;
    unsigned char* ws = p.ws;
    switch (j) {
    case 0: c.src = p.in[5] + (size_t)l * DM * IN_COLS; c.src_ld = IN_COLS; c.dst = (bf16_t*)(ws + W_IN); c.dst_ld = DM; c.K = DM; c.N = NPROJ; c.map = 1; c.kscale = p.in[3] + (size_t)l * DM; break;
    case 1: c.src = p.in[12] + (size_t)l * 512 * 1024; c.src_ld = 1024; c.dst = (bf16_t*)(ws + W_B) + (size_t)1536 * 512; c.dst_ld = 512; c.K = 512; c.N = 1024; c.scale = 1.0f / 32.0f; break;
    case 2: c.src = p.in[6] + (size_t)l * DM * DM; c.src_ld = DM; c.dst = (bf16_t*)(ws + W_OUT); c.dst_ld = NMIX; c.K = DM; c.N = DM; break;
    case 3: c.src = p.in[14] + (size_t)l * 256 * 768; c.src_ld = 768; c.dst = (bf16_t*)(ws + W_UVT); c.dst_ld = 256; c.K = 256; c.N = 768; break;
    case 4: c.src = p.in[22] + (size_t)l * DM * 512; c.src_ld = 512; c.dst = (bf16_t*)(ws + W_XQ); c.dst_ld = DM; c.K = DM; c.N = 512; c.kscale = p.in[19] + (size_t)l * DM; break;
    case 5: c.src = p.in[23] + (size_t)l * DM * 1024; c.src_ld = 1024; c.dst = (bf16_t*)(ws + W_XKV); c.dst_ld = DM; c.K = DM; c.N = 1024; break;
    case 6: c.src = p.in[24] + (size_t)l * 512 * DM; c.src_ld = DM; c.dst = (bf16_t*)(ws + W_XO); c.dst_ld = 512; c.K = 512; c.N = DM; break;
    case 7: c.src = p.in[27] + (size_t)l * DM * 2 * FH; c.src_ld = 2 * FH; c.dst = (bf16_t*)(ws + W_GU); c.dst_ld = DM; c.K = DM; c.N = 2 * FH; c.map = 2; c.kscale = p.in[25] + (size_t)l * DM; break;
    default: c.src = p.in[28] + (size_t)l * FH * DM; c.src_ld = DM; c.dst = (bf16_t*)(ws + W_DOWN); c.dst_ld = FH; c.K = FH; c.N = DM; break;
    }
    return c;
}
constexpr int NCONV = 9;

struct ConvRegs { f32x4 r[8]; };
__device__ __forceinline__ void conv_load(const ConvJob& c, int kt, int nt, int tid, ConvRegs& R) {
    const int n = nt * 128 + (tid & 31) * 4, k = kt * 128 + (tid >> 5) * 8;
    const int col = conv_col(c.map, (n & ~31) | perm32(n & 31));
    if (col >= 0) {
        const float* sp = c.src + (size_t)k * c.src_ld + col;
#pragma unroll
        for (int i = 0; i < 8; ++i) R.r[i] = *(const f32x4*)(sp + (size_t)i * c.src_ld);
    } else {
#pragma unroll
        for (int i = 0; i < 8; ++i) R.r[i] = (f32x4){0.f, 0.f, 0.f, 0.f};
    }
}
__device__ __forceinline__ void conv_gain(const ConvJob& c, int kt, int tid, f32x4& g0, f32x4& g1) {
    const int k = kt * 128 + (tid >> 5) * 8;
    if (c.kscale) { g0 = *(const f32x4*)(c.kscale + k); g1 = *(const f32x4*)(c.kscale + k + 4); }
    else { g0 = (f32x4){c.scale, c.scale, c.scale, c.scale}; g1 = g0; }
}
__device__ __forceinline__ void conv_stage(const ConvJob& c, int kt, int tid, const ConvRegs& R, const f32x4& g0, const f32x4& g1, unsigned char* buf) {
    const int n4 = tid & 31, kg = tid >> 5;
    const float sc[8] = {g0[0], g0[1], g0[2], g0[3], g1[0], g1[1], g1[2], g1[3]};
#pragma unroll
    for (int j = 0; j < 4; ++j) {
        u32x4 w;
        w.x = cvt_pk_bf16(R.r[0][j] * sc[0], R.r[1][j] * sc[1]); w.y = cvt_pk_bf16(R.r[2][j] * sc[2], R.r[3][j] * sc[3]);
        w.z = cvt_pk_bf16(R.r[4][j] * sc[4], R.r[5][j] * sc[5]); w.w = cvt_pk_bf16(R.r[6][j] * sc[6], R.r[7][j] * sc[7]);
        *(u32x4*)(buf + (n4 * 4 + j) * 256 + ((kg ^ (n4 & 15)) << 4)) = w;
    }
}
__device__ __forceinline__ void conv_flush(const ConvJob& c, int kt, int nt, int tid, const unsigned char* buf) {
    const int k16 = tid & 15;
#pragma unroll
    for (int i = 0; i < 4; ++i) {
        const int n = (tid >> 4) + 32 * i;
        const u32x4 w = *(const u32x4*)(buf + n * 256 + ((k16 ^ ((n >> 2) & 15)) << 4));
        *(u32x4*)(c.dst + (size_t)(nt * 128 + n) * c.dst_ld + kt * 128 + k16 * 8) = w;
    }
}
constexpr int NCONV_EARLY = 7;
__device__ __forceinline__ bool conv_locate(const Params& p, int l, int g, int j0, int j1, ConvJob& c, int& kt, int& nt) {
    for (int j = j0; j < j1; ++j) {
        c = conv_job(p, l, j);
        const int nk = c.K / 128, n = nk * (c.N / 128);
        if (g < n) { kt = g % nk; nt = g / nk; return true; }
        g -= n;
    }
    return false;
}

__device__ void combo_tile(const float* Ap, int a_i, int a_d, const float* Bp, int b_j, bf16_t* dst, int ldc, float scale, unsigned char* smem) {
    constexpr int S = 132;
    float* As = (float*)smem; float* Bs = As + 64 * S;
    const int tid = opaque_tid();
    __syncthreads();
#pragma unroll
    for (int q = 0; q < 4; ++q) {
        const int idx = tid + 512 * q;
        { const int j = idx >> 5, d4 = (idx & 31) * 4; *(f32x4*)(Bs + j * S + d4) = *(const f32x4*)(Bp + (size_t)j * b_j + d4); }
        if (a_d == 1) { const int i = idx >> 5, d4 = (idx & 31) * 4; *(f32x4*)(As + i * S + d4) = *(const f32x4*)(Ap + (size_t)i * a_i + d4); }
        else { const int e = idx >> 4, i4 = (idx & 15) * 4; const f32x4 v = *(const f32x4*)(Ap + (size_t)e * a_d + i4);
               As[(i4 + 0) * S + e] = v[0]; As[(i4 + 1) * S + e] = v[1]; As[(i4 + 2) * S + e] = v[2]; As[(i4 + 3) * S + e] = v[3]; }
    }
    __syncthreads();
    const int ty = tid >> 4, tx = tid & 15;
    float acc[2][4] = {{0.f, 0.f, 0.f, 0.f}, {0.f, 0.f, 0.f, 0.f}};
#pragma unroll 4
    for (int d4 = 0; d4 < 128; d4 += 4) {
        const f32x4 a0 = *(const f32x4*)(As + (2 * ty) * S + d4), a1 = *(const f32x4*)(As + (2 * ty + 1) * S + d4);
#pragma unroll
        for (int c = 0; c < 4; ++c) {
            const f32x4 b = *(const f32x4*)(Bs + (tx + 16 * c) * S + d4);
            acc[0][c] += a0[0] * b[0] + a0[1] * b[1] + a0[2] * b[2] + a0[3] * b[3];
            acc[1][c] += a1[0] * b[0] + a1[1] * b[1] + a1[2] * b[2] + a1[3] * b[3];
        }
    }
#pragma unroll
    for (int r = 0; r < 2; ++r) {
        const int i = 2 * ty + r, ip = (i & ~31) | perm32_inv(i & 31);
#pragma unroll
        for (int c = 0; c < 4; ++c) dst[(size_t)ip * ldc + tx + 16 * c] = f2bf(acc[r][c] * scale);
    }
}

__device__ __forceinline__ void rownorm_to_bf16(const float* src, const float* g, bf16_t* dst, int lane) {
    f32x4 v[8]; float ss = 0.f;
#pragma unroll
    for (int i = 0; i < 8; ++i) { v[i] = *(const f32x4*)(src + (i * 64 + lane) * 4); ss += v[i][0] * v[i][0] + v[i][1] * v[i][1] + v[i][2] * v[i][2] + v[i][3] * v[i][3]; }
    ss = wave_sum(ss);
    const float r = rsqrtf(ss * (1.0f / DM) + EPS);
#pragma unroll
    for (int i = 0; i < 8; ++i) {
        const f32x4 gg = *(const f32x4*)(g + (i * 64 + lane) * 4);
        u32x2 w; w.x = cvt_pk_bf16(v[i][0] * r * gg[0], v[i][1] * r * gg[1]); w.y = cvt_pk_bf16(v[i][2] * r * gg[2], v[i][3] * r * gg[3]);
        *(u32x2*)(dst + (i * 64 + lane) * 4) = w;
    }
}

__device__ __forceinline__ int rel_bucket(int n) {
    if (n < 16) return n;
    const int b = 16 + (int)(logf((float)n / 16.0f) / 2.0794415416798357f * 16.0f);
    return b < 31 ? b : 31;
}

__device__ __forceinline__ void conv_run(const Params& p, int l, int j0, int j1, int g0, int stride, int cnt, int tid, unsigned char* smem) {
    ConvJob c0, c1; int kt0 = 0, nt0 = 0, kt1 = 0, nt1 = 0;
    ConvRegs R0, R1;
    int g = g0;
    __syncthreads();
    bool v0 = cnt > 0 && conv_locate(p, l, g, j0, j1, c0, kt0, nt0);
    if (v0) conv_load(c0, kt0, nt0, tid, R0);
    while (v0) {
        f32x4 ga, gb; conv_gain(c0, kt0, tid, ga, gb);
        const bool v1 = cnt > 1 && conv_locate(p, l, g + stride, j0, j1, c1, kt1, nt1);
        if (v1) conv_load(c1, kt1, nt1, tid, R1);
        conv_stage(c0, kt0, tid, R0, ga, gb, smem);
        __syncthreads();
        conv_flush(c0, kt0, nt0, tid, smem);
        if (!v1) break;
        conv_gain(c1, kt1, tid, ga, gb);
        g += 2 * stride; cnt -= 2;
        v0 = cnt > 0 && conv_locate(p, l, g, j0, j1, c0, kt0, nt0);
        if (v0) conv_load(c0, kt0, nt0, tid, R0);
        conv_stage(c1, kt1, tid, R1, ga, gb, smem + 32768);
        __syncthreads();
        conv_flush(c1, kt1, nt1, tid, smem + 32768);
    }
}

__device__ void phase_weights(const Params& p, int l, unsigned char* smem) {
    const int tid = opaque_tid(), wid = tid >> 6, lane = tid & 63;
    const int gtid = blockIdx.x * NTHREADS + tid, gthreads = gridDim.x * NTHREADS;
    unsigned char* ws = p.ws;
    conv_run(p, l, 0, NCONV_EARLY, blockIdx.x, gridDim.x, 1 << 30, tid, smem);
    {
        const float* uq = p.in[11] + (size_t)l * 512 * 768;
        const float* uk = p.in[13] + (size_t)l * 256 * 768;
        const float* uv = p.in[14] + (size_t)l * 256 * 768;
        const float* wo = p.in[6] + (size_t)l * DM * DM;
        for (int t = blockIdx.x; t < 192; t += gridDim.x) {
            {
                const int it = t >> 3, jt = t & 7, n0 = it * 64, h = n0 >> 8, rkv0 = n0 & 255;
                combo_tile(uk + (size_t)rkv0 * 768 + h * 128, 768, 1, uq + (size_t)(jt * 64) * 768 + h * 128, 768,
                           (bf16_t*)(ws + W_B) + (size_t)n0 * 512 + jt * 64, 512, 0.08838834764831845f, smem);
            }
        }
    }
    for (int r = blockIdx.x * 8 + wid; r < MEMROWS; r += gridDim.x * 8)
        rownorm_to_bf16(p.in[1] + (size_t)r * DM, p.in[21] + (size_t)l * DM, (bf16_t*)(ws + WS_MEMN) + (size_t)r * DM, lane);
    if (l == 0) {
        {
            const int stride = gridDim.x * 8;
            int r = blockIdx.x * 8 + wid;
            f32x4 nx[8];
            if (r < MTOK) {
#pragma unroll
                for (int i = 0; i < 8; ++i) nx[i] = *(const f32x4*)(p.in[0] + (size_t)r * DM + (i * 64 + lane) * 4);
            }
            for (; r < MTOK; r += stride) {
                bf16_t* dst = (bf16_t*)(ws + WS_H16) + (size_t)r * DM;
                f32x4 v[8];
#pragma unroll
                for (int i = 0; i < 8; ++i) v[i] = nx[i];
                if (r + stride < MTOK) {
#pragma unroll
                    for (int i = 0; i < 8; ++i) nx[i] = *(const f32x4*)(p.in[0] + (size_t)(r + stride) * DM + (i * 64 + lane) * 4);
                }
                float ss = 0.f;
#pragma unroll
                for (int i = 0; i < 8; ++i) { ss += v[i][0] * v[i][0] + v[i][1] * v[i][1] + v[i][2] * v[i][2] + v[i][3] * v[i][3];
                    u32x2 w; w.x = cvt_pk_bf16(v[i][0], v[i][1]); w.y = cvt_pk_bf16(v[i][2], v[i][3]); *(u32x2*)(dst + (i * 64 + lane) * 4) = w; }
                ss = wave_sum(ss);
                if (lane < 8) ((float*)(ws + WS_SSQ))[(size_t)r * 8 + lane] = lane == 0 ? ss : 0.f;
            }
        }
        float* lut = (float*)(ws + WS_LUT);
        for (int o = gtid; o < 12 * 128; o += gthreads) { const int h = o >> 7, d = o & 127; lut[o] = p.in[2][rel_bucket(d) * 12 + h] * LOG2E; }
    }
    if (blockIdx.x == 0 && wid == 0) {
        bool ok = true;
#if PROBE_CHK
        {
            typedef int v2i __attribute__((ext_vector_type(2)));
            unsigned char* tb = smem + 100000;
            const int g = lane >> 4, i = lane & 15;
#if PROBE_CHK & 1
            for (int e = lane; e < 512; e += 64) { const int gg = e >> 7, rr = (e >> 4) & 7, cc = e & 15; tb[e] = (unsigned char)((rr * 16 + cc + 37 * gg) & 255); }
            asm volatile("s_waitcnt lgkmcnt(0)" ::: "memory");
            const v2i r = __builtin_amdgcn_ds_read_tr8_b64_v2i32((LAS v2i*)(tb + g * 128 + (i >> 1) * 16 + (i & 1) * 8));
            unsigned long long got = ((unsigned long long)(unsigned)r.y << 32) | (unsigned)r.x, want = 0ull;
            for (int e = 0; e < 8; ++e) want |= (unsigned long long)((e * 16 + i + 37 * g) & 255) << (8 * e);
            ok = ok && __all(got == want);
#endif
#if PROBE_CHK & 2
            unsigned long long av = 0ull, bv = 0ull;
            for (int e = 0; e < 8; e += 2) {
                const int k0 = 8 * g + e;
                const int pa = __builtin_amdgcn_cvt_pk_fp8_f32((float)((i + 2 * k0) % 5), (float)((i + 2 * (k0 + 1)) % 5), 0, false);
                const int pb = __builtin_amdgcn_cvt_pk_fp8_f32((float)((3 * i + k0) % 7), (float)((3 * i + k0 + 1) % 7), 0, false);
                av |= (unsigned long long)(pa & 0xFFFF) << (8 * e); bv |= (unsigned long long)(pb & 0xFFFF) << (8 * e);
            }
            f32x4 acc = {0.f, 0.f, 0.f, 0.f};
            acc = __builtin_amdgcn_mfma_f32_16x16x32_fp8_fp8((long)av, (long)bv, acc, 0, 0, 0);
            bool good = true;
            for (int r = 0; r < 4; ++r) { const int ii = 4 * g + r, jj = i; float want2 = 0.f; for (int k = 0; k < 32; ++k) want2 += (float)(((ii + 2 * k) % 5) * ((3 * jj + k) % 7)); good = good && (acc[r] == want2); }
            ok = ok && __all(good);
#endif
        }
#endif
        const float* lp = p.in[7] + (size_t)l * 256;
        float a = lp[lane] * lp[64 + lane], b = lp[128 + lane] * lp[192 + lane];
        a = wave_sum(a); b = wave_sum(b);
        if (lane == 0) ((float*)(ws + WS_LAM))[l] = ok ? expf(a) - expf(b) + (0.8f - 0.6f * expf(-0.3f * (float)l)) : __builtin_nanf("");
    }
}

__device__ void phase_post(const bf16_t* tmp, const float* hold32, bf16_t* h16, float* out32, const float* g_post, float* rstd) {
    const int tid = opaque_tid(), wid = tid >> 6, lane = tid & 63;
    f32x4 gg[8];
#pragma unroll
    for (int i = 0; i < 4; ++i) { gg[2 * i] = *(const f32x4*)(g_post + (i * 64 + lane) * 8); gg[2 * i + 1] = *(const f32x4*)(g_post + (i * 64 + lane) * 8 + 4); }
    const int stride = gridDim.x * 8;
    u32x4 tw[4], hw[4]; f32x4 hf[8];
#define PP_LOAD(r_) do { _Pragma("unroll") for (int i_ = 0; i_ < 4; ++i_) { \
        tw[i_] = *(const u32x4*)(tmp + (size_t)(r_) * DM + (i_ * 64 + lane) * 8); \
        if (hold32) { hf[2 * i_] = *(const f32x4*)(hold32 + (size_t)(r_) * DM + (i_ * 64 + lane) * 8); hf[2 * i_ + 1] = *(const f32x4*)(hold32 + (size_t)(r_) * DM + (i_ * 64 + lane) * 8 + 4); } \
        else hw[i_] = *(const u32x4*)(h16 + (size_t)(r_) * DM + (i_ * 64 + lane) * 8); } } while (0)
    int r = blockIdx.x * 8 + wid;
    if (r < MTOK) PP_LOAD(r);
    for (; r < MTOK; r += stride) {
        bf16_t* hr = h16 + (size_t)r * DM;
        f32x4 v[8], hv[8]; float ss = 0.f;
#pragma unroll
        for (int i = 0; i < 4; ++i) {
            v[2 * i] = (f32x4){bflo(tw[i].x), bfhi(tw[i].x), bflo(tw[i].y), bfhi(tw[i].y)}; v[2 * i + 1] = (f32x4){bflo(tw[i].z), bfhi(tw[i].z), bflo(tw[i].w), bfhi(tw[i].w)};
            if (hold32) { hv[2 * i] = hf[2 * i]; hv[2 * i + 1] = hf[2 * i + 1]; }
            else { hv[2 * i] = (f32x4){bflo(hw[i].x), bfhi(hw[i].x), bflo(hw[i].y), bfhi(hw[i].y)}; hv[2 * i + 1] = (f32x4){bflo(hw[i].z), bfhi(hw[i].z), bflo(hw[i].w), bfhi(hw[i].w)}; }
        }
#pragma unroll
        for (int i = 0; i < 8; ++i) ss += v[i][0] * v[i][0] + v[i][1] * v[i][1] + v[i][2] * v[i][2] + v[i][3] * v[i][3];
        if (r + stride < MTOK) PP_LOAD(r + stride);
        ss = wave_sum(ss);
        const float rr = rsqrtf(ss * (1.0f / DM) + EPS);
        float s2 = 0.f;
#pragma unroll
        for (int i = 0; i < 8; ++i) hv[i] = hv[i] + v[i] * rr * gg[i];
#pragma unroll
        for (int i = 0; i < 4; ++i) {
            if (out32) { *(f32x4*)(out32 + (size_t)r * DM + (i * 64 + lane) * 8) = hv[2 * i]; *(f32x4*)(out32 + (size_t)r * DM + (i * 64 + lane) * 8 + 4) = hv[2 * i + 1]; }
            else {
                u32x4 w; w.x = cvt_pk_bf16(hv[2 * i][0], hv[2 * i][1]); w.y = cvt_pk_bf16(hv[2 * i][2], hv[2 * i][3]); w.z = cvt_pk_bf16(hv[2 * i + 1][0], hv[2 * i + 1][1]); w.w = cvt_pk_bf16(hv[2 * i + 1][2], hv[2 * i + 1][3]);
                *(u32x4*)(hr + (i * 64 + lane) * 8) = w;
                const float e0 = bflo(w.x), e1 = bfhi(w.x), e2 = bflo(w.y), e3 = bfhi(w.y), e4 = bflo(w.z), e5 = bfhi(w.z), e6 = bflo(w.w), e7 = bfhi(w.w);
                s2 += e0 * e0 + e1 * e1 + e2 * e2 + e3 * e3 + e4 * e4 + e5 * e5 + e6 * e6 + e7 * e7;
            }
        }
        if (!out32) { s2 = wave_sum(s2); if (lane < 8) rstd[(size_t)r * 8 + lane] = lane == 0 ? s2 : 0.f; }
    }
#undef PP_LOAD
}

__device__ void phase_latent_norms(const Params& p, int l) {
    const int tid = opaque_tid(), wid = tid >> 6, lane = tid & 63;
    const bf16_t* proj = (const bf16_t*)(p.ws + WS_PROJ);
    bf16_t* cqn = (bf16_t*)(p.ws + WS_CQN); unsigned char* ckv8 = p.ws + WS_CKVN;
    float* cstat = (float*)(p.ws + WS_CSTAT);
    const float* gq = p.in[9] + (size_t)l * 512; const float* gkv = p.in[10] + (size_t)l * 256;
    const f32x4 g0 = *(const f32x4*)(gq + lane * 8), g1 = *(const f32x4*)(gq + lane * 8 + 4), g2 = *(const f32x4*)(gkv + lane * 4);
    const int stride = gridDim.x * 8;
    int r = blockIdx.x * 8 + wid;
    u32x4 na = {0u, 0u, 0u, 0u}, ncv = {0u, 0u, 0u, 0u}; u32x2 nb = {0u, 0u};
    if (r < MTOK) { na = *(const u32x4*)(proj + (size_t)r * NPROJ + OFF_CQ + lane * 8); nb = *(const u32x2*)(proj + (size_t)r * NPROJ + OFF_CKV + lane * 4); ncv = *(const u32x4*)(proj + (size_t)r * NPROJ + OFF_CV + lane * 8); }
    for (; r < MTOK; r += stride) {
        const u32x4 a = na; const u32x2 b = nb; const u32x4 cvv = ncv;
        if (r + stride < MTOK) { const size_t rn = (size_t)(r + stride);
            na = *(const u32x4*)(proj + rn * NPROJ + OFF_CQ + lane * 8); nb = *(const u32x2*)(proj + rn * NPROJ + OFF_CKV + lane * 4); ncv = *(const u32x4*)(proj + rn * NPROJ + OFF_CV + lane * 8); }
        float x[8] = {bflo(a.x), bfhi(a.x), bflo(a.y), bfhi(a.y), bflo(a.z), bfhi(a.z), bflo(a.w), bfhi(a.w)};
        float y[4] = {bflo(b.x), bfhi(b.x), bflo(b.y), bfhi(b.y)};
        float z[8] = {bflo(cvv.x), bfhi(cvv.x), bflo(cvv.y), bfhi(cvv.y), bflo(cvv.z), bfhi(cvv.z), bflo(cvv.w), bfhi(cvv.w)};
        float sa = 0.f, sb = 0.f, sc = 0.f, sd = 0.f;
#pragma unroll
        for (int i = 0; i < 8; ++i) { sa += x[i] * x[i]; sc += z[i]; sd += z[i] * z[i]; }
#pragma unroll
        for (int i = 0; i < 4; ++i) sb += y[i] * y[i];
        sa = wave_sum(sa); sb = wave_sum(sb); sc = wave_sum(sc); sd = wave_sum(sd);
        const float ra = rsqrtf(sa * (1.0f / 512.0f) + EPS), rb = rsqrtf(sb * (1.0f / 256.0f) + EPS);
        const float mu = sc * (1.0f / 512.0f), var = fmaxf(sd * (1.0f / 512.0f) - mu * mu, 0.f);
        u32x4 wa; wa.x = cvt_pk_bf16(x[0] * ra * g0[0], x[1] * ra * g0[1]); wa.y = cvt_pk_bf16(x[2] * ra * g0[2], x[3] * ra * g0[3]);
        wa.z = cvt_pk_bf16(x[4] * ra * g1[0], x[5] * ra * g1[1]); wa.w = cvt_pk_bf16(x[6] * ra * g1[2], x[7] * ra * g1[3]);
        int wb = __builtin_amdgcn_cvt_pk_fp8_f32(y[0] * rb * g2[0], y[1] * rb * g2[1], 0, false);
        wb = __builtin_amdgcn_cvt_pk_fp8_f32(y[2] * rb * g2[2], y[3] * rb * g2[3], wb, true);
        *(u32x4*)(cqn + (size_t)r * 512 + lane * 8) = wa;
        *(int*)(ckv8 + (size_t)r * 256 + lane * 4) = wb;
        if (lane == 0) { cstat[2 * (size_t)r] = mu; cstat[2 * (size_t)r + 1] = rsqrtf(var + EPS); }
    }
}

__device__ void cbranch_unit(const Params& p, int l, int unit, unsigned char* smem) {
    constexpr int LS = 136;
    bf16_t* Ws = (bf16_t*)smem;
    bf16_t* Vs = Ws + 128 * LS;
    const int tid = opaque_tid(), wid = tid >> 6, lane = tid & 63;
    const int chunk = unit >> 2, g = unit & 3, r0 = chunk * 128;
    const bf16_t* proj = (const bf16_t*)(p.ws + WS_PROJ);
    const float* cstat = (const float*)(p.ws + WS_CSTAT);
    bf16_t* mix = (bf16_t*)(p.ws + WS_MIX);
    __syncthreads();
    {
        const int c8 = (tid & 15) * 8;
        const float* lg = p.in[15] + (size_t)l * 512 + g * 128 + c8;
        const float* lb = p.in[16] + (size_t)l * 512 + g * 128 + c8;
        const f32x4 lg0 = *(const f32x4*)lg, lg1 = *(const f32x4*)(lg + 4), lb0 = *(const f32x4*)lb, lb1 = *(const f32x4*)(lb + 4);
#pragma unroll
        for (int i = 0; i < 4; ++i) {
            const int sr = (tid >> 4) + 32 * i;
            const u32x4 a = *(const u32x4*)(proj + (size_t)(r0 + sr) * NPROJ + OFF_CV + g * 128 + c8);
            const float mu = cstat[2 * (size_t)(r0 + sr)], rs = cstat[2 * (size_t)(r0 + sr) + 1];
            u32x4 o;
            o.x = cvt_pk_bf16((bflo(a.x) - mu) * rs * lg0[0] + lb0[0], (bfhi(a.x) - mu) * rs * lg0[1] + lb0[1]);
            o.y = cvt_pk_bf16((bflo(a.y) - mu) * rs * lg0[2] + lb0[2], (bfhi(a.y) - mu) * rs * lg0[3] + lb0[3]);
            o.z = cvt_pk_bf16((bflo(a.z) - mu) * rs * lg1[0] + lb1[0], (bfhi(a.z) - mu) * rs * lg1[1] + lb1[1]);
            o.w = cvt_pk_bf16((bflo(a.w) - mu) * rs * lg1[2] + lb1[2], (bfhi(a.w) - mu) * rs * lg1[3] + lb1[3]);
            *(u32x4*)(Vs + sr * LS + c8) = o;
        }
        const float* wsrc = p.in[17] + ((size_t)l * 4 + g) * 128 * 128;
        const int s4 = (tid & 31) * 4;
#pragma unroll
        for (int i = 0; i < 8; ++i) {
            const int tr = (tid >> 5) + 16 * i;
            const f32x4 w = *(const f32x4*)(wsrc + (size_t)tr * 128 + s4);
            u32x2 o; o.x = cvt_pk_bf16(s4 <= tr ? w[0] : 0.f, s4 + 1 <= tr ? w[1] : 0.f); o.y = cvt_pk_bf16(s4 + 2 <= tr ? w[2] : 0.f, s4 + 3 <= tr ? w[3] : 0.f);
            *(u32x2*)(Ws + tr * LS + s4) = o;
        }
    }
    __syncthreads();
    const int fr = lane & 15, fq = lane >> 4, q4 = fr >> 2, p4 = lane & 3;
    const int t = wid * 16 + fr;
    const float bs = p.in[18][((size_t)l * 4 + g) * 128 + t];
    bf16x8 bw[4];
#pragma unroll
    for (int ks = 0; ks < 4; ++ks) bw[ks] = *(const bf16x8*)(Ws + t * LS + ks * 32 + fq * 8);
    const unsigned char* vtr = (const unsigned char*)Vs + ((8 * fq + q4) * LS + 4 * p4) * 2;
    u32x2 uu[8];
#pragma unroll
    for (int ct = 0; ct < 8; ++ct) uu[ct] = *(const u32x2*)(proj + (size_t)(r0 + t) * NPROJ + OFF_CU + g * 128 + ct * 16 + fq * 4);
#pragma unroll
    for (int ct = 0; ct < 8; ++ct) {
        f32x4 acc = {0.f, 0.f, 0.f, 0.f};
        s16x4 lo[4], hi[4];
#pragma unroll
        for (int ks = 0; ks < 4; ++ks) {
            lo[ks] = __builtin_amdgcn_ds_read_tr16_b64_v4i16((LAS s16x4*)(vtr + (32 * ks) * LS * 2 + ct * 32));
            hi[ks] = __builtin_amdgcn_ds_read_tr16_b64_v4i16((LAS s16x4*)(vtr + (32 * ks + 4) * LS * 2 + ct * 32));
        }
#pragma unroll
        for (int ks = 0; ks < 4; ++ks) {
            const bf16x8 af = __builtin_shufflevector(lo[ks], hi[ks], 0, 1, 2, 3, 4, 5, 6, 7);
            acc = __builtin_amdgcn_mfma_f32_16x16x32_bf16(af, bw[ks], acc, 0, 0, 0);
        }
        const int c = ct * 16 + fq * 4;
        const u32x2 u = uu[ct];
        u32x2 o; o.x = cvt_pk_bf16(bflo(u.x) * (acc[0] + bs), bfhi(u.x) * (acc[1] + bs)); o.y = cvt_pk_bf16(bflo(u.y) * (acc[2] + bs), bfhi(u.y) * (acc[3] + bs));
        *(u32x2*)(mix + (size_t)(r0 + t) * NMIX + 1536 + g * 128 + c) = o;
    }
}

namespace at {
constexpr int VS = 320;
__device__ __forceinline__ int crow(int r, int hi) { return (r & 3) + 8 * (r >> 2) + 4 * hi; }

template <int DQK, bool CAUSAL>
__device__ __forceinline__ void attn_pass(const bf16_t* __restrict__ Qp, const int ldq, const bf16_t* __restrict__ Kp, const int ldk,
                                          const bf16_t* __restrict__ Vp, const int ldv, const int q0, const int ntiles, const float c2,
                                          const float* lutp, f32x16 (&O)[4], float& lsum_out, unsigned char* smem) {
    constexpr int KS = DQK * 2 + 16, KB = 64 * KS, BUF = KB + 64 * VS, NKC = DQK / 64, NKS = DQK / 16;
    const int tid = opaque_tid(), wid = tid >> 6, lane = tid & 63, l31 = lane & 31, hi = lane >> 5;
    const int krow = (DQK == 64) ? (tid >> 3) : (tid >> 4), kch = (DQK == 64) ? (tid & 7) : (tid & 15);
    const int vrow = tid >> 4, vch = tid & 15;
    u32x4 kr[NKC], vr[2];
#define AT_GLOAD(j) do { const int k0_ = (j) * 64; \
        for (int i_ = 0; i_ < NKC; ++i_) kr[i_] = *(const u32x4*)(Kp + (size_t)(k0_ + krow + 32 * i_) * ldk + kch * 8); \
        for (int i_ = 0; i_ < 2; ++i_) vr[i_] = *(const u32x4*)(Vp + (size_t)(k0_ + vrow + 32 * i_) * ldv + vch * 8); } while (0)
#define AT_LSTORE(buf) do { \
        for (int i_ = 0; i_ < NKC; ++i_) *(u32x4*)((buf) + (krow + 32 * i_) * KS + kch * 16) = kr[i_]; \
        for (int i_ = 0; i_ < 2; ++i_) *(u32x4*)((buf) + KB + (vrow + 32 * i_) * VS + vch * 16) = vr[i_]; } while (0)
    bf16x8 qf[NKS];
#pragma unroll
    for (int ks = 0; ks < NKS; ++ks) qf[ks] = *(const bf16x8*)(Qp + (size_t)(wid * 32 + l31) * ldq + ks * 16 + hi * 8);
#pragma unroll
    for (int d = 0; d < 4; ++d)
#pragma unroll
        for (int r = 0; r < 16; ++r) O[d][r] = 0.f;
    float m = -1e30f, lsum = 0.f;
    const int qw0 = q0 + wid * 32;
    const int q4 = (lane & 15) >> 2, p4 = lane & 3, blk = (lane >> 4) & 1;
    const int vtr = (4 * hi + q4) * VS + (16 * blk + 4 * p4) * 2;
    __syncthreads();
    AT_GLOAD(0);
    AT_LSTORE(smem);
    if (ntiles > 1) AT_GLOAD(1);
    __syncthreads();
    const float lut127 = CAUSAL ? lutp[127] : 0.f;
#pragma unroll 1
    for (int j = 0; j < ntiles; ++j) {
        unsigned char* buf = smem + (j & 1) * BUF;
        if (j + 1 < ntiles) { AT_LSTORE(smem + ((j + 1) & 1) * BUF); if (j + 2 < ntiles) AT_GLOAD(j + 2); }
        const int k0 = j * 64;
        if (!CAUSAL || k0 <= qw0 + 31) {
            f32x16 st[2];
#pragma unroll
            for (int kt = 0; kt < 2; ++kt)
#pragma unroll
                for (int r = 0; r < 16; ++r) st[kt][r] = 0.f;
            if (DQK == 64) {
                bf16x8 kf[2][NKS];
#pragma unroll
                for (int kt = 0; kt < 2; ++kt)
#pragma unroll
                    for (int ks = 0; ks < NKS; ++ks) kf[kt][ks] = *(const bf16x8*)(buf + (kt * 32 + l31) * KS + (ks * 16 + hi * 8) * 2);
                __builtin_amdgcn_sched_barrier(0);
#pragma unroll
                for (int ks = 0; ks < NKS; ++ks)
#pragma unroll
                    for (int kt = 0; kt < 2; ++kt) st[kt] = __builtin_amdgcn_mfma_f32_32x32x16_bf16(kf[kt][ks], qf[ks], st[kt], 0, 0, 0);
                __builtin_amdgcn_sched_barrier(0);
            } else {
#pragma unroll
                for (int kt = 0; kt < 2; ++kt) {
                    bf16x8 kf[NKS];
#pragma unroll
                    for (int ks = 0; ks < NKS; ++ks) kf[ks] = *(const bf16x8*)(buf + (kt * 32 + l31) * KS + (ks * 16 + hi * 8) * 2);
                    __builtin_amdgcn_sched_barrier(0);
#pragma unroll
                    for (int ks = 0; ks < NKS; ++ks) st[kt] = __builtin_amdgcn_mfma_f32_32x32x16_bf16(kf[ks], qf[ks], st[kt], 0, 0, 0);
                    __builtin_amdgcn_sched_barrier(0);
                }
            }
            const bool unif = !CAUSAL || (qw0 - (k0 + 63) >= 127);
            float pmax;
            if (unif) {
                pmax = st[0][0];
#pragma unroll
                for (int r = 1; r < 16; ++r) pmax = fmaxf(pmax, st[0][r]);
#pragma unroll
                for (int r = 0; r < 16; ++r) pmax = fmaxf(pmax, st[1][r]);
                pmax = fmaf(pmax, c2, lut127);
            } else {
                const int tq = qw0 + l31;
                pmax = -__builtin_inff();
                float bias[2][16];
#pragma unroll
                for (int kt = 0; kt < 2; ++kt)
#pragma unroll
                    for (int r = 0; r < 16; ++r) {
                        const int dd = tq - (k0 + 32 * kt + crow(r, hi));
                        bias[kt][r] = lutp[dd < 0 ? 0 : (dd > 127 ? 127 : dd)];
                    }
                __builtin_amdgcn_sched_barrier(0);
#pragma unroll
                for (int kt = 0; kt < 2; ++kt)
#pragma unroll
                    for (int r = 0; r < 16; ++r) {
                        const int dd = tq - (k0 + 32 * kt + crow(r, hi));
                        st[kt][r] = dd < 0 ? -__builtin_inff() : fmaf(st[kt][r], c2, bias[kt][r]);
                        pmax = fmaxf(pmax, st[kt][r]);
                    }
            }
            pmax = fmaxf(pmax, __shfl_xor(pmax, 32, 64));
            if (!__all(pmax - m <= 8.0f)) {
                const float mn = fmaxf(m, pmax);
                const float alpha = fast_exp2(m - mn);
                m = mn;
                lsum *= alpha;
#pragma unroll
                for (int d = 0; d < 4; ++d)
#pragma unroll
                    for (int r = 0; r < 16; ++r) O[d][r] *= alpha;
            }
            float ps = 0.f;
            const float off = unif ? lut127 - m : -m, csc = unif ? c2 : 1.0f;
            bf16x8 pf[2][2];
#define AT_EXP(kt) do { _Pragma("unroll") for (int r = 0; r < 16; ++r) { st[kt][r] = fast_exp2(fmaf(st[kt][r], csc, off)); ps += st[kt][r]; } \
                _Pragma("unroll") for (int s_ = 0; s_ < 2; ++s_) { \
                    u32x4 w; w.x = cvt_pk_bf16(st[kt][8 * s_ + 0], st[kt][8 * s_ + 1]); w.y = cvt_pk_bf16(st[kt][8 * s_ + 2], st[kt][8 * s_ + 3]); \
                    w.z = cvt_pk_bf16(st[kt][8 * s_ + 4], st[kt][8 * s_ + 5]); w.w = cvt_pk_bf16(st[kt][8 * s_ + 6], st[kt][8 * s_ + 7]); \
                    pf[kt][s_] = *reinterpret_cast<bf16x8*>(&w); } } while (0)
            const unsigned char* vb = buf + KB + vtr;
#define AT_LOADV(dst, q_) do { _Pragma("unroll") for (int d_ = 0; d_ < 4; ++d_) { \
                dst[2 * d_]     = __builtin_amdgcn_ds_read_tr16_b64_v4i16((LAS s16x4*)(vb + (16 * (q_)) * VS + d_ * 64)); \
                dst[2 * d_ + 1] = __builtin_amdgcn_ds_read_tr16_b64_v4i16((LAS s16x4*)(vb + (16 * (q_) + 8) * VS + d_ * 64)); } } while (0)
#define AT_PV(src, q_) do { _Pragma("unroll") for (int d_ = 0; d_ < 4; ++d_) { \
                const bf16x8 vf_ = __builtin_shufflevector(src[2 * d_], src[2 * d_ + 1], 0, 1, 2, 3, 4, 5, 6, 7); \
                O[d_] = __builtin_amdgcn_mfma_f32_32x32x16_bf16(vf_, pf[(q_) >> 1][(q_) & 1], O[d_], 0, 0, 0); } } while (0)
            s16x4 va[8], vc[8];
            AT_LOADV(va, 0); AT_LOADV(vc, 1);
            AT_EXP(0);
            __builtin_amdgcn_sched_barrier(0);
            __builtin_amdgcn_s_waitcnt(0xC07F);
            AT_PV(va, 0); AT_PV(vc, 1);
            AT_EXP(1);
#pragma unroll
            for (int i_ = 0; i_ < 8; ++i_) { __builtin_amdgcn_sched_group_barrier(0x008, 1, 0); __builtin_amdgcn_sched_group_barrier(0x002, 7, 0); }
            __builtin_amdgcn_sched_barrier(0);
            lsum += ps;
            AT_LOADV(va, 2); AT_LOADV(vc, 3); __builtin_amdgcn_sched_barrier(0);
            AT_PV(va, 2);    __builtin_amdgcn_sched_barrier(0);
            AT_PV(vc, 3);    __builtin_amdgcn_sched_barrier(0);
#undef AT_EXP
#undef AT_LOADV
#undef AT_PV
        }
        __syncthreads();
    }
    lsum_out = lsum + __shfl_xor(lsum, 32, 64);
#undef AT_GLOAD
#undef AT_LSTORE
}
constexpr int LDS_LUT_A = 2 * (64 * (64 * 2 + 16) + 64 * VS);

__device__ void attnA_unit(const Params& p, int unit, unsigned char* smem) {
    const int qblk = 15 - unit / 48, rem = unit % 48, bh = rem >> 1, map = rem & 1, b = bh / 6, h = bh % 6;
    const int tid = opaque_tid(), wid = tid >> 6, lane = tid & 63, l31 = lane & 31, hi = lane >> 5;
    const bf16_t* proj = (const bf16_t*)(p.ws + WS_PROJ);
    const size_t rowb = (size_t)b * SEQ;
    const int q0 = qblk * 256;
    float* lut = (float*)(smem + LDS_LUT_A);
    __syncthreads();
    if (tid < 128) lut[tid] = ((const float*)(p.ws + WS_LUT))[h * 128 + tid];
    f32x16 O[4]; float lsum;
    attn_pass<64, true>(proj + (rowb + q0) * NPROJ + OFF_QA + h * 128 + map * 64, NPROJ, proj + rowb * NPROJ + OFF_KA + h * 128 + map * 64, NPROJ,
                        proj + rowb * NPROJ + OFF_VA + h * 128, NPROJ, q0, 4 * (qblk + 1), 0.125f * LOG2E, lut, O, lsum, smem);
    const float inv = 1.0f / lsum;
    bf16_t* orow = map == 0 ? (bf16_t*)(p.ws + WS_MIX) + (rowb + q0 + wid * 32 + l31) * NMIX + h * 128
                            : (bf16_t*)p.out + (rowb + q0 + wid * 32 + l31) * 768 + h * 128;
#pragma unroll
    for (int d = 0; d < 4; ++d)
#pragma unroll
        for (int gp = 0; gp < 2; ++gp) {
            const int ga = 2 * gp, gb = 2 * gp + 1;
            unsigned ax = cvt_pk_bf16(O[d][4 * ga] * inv, O[d][4 * ga + 1] * inv), ay = cvt_pk_bf16(O[d][4 * ga + 2] * inv, O[d][4 * ga + 3] * inv);
            unsigned bx = cvt_pk_bf16(O[d][4 * gb] * inv, O[d][4 * gb + 1] * inv), by = cvt_pk_bf16(O[d][4 * gb + 2] * inv, O[d][4 * gb + 3] * inv);
            const auto sx = __builtin_amdgcn_permlane32_swap(ax, bx, false, false);
            const auto sy = __builtin_amdgcn_permlane32_swap(ay, by, false, false);
            ax = sx[0]; bx = sx[1]; ay = sy[0]; by = sy[1];
            u32x4 w;
            if (hi == 0) { w.x = ax; w.y = ay; w.z = bx; w.w = by; }
            else         { w.x = ax; w.y = ay; w.z = bx; w.w = by; }
            *(u32x4*)(orow + 32 * d + 8 * (hi == 0 ? ga : gb)) = w;
        }
}
__device__ void attnA_combine(const Params& p, int l, int unit) {
    const int tid = opaque_tid(), sub = tid & 15, grp = tid >> 4;
    const float lam = ((const float*)(p.ws + WS_LAM))[l];
    const float lam_init = 0.8f - 0.6f * expf(-0.3f * (float)l);
    const float* sg = p.in[8] + (size_t)l * 128 + sub * 8;
    const f32x4 g0 = *(const f32x4*)sg, g1 = *(const f32x4*)(sg + 4);
    bf16_t* mix = (bf16_t*)(p.ws + WS_MIX); const bf16_t* oa1 = (const bf16_t*)p.out;
    constexpr int NPAIR = 64 * 6;
    u32x4 na, nc;
    { const size_t row = (size_t)unit * 64 + grp / 6; const int h = grp % 6; na = *(const u32x4*)(mix + row * NMIX + h * 128 + sub * 8); nc = *(const u32x4*)(oa1 + row * 768 + h * 128 + sub * 8); }
    for (int pr = grp; pr < NPAIR; pr += 32) {
        const size_t row = (size_t)unit * 64 + pr / 6; const int h = pr % 6;
        bf16_t* mp = mix + row * NMIX + h * 128 + sub * 8;
        const u32x4 a = na, c = nc;
        if (pr + 32 < NPAIR) { const size_t row2 = (size_t)unit * 64 + (pr + 32) / 6; const int h2 = (pr + 32) % 6;
            na = *(const u32x4*)(mix + row2 * NMIX + h2 * 128 + sub * 8); nc = *(const u32x4*)(oa1 + row2 * 768 + h2 * 128 + sub * 8); }
        float o[8] = {bflo(a.x) - lam * bflo(c.x), bfhi(a.x) - lam * bfhi(c.x), bflo(a.y) - lam * bflo(c.y), bfhi(a.y) - lam * bfhi(c.y),
                      bflo(a.z) - lam * bflo(c.z), bfhi(a.z) - lam * bfhi(c.z), bflo(a.w) - lam * bflo(c.w), bfhi(a.w) - lam * bfhi(c.w)};
        float ss = 0.f;
#pragma unroll
        for (int i = 0; i < 8; ++i) ss += o[i] * o[i];
        ss += __shfl_xor(ss, 1, 64); ss += __shfl_xor(ss, 2, 64); ss += __shfl_xor(ss, 4, 64); ss += __shfl_xor(ss, 8, 64);
        const float rn = rsqrtf(ss * (1.0f / 128.0f) + EPS) * (1.0f - lam_init);
        u32x4 w; w.x = cvt_pk_bf16(o[0] * rn * g0[0], o[1] * rn * g0[1]); w.y = cvt_pk_bf16(o[2] * rn * g0[2], o[3] * rn * g0[3]);
        w.z = cvt_pk_bf16(o[4] * rn * g1[0], o[5] * rn * g1[1]); w.w = cvt_pk_bf16(o[6] * rn * g1[2], o[7] * rn * g1[3]);
        *(u32x4*)mp = w;
    }
}

__device__ void attnX_unit(const Params& p, int unit, unsigned char* smem) {
    const int qblk = unit & 15, bh = unit >> 4, b = bh >> 2, h = bh & 3;
    const int tid = opaque_tid(), wid = tid >> 6, lane = tid & 63, l31 = lane & 31, hi = lane >> 5;
    const bf16_t* xq = (const bf16_t*)(p.ws + WS_XQ);
    const bf16_t* kvx = (const bf16_t*)(p.ws + WS_KVX);
    const size_t row0 = (size_t)b * SEQ + qblk * 256;
    f32x16 O[4]; float lsum;
    attn_pass<128, false>(xq + row0 * 512 + h * 128, 512, kvx + (size_t)b * MEMLEN * 1024 + h * 128, 1024, kvx + (size_t)b * MEMLEN * 1024 + 512 + h * 128, 1024,
                          0, 4, 0.08838834764831845f * LOG2E, nullptr, O, lsum, smem);
    const float inv = 1.0f / lsum;
    bf16_t* orow = (bf16_t*)(p.ws + WS_XO) + (row0 + wid * 32 + l31) * 512 + h * 128;
#pragma unroll
    for (int d = 0; d < 4; ++d)
#pragma unroll
        for (int gp = 0; gp < 2; ++gp) {
            const int ga = 2 * gp, gb = 2 * gp + 1;
            unsigned ax = cvt_pk_bf16(O[d][4 * ga] * inv, O[d][4 * ga + 1] * inv), ay = cvt_pk_bf16(O[d][4 * ga + 2] * inv, O[d][4 * ga + 3] * inv);
            unsigned bx = cvt_pk_bf16(O[d][4 * gb] * inv, O[d][4 * gb + 1] * inv), by = cvt_pk_bf16(O[d][4 * gb + 2] * inv, O[d][4 * gb + 3] * inv);
            const auto sx = __builtin_amdgcn_permlane32_swap(ax, bx, false, false);
            const auto sy = __builtin_amdgcn_permlane32_swap(ay, by, false, false);
            ax = sx[0]; bx = sx[1]; ay = sy[0]; by = sy[1];
            u32x4 w;
            if (hi == 0) { w.x = ax; w.y = ay; w.z = bx; w.w = by; }
            else         { w.x = ax; w.y = ay; w.z = bx; w.w = by; }
            *(u32x4*)(orow + 32 * d + 8 * (hi == 0 ? ga : gb)) = w;
        }
}
}

namespace ix {
constexpr int RS = 8208;
constexpr int LDS_STAGE = 16 * RS;
constexpr int LDS_HIST = LDS_STAGE + 8 * 512;
constexpr int HS = 257;
constexpr int LDS_DUMMY = LDS_HIST + 16 * HS * 4;
static_assert(LDS_DUMMY + 8 * 256 <= LDS_CTL, "indexer LDS");
__device__ __forceinline__ unsigned wave_sum_u(unsigned v) { return (unsigned)__builtin_amdgcn_readlane(wave_iscan_i((int)v), 63); }
__device__ __forceinline__ unsigned wave_excl_scan(unsigned v, int lane) { return (unsigned)wave_iscan_i((int)v) - v; }
__device__ void indexer_unit(const Params& p, int b, int qt, unsigned char* smem) {
    const int tid = opaque_tid(), wid = tid >> 6, lane = tid & 63, fr = lane & 15, fq = lane >> 4;
    const int q0 = qt * 16;
    const size_t rowb = (size_t)b * SEQ;
    unsigned short* idxg = (unsigned short*)(p.ws + WS_IDX);
    __syncthreads();
    if (qt < 16) {
        for (int e = tid; e < 16 * 128; e += NTHREADS) { const int r = e >> 7, c = (e & 127) * 2; *(unsigned*)(idxg + (rowb + q0 + r) * TOPK + c) = (unsigned)c | ((unsigned)(c + 1) << 16); }
        return;
    }
    const bf16_t* proj = (const bf16_t*)(p.ws + WS_PROJ);
    const bf16_t* qb = (const bf16_t*)(p.ws + WS_QB);
    const int nkt = qt + 1;
    unsigned* hist = (unsigned*)(smem + LDS_HIST);
    {
        bf16x8 qf[16][2];
        const bf16_t* qrow = qb + (rowb + q0 + fr) * NQB + 1536 + fq * 8;
#pragma unroll
        for (int g = 0; g < 16; ++g)
#pragma unroll
            for (int ks = 0; ks < 2; ++ks) qf[g][ks] = *(const bf16x8*)(qrow + g * 64 + ks * 32);
        unsigned wp[8];
        {
            const u32x4 a = *(const u32x4*)(proj + (rowb + q0 + fr) * NPROJ + OFF_WIDX), c = *(const u32x4*)(proj + (rowb + q0 + fr) * NPROJ + OFF_WIDX + 8);
            wp[0] = a.x; wp[1] = a.y; wp[2] = a.z; wp[3] = a.w; wp[4] = c.x; wp[5] = c.y; wp[6] = c.z; wp[7] = c.w;
        }
        const bf16_t* kbase = proj + (rowb + fr) * NPROJ + OFF_KIDX + fq * 8;
        bf16x8 af0, af1, ag0, ag1;
        if (wid < nkt) { af0 = *(const bf16x8*)(kbase + (size_t)wid * 16 * NPROJ); af1 = *(const bf16x8*)(kbase + (size_t)wid * 16 * NPROJ + 32); }
        if (wid + 8 < nkt) { ag0 = *(const bf16x8*)(kbase + (size_t)(wid + 8) * 16 * NPROJ); ag1 = *(const bf16x8*)(kbase + (size_t)(wid + 8) * 16 * NPROJ + 32); }
#if IX_HIST & 1
        for (int e = tid; e < 16 * HS; e += NTHREADS) hist[e] = 0u;
        asm volatile("s_waitcnt lgkmcnt(0)" ::: "memory");
        __builtin_amdgcn_s_barrier();
#endif
        bf16x8 qc[2];
#pragma unroll
        for (int ks = 0; ks < 2; ++ks) {
            float a8[8] = {0.f, 0.f, 0.f, 0.f, 0.f, 0.f, 0.f, 0.f};
#pragma unroll
            for (int g = 0; g < 16; ++g) {
                const float wg = (g & 1) ? bfhi(wp[g >> 1]) : bflo(wp[g >> 1]);
                const u32x4 qv = *reinterpret_cast<const u32x4*>(&qf[g][ks]);
                a8[0] = fmaf(wg, bflo(qv.x), a8[0]); a8[1] = fmaf(wg, bfhi(qv.x), a8[1]); a8[2] = fmaf(wg, bflo(qv.y), a8[2]); a8[3] = fmaf(wg, bfhi(qv.y), a8[3]);
                a8[4] = fmaf(wg, bflo(qv.z), a8[4]); a8[5] = fmaf(wg, bfhi(qv.z), a8[5]); a8[6] = fmaf(wg, bflo(qv.w), a8[6]); a8[7] = fmaf(wg, bfhi(qv.w), a8[7]);
            }
            u32x4 o4; o4.x = cvt_pk_bf16(a8[0], a8[1]); o4.y = cvt_pk_bf16(a8[2], a8[3]); o4.z = cvt_pk_bf16(a8[4], a8[5]); o4.w = cvt_pk_bf16(a8[6], a8[7]);
            qc[ks] = *reinterpret_cast<bf16x8*>(&o4);
        }
        {
        for (int kt = wid; kt < nkt; kt += 8) {
            const bf16x8 a0 = af0, a1 = af1;
            af0 = ag0; af1 = ag1;
            if (kt + 16 < nkt) { ag0 = *(const bf16x8*)(kbase + (size_t)(kt + 16) * 16 * NPROJ); ag1 = *(const bf16x8*)(kbase + (size_t)(kt + 16) * 16 * NPROJ + 32); }
            f32x4 sc = {0.f, 0.f, 0.f, 0.f};
            sc = __builtin_amdgcn_mfma_f32_16x16x32_bf16(a0, qc[0], sc, 0, 0, 0);
            sc = __builtin_amdgcn_mfma_f32_16x16x32_bf16(a1, qc[1], sc, 0, 0, 0);
            f32x4 dc = {0.f, 0.f, 0.f, 0.f};
            dc = __builtin_amdgcn_mfma_f32_16x16x32_bf16(a0, qf[0][0], dc, 0, 0, 0);
            dc = __builtin_amdgcn_mfma_f32_16x16x32_bf16(a1, qf[0][1], dc, 0, 0, 0);
            __builtin_amdgcn_sched_barrier(0);
#pragma unroll
            for (int g = 0; g < 16; ++g) {
                f32x4 dn = {0.f, 0.f, 0.f, 0.f};
                if (g < 15) {
                    dn = __builtin_amdgcn_mfma_f32_16x16x32_bf16(a0, qf[g + 1][0], dn, 0, 0, 0);
                    dn = __builtin_amdgcn_mfma_f32_16x16x32_bf16(a1, qf[g + 1][1], dn, 0, 0, 0);
                }
                __builtin_amdgcn_sched_barrier(0);
                const float wg = (g & 1) ? bfhi(wp[g >> 1]) : bflo(wp[g >> 1]);
                if (g < 15) {
                    asm volatile("v_fma_f32 %0, %4, |%5|, %0\n\tv_fma_f32 %1, %4, |%6|, %1\n\tv_fma_f32 %2, %4, |%7|, %2\n\tv_fma_f32 %3, %4, |%8|, %3"
                                 : "+v"(sc[0]), "+v"(sc[1]), "+v"(sc[2]), "+v"(sc[3]) : "v"(wg), "v"(dc[0]), "v"(dc[1]), "v"(dc[2]), "v"(dc[3]));
                } else {
                    asm volatile("s_nop 7\n\ts_nop 7\n\tv_fma_f32 %0, %4, |%5|, %0\n\tv_fma_f32 %1, %4, |%6|, %1\n\tv_fma_f32 %2, %4, |%7|, %2\n\tv_fma_f32 %3, %4, |%8|, %3"
                                 : "+v"(sc[0]), "+v"(sc[1]), "+v"(sc[2]), "+v"(sc[3]) : "v"(wg), "v"(dc[0]), "v"(dc[1]), "v"(dc[2]), "v"(dc[3]));
                }
                __builtin_amdgcn_sched_barrier(0);
                dc = dn;
            }
            if (kt == qt) {
#pragma unroll
                for (int r = 0; r < 4; ++r) if (4 * fq + r > fr) sc[r] = -__builtin_inff();
            }
            unsigned x0 = __builtin_bit_cast(unsigned, __builtin_amdgcn_cvt_pkrtz(sc[0], sc[1]));
            unsigned x1 = __builtin_bit_cast(unsigned, __builtin_amdgcn_cvt_pkrtz(sc[2], sc[3]));
            x0 ^= (((x0 >> 15) & 0x00010001u) * 0xFFFFu) | 0x80008000u; x1 ^= (((x1 >> 15) & 0x00010001u) * 0xFFFFu) | 0x80008000u;
            u32x2 o; o.x = (x0 >> 1) & 0x7FFF7FFFu; o.y = (x1 >> 1) & 0x7FFF7FFFu;
            *(u32x2*)(smem + fr * RS + (kt * 16 + 4 * fq) * 2) = o;
#if IX_HIST & 2
            {
                unsigned* hq = hist + fr * HS;
                unsigned one;
                asm volatile("v_mov_b32 %0, 1" : "=v"(one));
                __hip_atomic_fetch_add(hq + ((o.x >> 7) & 0xFFu), one, __ATOMIC_RELAXED, __HIP_MEMORY_SCOPE_WORKGROUP);
                __hip_atomic_fetch_add(hq + (o.x >> 23), one, __ATOMIC_RELAXED, __HIP_MEMORY_SCOPE_WORKGROUP);
                __hip_atomic_fetch_add(hq + ((o.y >> 7) & 0xFFu), one, __ATOMIC_RELAXED, __HIP_MEMORY_SCOPE_WORKGROUP);
                __hip_atomic_fetch_add(hq + (o.y >> 23), one, __ATOMIC_RELAXED, __HIP_MEMORY_SCOPE_WORKGROUP);
            }
#endif
        }
        }
    }
    __syncthreads();
    unsigned short* stage = (unsigned short*)(smem + LDS_STAGE + wid * 512);
    for (int rr = 0; rr < (PROBE_SUB == 2 ? 4 : 2); ++rr) {
        const int qi = wid * 2 + (rr & 1);
        const unsigned char* rowp = smem + qi * RS;
        const int nch = nkt * 4;
        const int nsl = __builtin_amdgcn_readfirstlane((nch + 63) >> 6);
        unsigned kreg[32];
#pragma unroll
        for (int i = 0; i < 16; ++i) {
            const int c = lane + 64 * i;
            const u32x2 v = *(const u32x2*)(rowp + c * 8);
            const bool ok = c < nch;
            kreg[2 * i] = ok ? v.x : 0u; kreg[2 * i + 1] = ok ? v.y : 0u;
        }
        unsigned T;
        {
            const unsigned* hp = hist + qi * HS + lane * 4;
            u32x4 hv; hv.x = hp[0]; hv.y = hp[1]; hv.z = hp[2]; hv.w = hp[3];
            const unsigned s4 = (hv.x + hv.y) + (hv.z + hv.w);
            const unsigned pin = (unsigned)wave_iscan_i((int)s4);
            const unsigned tot = (unsigned)__builtin_amdgcn_readlane((int)pin, 63);
            const unsigned above = tot - pin;
            const unsigned long long mk = __builtin_amdgcn_ballot_w64(above + s4 >= (unsigned)TOPK);
            const int L = 63 - __builtin_clzll(mk);
            const unsigned a3 = above + hv.w, a2 = a3 + hv.z, a1 = a2 + hv.y;
            const unsigned bo = a3 >= (unsigned)TOPK ? 3u : (a2 >= (unsigned)TOPK ? 2u : (a1 >= (unsigned)TOPK ? 1u : 0u));
            T = ((unsigned)(4 * L) + (unsigned)__builtin_amdgcn_readlane((int)bo, L)) << 7;
#if IX_CHECK & 1
            if (tot != (unsigned)(16 * nkt)) *(unsigned short*)(p.ws + WS_H16) = 0x7FC0;
#endif
        }
        const int ngr = nsl > 12 ? 16 : (nsl > 8 ? 12 : 8);
        const int ntot = ngr * 256;
#define IX_G4(B, g) { B(4 * (g)) B(4 * (g) + 1) B(4 * (g) + 2) B(4 * (g) + 3) }
#define IX_SW(B) { IX_G4(B, 0) IX_G4(B, 1) if (nsl > 8) { asm volatile(""); IX_G4(B, 2) if (nsl > 12) { asm volatile(""); IX_G4(B, 3) } } }
#define IX_SAD(i) { f0 = __builtin_amdgcn_sad_u16(kreg[2 * (i)], c0, f0); f1 = __builtin_amdgcn_sad_u16(kreg[2 * (i)], c1, f1); \
                    f0 = __builtin_amdgcn_sad_u16(kreg[2 * (i) + 1], c0, f0); f1 = __builtin_amdgcn_sad_u16(kreg[2 * (i) + 1], c1, f1); }
#pragma unroll 1
        for (int bit = 6; bit >= 0; --bit) {
            const unsigned cand = T | (1u << bit);
            const unsigned c1 = cand * 0x10001u, c0 = (cand - 1u) * 0x10001u;
            unsigned f0 = 0, f1 = 0;
            IX_SW(IX_SAD)
            const int dsum = __builtin_amdgcn_readlane(wave_iscan_i((int)f0 - (int)f1), 63);
            if (ntot + dsum >= 2 * TOPK) T = cand;
        }
        unsigned cg, ce;
        {
            const unsigned c0 = (T - 1u) * 0x10001u, c1 = T * 0x10001u, c2 = (T + 1u) * 0x10001u;
            unsigned f0 = 0, f1 = 0, f2 = 0;
#define IX_SAD3(i) { f0 = __builtin_amdgcn_sad_u16(kreg[2 * (i)], c0, f0); f1 = __builtin_amdgcn_sad_u16(kreg[2 * (i)], c1, f1); f2 = __builtin_amdgcn_sad_u16(kreg[2 * (i)], c2, f2); \
                     f0 = __builtin_amdgcn_sad_u16(kreg[2 * (i) + 1], c0, f0); f1 = __builtin_amdgcn_sad_u16(kreg[2 * (i) + 1], c1, f1); f2 = __builtin_amdgcn_sad_u16(kreg[2 * (i) + 1], c2, f2); }
            IX_SW(IX_SAD3)
            cg = (unsigned)(ngr * 4 + (int)f1 - (int)f2) >> 1;
            ce = ((unsigned)(ngr * 4 + (int)f0 - (int)f1) >> 1) - cg;
        }
        const unsigned cgt = wave_sum_u(cg);
        unsigned pg = wave_excl_scan(cg, lane);
        unsigned pe = wave_excl_scan(ce, lane);
        const unsigned need = (unsigned)TOPK - cgt;
        const unsigned didx = (unsigned)((LDS_DUMMY + wid * 256) - (LDS_STAGE + wid * 512)) / 2u + 2u * (unsigned)lane;
#define IX_PUT(i) { _Pragma("unroll") for (int e = 0; e < 4; ++e) { \
                    const unsigned w2 = kreg[2 * (i) + (e >> 1)]; const unsigned k15 = (e & 1) ? (w2 >> 16) : (w2 & 0xFFFFu); \
                    const bool gt = k15 > T, eq = k15 == T; \
                    const unsigned te = eq ? pe : ~0u; \
                    const unsigned ix = gt ? pg : (te < need ? cgt + pe : didx); \
                    stage[ix] = (unsigned short)(lane * 4 + (i) * 256 + e); \
                    pg += gt ? 1u : 0u; pe += eq ? 1u : 0u; } }
        IX_SW(IX_PUT)
#undef IX_SAD3
#undef IX_PUT
#undef IX_SW
#undef IX_G4
#undef IX_SAD
        asm volatile("s_waitcnt lgkmcnt(0)" ::: "memory");
        const u32x2 o = *(const u32x2*)(stage + lane * 4);
        *(u32x2*)(idxg + (rowb + q0 + qi) * TOPK + lane * 4) = o;
        asm volatile("s_waitcnt lgkmcnt(0)" ::: "memory");
    }
}
}

namespace bt {
constexpr int BUF_BYTES = 32 * 256;
constexpr int WAVE_BYTES = 2 * BUF_BYTES;
constexpr int LDS_IST = 8 * WAVE_BYTES;
constexpr int LDS_LUT = LDS_IST + 8 * 512;
typedef int v2i __attribute__((ext_vector_type(2)));
__device__ __forceinline__ int swz(int k) { return (k & 15) ^ (8 * (k >> 4)); }
__device__ void battn_rows(const Params& p, unsigned char* smem) {
    const int tid = opaque_tid(), wid = tid >> 6, lane = tid & 63, hh = lane & 15, kg = lane >> 4;
    const bool hv = hh < 6;
    const bf16_t* qb = (const bf16_t*)(p.ws + WS_QB);
    const unsigned char* ckv8 = p.ws + WS_CKVN;
    const unsigned short* idxg = (const unsigned short*)(p.ws + WS_IDX);
    bf16_t* mix = (bf16_t*)(p.ws + WS_MIX);
    unsigned char* cs = smem + wid * WAVE_BYTES;
    const unsigned csa = (unsigned)__builtin_amdgcn_readfirstlane((int)(unsigned)(size_t)(LAS unsigned char*)cs);
    unsigned short* ist = (unsigned short*)(smem + LDS_IST + wid * 512);
    float* lut = (float*)(smem + LDS_LUT);
    __syncthreads();
    for (int e = tid; e < 6 * 128; e += NTHREADS) lut[e] = ((const float*)(p.ws + WS_LUT))[6 * 128 + e];
    __syncthreads();
    const float* lrow = lut + (hv ? hh : 0) * 128;
    const int qk0 = hh * 256 + 8 * (kg & 1), qk1 = (16 + hh) * 256 + 8 * (kg & 1), qs0 = swz(hh), qs1 = swz(16 + hh), qc = kg >> 1;
    const int tq = hh >> 1, tkey = tq < 4 ? 4 * kg + tq : 16 + 4 * kg + (tq - 4), tr0 = tkey * 256 + 8 * (hh & 1), ts = swz(tkey);
    const int dsub = lane >> 4, dpos = lane & 15;
    unsigned lp[8];
#pragma unroll
    for (int i = 0; i < 8; ++i) lp[i] = (unsigned)((dpos ^ swz(4 * i + dsub)) * 16);
    const unsigned ista = (unsigned)(size_t)(LAS unsigned short*)ist;
    const unsigned idma = ista + 2u * (unsigned)dsub, ibia = ista + 8u * (unsigned)kg;
    unsigned aq0[8], aq1[8], av[16];
#pragma unroll
    for (int ks = 0; ks < 8; ++ks) { aq0[ks] = csa + (unsigned)(qk0 + (((2 * ks + qc) ^ qs0) << 4)); aq1[ks] = csa + (unsigned)(qk1 + (((2 * ks + qc) ^ qs1) << 4)); }
#pragma unroll
    for (int d = 0; d < 16; ++d) av[d] = csa + (unsigned)(tr0 + ((d ^ ts) << 4));
    u32x2 nidx = {0u, 0u}; u32x4 nq[8];
#define BT_ROWREQ(r_) do { nidx = *(const u32x2*)(idxg + (size_t)(r_) * TOPK + lane * 4); \
        _Pragma("unroll") for (int ks = 0; ks < 8; ++ks) { nq[ks] = (u32x4){0u, 0u, 0u, 0u}; if (hv) nq[ks] = *(const u32x4*)(qb + (size_t)(r_) * NQB + hh * 256 + ks * 32 + kg * 8); } } while (0)
    if ((int)(blockIdx.x * 8 + wid) < MTOK) BT_ROWREQ(blockIdx.x * 8 + wid);
    for (int row = blockIdx.x * 8 + wid; row < MTOK; row += gridDim.x * 8) {
        const int t = row & (SEQ - 1);
        const size_t rowb = (size_t)(row - t);
        const int nvalid = __builtin_amdgcn_readfirstlane(t + 1 < TOPK ? t + 1 : TOPK);
        const int nchunks = __builtin_amdgcn_readfirstlane((nvalid + 31) >> 5);
        *(u32x2*)(ist + lane * 4) = nidx;
        long qlf[8];
#pragma unroll
        for (int ks = 0; ks < 8; ++ks) {
            const u32x4 qv = nq[ks];
            int lo = __builtin_amdgcn_cvt_pk_fp8_f32(bflo(qv.x) * 16.f, bfhi(qv.x) * 16.f, 0, false); lo = __builtin_amdgcn_cvt_pk_fp8_f32(bflo(qv.y) * 16.f, bfhi(qv.y) * 16.f, lo, true);
            int hi2 = __builtin_amdgcn_cvt_pk_fp8_f32(bflo(qv.z) * 16.f, bfhi(qv.z) * 16.f, 0, false); hi2 = __builtin_amdgcn_cvt_pk_fp8_f32(bflo(qv.w) * 16.f, bfhi(qv.w) * 16.f, hi2, true);
            qlf[ks] = (long)(((unsigned long long)(unsigned)hi2 << 32) | (unsigned)lo);
        }
        f32x4 O[16];
#pragma unroll
        for (int d = 0; d < 16; ++d) O[d] = (f32x4){0.f, 0.f, 0.f, 0.f};
        float m = -1e30f, lsum = 0.f;
        unsigned long long gb;
        {
            const unsigned long long ga = (unsigned long long)(size_t)(ckv8 + rowb * 256);
            gb = ((unsigned long long)(unsigned)__builtin_amdgcn_readfirstlane((int)(unsigned)(ga >> 32)) << 32) | (unsigned)__builtin_amdgcn_readfirstlane((int)(unsigned)ga);
        }
#define BT_DMA(c, ldsa) do { unsigned ia_ = idma + (unsigned)(c) * 64u; asm volatile("" : "+v"(ia_)); unsigned o_[8]; \
            _Pragma("unroll") for (int i_ = 0; i_ < 8; ++i_) o_[i_] = (unsigned)*(const LAS unsigned short*)(size_t)(ia_ + 8u * i_); \
            __builtin_amdgcn_s_waitcnt(0xC07F);                   \
            _Pragma("unroll") for (int i_ = 0; i_ < 8; ++i_) o_[i_] = (o_[i_] << 8) + lp[i_]; \
            unsigned sv_; \
            asm volatile("s_mov_b32 %0, m0\n\ts_mov_b32 m0, %10\n\ts_nop 0\n\tglobal_load_lds_dwordx4 %1, %9\n\t" \
                         "s_add_u32 m0, m0, 0x400\n\ts_nop 0\n\tglobal_load_lds_dwordx4 %2, %9\n\t" \
                         "s_add_u32 m0, m0, 0x400\n\ts_nop 0\n\tglobal_load_lds_dwordx4 %3, %9\n\t" \
                         "s_add_u32 m0, m0, 0x400\n\ts_nop 0\n\tglobal_load_lds_dwordx4 %4, %9\n\t" \
                         "s_add_u32 m0, m0, 0x400\n\ts_nop 0\n\tglobal_load_lds_dwordx4 %5, %9\n\t" \
                         "s_add_u32 m0, m0, 0x400\n\ts_nop 0\n\tglobal_load_lds_dwordx4 %6, %9\n\t" \
                         "s_add_u32 m0, m0, 0x400\n\ts_nop 0\n\tglobal_load_lds_dwordx4 %7, %9\n\t" \
                         "s_add_u32 m0, m0, 0x400\n\ts_nop 0\n\tglobal_load_lds_dwordx4 %8, %9\n\t" \
                         "s_mov_b32 m0, %0" \
                         : "=&s"(sv_) : "v"(o_[0]), "v"(o_[1]), "v"(o_[2]), "v"(o_[3]), "v"(o_[4]), "v"(o_[5]), "v"(o_[6]), "v"(o_[7]), "s"(gb), "s"((unsigned)(ldsa)) : "memory", "scc"); } while (0)
        asm volatile("s_waitcnt lgkmcnt(0)" ::: "memory");
        BT_DMA(0, csa);
        float bnx[8];
#define BT_BIAS(c) do { unsigned ib_ = ibia + (unsigned)(c) * 64u; asm volatile("" : "+v"(ib_)); \
            _Pragma("unroll") for (int tt_ = 0; tt_ < 2; ++tt_) { const int slot0_ = (c) * 32 + tt_ * 16 + 4 * kg; const u32x2 iv_ = *(const LAS u32x2*)(size_t)(ib_ + 32u * tt_); \
            const unsigned ids_[4] = {iv_.x & 0xFFFFu, iv_.x >> 16, iv_.y & 0xFFFFu, iv_.y >> 16}; \
            _Pragma("unroll") for (int r_ = 0; r_ < 4; ++r_) { int dd_ = t - (int)ids_[r_]; dd_ = dd_ < 0 ? 0 : (dd_ > 127 ? 127 : dd_); \
                bnx[tt_ * 4 + r_] = lrow[dd_]; } } \
            if (nvalid < TOPK) {                                      \
                _Pragma("unroll") for (int e_ = 0; e_ < 8; ++e_) bnx[e_] = ((c) * 32 + (e_ >> 2) * 16 + 4 * kg + (e_ & 3) < nvalid) ? bnx[e_] : -__builtin_inff(); } } while (0)
        BT_BIAS(0);
#define BT_CHUNK(c, B) { \
            if ((c) + 1 < nchunks) { BT_DMA((c) + 1, csa + (1 - (B)) * BUF_BYTES); asm volatile("s_waitcnt vmcnt(8)" ::: "memory"); } \
            else asm volatile("s_waitcnt vmcnt(0)" ::: "memory"); \
            long af[16]; v2i vf[16]; \
            _Pragma("unroll") for (int ks = 0; ks < 8; ++ks) { \
                af[ks]     = *(const LAS long*)(size_t)(aq0[ks] + (B) * BUF_BYTES); \
                af[8 + ks] = *(const LAS long*)(size_t)(aq1[ks] + (B) * BUF_BYTES); } \
            __builtin_amdgcn_sched_barrier(0); \
            __builtin_amdgcn_s_waitcnt(0xC07F); \
            f32x4 s0 = {0.f, 0.f, 0.f, 0.f}, s1 = {0.f, 0.f, 0.f, 0.f}; \
            _Pragma("unroll") for (int ks = 0; ks < 8; ++ks) { \
                s0 = __builtin_amdgcn_mfma_f32_16x16x32_fp8_fp8(af[ks], qlf[ks], s0, 0, 0, 0);                \
                s1 = __builtin_amdgcn_mfma_f32_16x16x32_fp8_fp8(af[8 + ks], qlf[ks], s1, 0, 0, 0); } \
            _Pragma("unroll") for (int d = 0; d < 16; ++d) vf[d] = __builtin_amdgcn_ds_read_tr8_b64_v2i32((LAS v2i*)(size_t)(av[d] + (B) * BUF_BYTES));       \
            __builtin_amdgcn_sched_barrier(0); \
            float z[8]; \
            _Pragma("unroll") for (int r = 0; r < 4; ++r) { z[r] = fmaf(s0[r], LOG2E * (1.0f / 16.0f), bnx[r]); z[4 + r] = fmaf(s1[r], LOG2E * (1.0f / 16.0f), bnx[4 + r]); }       \
            BT_BIAS((c) + 1); \
            float pmax = fmaxf(fmaxf(fmaxf(z[0], z[1]), fmaxf(z[2], z[3])), fmaxf(fmaxf(z[4], z[5]), fmaxf(z[6], z[7]))); \
            if (!__all(pmax - m <= 8.0f)) {                             \
                pmax = fmaxf(pmax, __shfl_xor(pmax, 16, 64)); \
                pmax = fmaxf(pmax, __shfl_xor(pmax, 32, 64)); \
                const float mn = fmaxf(m, pmax); \
                const float alpha = fast_exp2(m - mn); \
                m = mn; lsum *= alpha; \
                _Pragma("unroll") for (int d = 0; d < 16; ++d) O[d] = O[d] * alpha; \
            } \
            _Pragma("unroll") for (int r = 0; r < 8; ++r) { z[r] = fast_exp2(z[r] - m); lsum += z[r]; } \
            int plo = __builtin_amdgcn_cvt_pk_fp8_f32(z[0], z[1], 0, false); plo = __builtin_amdgcn_cvt_pk_fp8_f32(z[2], z[3], plo, true); \
            int phi = __builtin_amdgcn_cvt_pk_fp8_f32(z[4], z[5], 0, false); phi = __builtin_amdgcn_cvt_pk_fp8_f32(z[6], z[7], phi, true); \
            const long pf = (long)(((unsigned long long)(unsigned)phi << 32) | (unsigned)plo); \
            __builtin_amdgcn_s_waitcnt(0xC07F); \
            _Pragma("unroll") for (int d = 0; d < 16; ++d) { \
                O[d] = __builtin_amdgcn_mfma_f32_16x16x32_fp8_fp8(__builtin_bit_cast(long, vf[d]), pf, O[d], 0, 0, 0);                     \
            } }
#pragma unroll 1
        for (int c = 0; c < nchunks; c += 2) {
            BT_CHUNK(c, 0)
            if (c + 1 < nchunks) BT_CHUNK(c + 1, 1)
        }
#undef BT_CHUNK
#undef BT_BIAS
#undef BT_DMA
        if (row + (int)gridDim.x * 8 < MTOK) BT_ROWREQ(row + (int)gridDim.x * 8);
        lsum += __shfl_xor(lsum, 16, 64);
        lsum += __shfl_xor(lsum, 32, 64);
        const float inv = 1.0f / lsum;
        if (hv) {
            bf16_t* orow = (bf16_t*)(p.ws + WS_OLAT) + ((size_t)hh * MTOK + row) * 256 + 4 * kg;
#pragma unroll
            for (int d = 0; d < 16; ++d) {
                u32x2 w; w.x = cvt_pk_bf16(O[d][0] * inv, O[d][1] * inv); w.y = cvt_pk_bf16(O[d][2] * inv, O[d][3] * inv);
                *(u32x2*)(orow + d * 16) = w;
            }
        }
    }
}
}


#define XB_TMO      128
#define XB_XCNT(j)  (256  + 64 * (j))
#define XB_XSUB(j)  (1280 + 64 * (j))
#define XB_XGEN(j)  (2304 + 64 * (j))
#define XB_TOP      3328
#define XB_TOPGEN   3392
#define XCD_BAR_WORDS 3456
#define XB_SPIN_CAP (1u << 18)

__device__ __forceinline__ unsigned xb_ld(unsigned* p)              { return __hip_atomic_load(p, __ATOMIC_RELAXED, __HIP_MEMORY_SCOPE_AGENT); }
__device__ __forceinline__ unsigned xb_add(unsigned* p, unsigned v) { return __hip_atomic_fetch_add(p, v, __ATOMIC_RELAXED, __HIP_MEMORY_SCOPE_AGENT); }
__device__ __forceinline__ unsigned xb_xcc_id() { return (unsigned)__builtin_amdgcn_s_getreg((3 << 11) | 20) & 0xFu; }
#define XB_SPIN(cond, bar) do { unsigned _sp = 0; while (cond) { __builtin_amdgcn_s_sleep(1); \
    if ((++_sp & 255u) == 0u) { if (xb_ld(&(bar)[XB_TMO])) break; if (_sp > XB_SPIN_CAP) { atomicAdd(&(bar)[XB_TMO], 1u); break; } } } } while (0)

struct XcdBarrier {
    unsigned* bar; unsigned x;
    volatile LAS unsigned* st;
};

__device__ __forceinline__ XcdBarrier xcd_barrier_post(unsigned* bar, volatile LAS unsigned* st) {
    XcdBarrier b; b.bar = bar; b.x = xb_xcc_id(); b.st = st;
    if (threadIdx.x == 0) (void)xb_add(&bar[XB_XCNT(b.x)], 1u);
    return b;
}
__device__ __forceinline__ void xcd_barrier_complete(unsigned* bar, unsigned x, unsigned& nloc, unsigned& nx) {
    const unsigned G = gridDim.x * gridDim.y * gridDim.z;
    unsigned sum, cnt, mine, sp = 0u;
    for (;;) {
        sum = 0u; cnt = 0u; mine = 0u;
#pragma unroll
        for (unsigned j = 0; j < 16; ++j) { const unsigned c = xb_ld(&bar[XB_XCNT(j)]); sum += c; cnt += (c > 0u) ? 1u : 0u; mine = (j == x) ? c : mine; }
        if (sum == G) break;
        __builtin_amdgcn_s_sleep(1);
        if ((++sp & 255u) == 0u) { if (xb_ld(&bar[XB_TMO])) break; if (sp > XB_SPIN_CAP) { atomicAdd(&bar[XB_TMO], 1u); break; } }
    }
    nloc = mine > 0u ? mine : 1u; nx = cnt > 0u ? cnt : 1u;
}

__device__ __forceinline__ void xcd_barrier(const XcdBarrier& b) {
    asm volatile("s_waitcnt vmcnt(0)" ::: "memory");
    __syncthreads();
    if (threadIdx.x == 0) {
        unsigned* bar = b.bar;
        __builtin_amdgcn_s_waitcnt(0);
        unsigned nloc = b.st[0], nx = b.st[1];
        if (nloc == 0u) { xcd_barrier_complete(bar, b.x, nloc, nx); b.st[0] = nloc; b.st[1] = nx; }
        const unsigned old = xb_add(&bar[XB_XSUB(b.x)], 1u);
        const unsigned gen = old / nloc;
        if (old + 1u == (gen + 1u) * nloc) {
            __builtin_amdgcn_fence(__ATOMIC_RELEASE, "agent");
            asm volatile("s_waitcnt vmcnt(0)" ::: "memory");
            const unsigned og = xb_add(&bar[XB_TOP], 1u);
            const unsigned tg = og / nx;
            if (og + 1u == (tg + 1u) * nx) xb_add(&bar[XB_TOPGEN], 1u);
            else XB_SPIN(xb_ld(&bar[XB_TOPGEN]) == tg, bar);
            __builtin_amdgcn_fence(__ATOMIC_ACQUIRE, "agent");
            xb_add(&bar[XB_XGEN(b.x)], 1u);
            asm volatile("s_waitcnt vmcnt(0)" ::: "memory");
        } else {
            XB_SPIN(xb_ld(&bar[XB_XGEN(b.x)]) == gen, bar);
            __builtin_amdgcn_fence(__ATOMIC_ACQUIRE, "agent");
            asm volatile("s_waitcnt vmcnt(0)" ::: "memory");
        }
    }
    __syncthreads();
}

enum { PH_W = 0, PH_INPROJ, PH_LAT, PH_QB_A, PH_IDX, PH_BATT, PH_UV, PH_OUT, PH_POST1, PH_XQ, PH_XATT, PH_XO, PH_POST2, PH_GU, PH_DOWN, PH_POST3, NPHASES };

template <int PH>
__device__ __forceinline__ void run_phase(const Params& p, const int l, unsigned char* smem, const int dup = 0) {
    unsigned char* ws = p.ws;
    unsigned* ctl = (unsigned*)(ws + WS_CTL);
    float* ssq = (float*)(ws + WS_SSQ);
    float* ssq_in = ssq + (size_t)(l == 0 ? 0 : 3 * l) * MTOK * 8;
    float* ssq_a = ssq + (size_t)(3 * l + 1) * MTOK * 8;
    float* ssq_b = ssq + (size_t)(3 * l + 2) * MTOK * 8;
    float* ssq_c = ssq + (size_t)(3 * l + 3) * MTOK * 8;
    const bool fused = gridDim.x == 256;
    if constexpr (PH == PH_W) {
        phase_weights(p, l, smem);
    } else if constexpr (PH == PH_INPROJ) {
        const float* rs = ssq_in;
        g8::gemm_phase((const bf16_t*)(ws + WS_H16), (const bf16_t*)(ws + W_IN), MTOK, OFF_KIDX, DM, g8::EpiBf16{(bf16_t*)(ws + WS_PROJ), NPROJ, 1 << 30, rs}, smem);
        g8::gemm_phase((const bf16_t*)(ws + WS_H16), (const bf16_t*)(ws + W_IN) + (size_t)OFF_CU * DM, MTOK, 1024, DM, g8::EpiBf16{(bf16_t*)(ws + WS_PROJ) + OFF_CU, NPROJ, 0, rs}, smem);
    } else if constexpr (PH == PH_LAT) {
        phase_latent_norms(p, l);
    } else if constexpr (PH == PH_QB_A) {
        unsigned* head = ctl + CW_QUEUE + 64 * (l * 8 + 0 + 4 * dup);
        const g8::EpiBf16 epi{(bf16_t*)(ws + WS_QB), NQB, 1 << 30, nullptr};
        const g8::EpiBf16 epik{(bf16_t*)(ws + WS_PROJ) + OFF_KIDX, NPROJ, 1 << 30, ssq_in};
        const g8::EpiBf16 epikv{(bf16_t*)(ws + WS_KVX), 1024, 1 << 30, nullptr};
        constexpr int U_ATT = 768, U_KW = U_ATT + 64, U_KV = U_KW + 16, U_QB = U_KV + 640, U_C = U_QB + 512;
        for (;;) {
            const int u = queue_next(head, smem);
            if (u >= U_C) break;
            if (u < U_ATT) { for (int rep_ = 0; rep_ < (PROBE_SUB == 5 ? 2 : 1); ++rep_) at::attnA_unit(p, u, smem); }
            else if (u < U_KW) { for (int rep_ = 0; rep_ < (PROBE_SUB == 8 ? 2 : 1); ++rep_) g8::gemm_tile((const bf16_t*)(ws + WS_H16), (const bf16_t*)(ws + W_IN) + (size_t)OFF_KIDX * DM, DM, u - U_ATT, 0, epik, smem); }
            else if (u < U_KV) { const int g = u - U_KW; g8::gemm_tile((const bf16_t*)(ws + WS_MEMN), (const bf16_t*)(ws + W_XKV), DM, g >> 2, g & 3, epikv, smem); }
            else if (u < U_QB) { const int g = u - U_KV; for (int rep_ = 0; rep_ < (PROBE_SUB == 6 ? 2 : 1); ++rep_) g8::gemm_tile((const bf16_t*)(ws + WS_CQN), (const bf16_t*)(ws + W_B), 512, g / 10, g % 10, epi, smem); }
            else { for (int rep_ = 0; rep_ < (PROBE_SUB == 7 ? 2 : 1); ++rep_) cbranch_unit(p, l, u - U_QB, smem); }
        }
    } else if constexpr (PH == PH_IDX) {
        unsigned* head = ctl + CW_QUEUE + 64 * (l * 8 + 1 + 4 * dup);
        for (;;) {
            const int u = queue_next(head, smem);
            if (u >= 256 + 1024) break;
            if (u < 256) at::attnA_combine(p, l, u);
            else { const int v = u - 256; for (int rep_ = 0; rep_ < (PROBE_SUB == 9 ? 2 : 1); ++rep_) ix::indexer_unit(p, v & 3, 255 - (v >> 2), smem); }
        }
    } else if constexpr (PH == PH_BATT) {
        bt::battn_rows(p, smem);
    } else if constexpr (PH == PH_UV) {
        for (int u = blockIdx.x; u < 384; u += gridDim.x) {
            const int pm = u & 63, h = u >> 6;
            g8::gemm_tile((const bf16_t*)(ws + WS_OLAT) + (size_t)h * MTOK * 256, (const bf16_t*)(ws + W_UVT) + (size_t)h * 128 * 256, 256, pm, 0,
                          g8::EpiHalfBf16{(bf16_t*)(ws + WS_MIX) + 768 + h * 128, NMIX}, smem);
        }
    } else if constexpr (PH == PH_OUT) {
        if (fused) g8::gemm_post_fused((const bf16_t*)(ws + WS_MIX), (const bf16_t*)(ws + W_OUT), NMIX,
                       g8::EpiFusedPost{(bf16_t*)(ws + WS_H16), nullptr, p.in[4] + (size_t)l * DM, ssq_a, (float*)(ws + WS_XBUF), ctl + CW_PANEL + ((l * 3 + 0) * 64) * 16, ctl + CW_TMO, smem}, smem);
        else g8::gemm_phase((const bf16_t*)(ws + WS_MIX), (const bf16_t*)(ws + W_OUT), MTOK, DM, NMIX, g8::EpiBf16{(bf16_t*)(ws + WS_TMP), DM, 1 << 30, nullptr}, smem);
    } else if constexpr (PH == PH_POST1) {
        phase_post((const bf16_t*)(ws + WS_TMP), l == 0 ? p.in[0] : nullptr, (bf16_t*)(ws + WS_H16), nullptr, p.in[4] + (size_t)l * DM, ssq_a);
    } else if constexpr (PH == PH_XQ) {
        unsigned* chead = ctl + CW_QUEUE + 64 * (l * 8 + 2 + 4 * dup);
        if ((int)blockIdx.x >= 128) for (;;) { const int u = queue_next(chead, smem); if (u >= 528) break; conv_run(p, l, NCONV_EARLY, NCONV, u * 4, 1, 4, opaque_tid(), smem); }
        g8::gemm_phase((const bf16_t*)(ws + WS_H16), (const bf16_t*)(ws + W_XQ), MTOK, 512, DM, g8::EpiBf16{(bf16_t*)(ws + WS_XQ), 512, 1 << 30, ssq_a}, smem);
        if ((int)blockIdx.x < 128) for (;;) { const int u = queue_next(chead, smem); if (u >= 528) break; conv_run(p, l, NCONV_EARLY, NCONV, u * 4, 1, 4, opaque_tid(), smem); }
    } else if constexpr (PH == PH_XATT) {
        for (int u = blockIdx.x; u < 256; u += gridDim.x) at::attnX_unit(p, u, smem);
    } else if constexpr (PH == PH_XO) {
        if (fused) g8::gemm_post_fused((const bf16_t*)(ws + WS_XO), (const bf16_t*)(ws + W_XO), 512,
                       g8::EpiFusedPost{(bf16_t*)(ws + WS_H16), nullptr, p.in[20] + (size_t)l * DM, ssq_b, (float*)(ws + WS_XBUF), ctl + CW_PANEL + ((l * 3 + 1) * 64) * 16, ctl + CW_TMO, smem}, smem);
        else g8::gemm_phase((const bf16_t*)(ws + WS_XO), (const bf16_t*)(ws + W_XO), MTOK, DM, 512, g8::EpiBf16{(bf16_t*)(ws + WS_TMP), DM, 1 << 30, nullptr}, smem);
    } else if constexpr (PH == PH_POST2) {
        phase_post((const bf16_t*)(ws + WS_TMP), nullptr, (bf16_t*)(ws + WS_H16), nullptr, p.in[20] + (size_t)l * DM, ssq_b);
    } else if constexpr (PH == PH_GU) {
        g8::gemm_phase((const bf16_t*)(ws + WS_H16), (const bf16_t*)(ws + W_GU), MTOK, 2 * FH, DM, g8::EpiSwiglu{(bf16_t*)(ws + WS_FFH), ssq_b}, smem);
    } else if constexpr (PH == PH_DOWN) {
        if (fused) g8::gemm_post_fused((const bf16_t*)(ws + WS_FFH), (const bf16_t*)(ws + W_DOWN), FH,
                       g8::EpiFusedPost{(bf16_t*)(ws + WS_H16), l + 1 < DEPTH ? nullptr : p.out, p.in[26] + (size_t)l * DM, ssq_c, (float*)(ws + WS_XBUF), ctl + CW_PANEL + ((l * 3 + 2) * 64) * 16, ctl + CW_TMO, smem}, smem);
        else g8::gemm_phase((const bf16_t*)(ws + WS_FFH), (const bf16_t*)(ws + W_DOWN), MTOK, DM, FH, g8::EpiBf16{(bf16_t*)(ws + WS_TMP), DM, 1 << 30, nullptr}, smem);
    } else if constexpr (PH == PH_POST3) {
        phase_post((const bf16_t*)(ws + WS_TMP), nullptr, (bf16_t*)(ws + WS_H16), l + 1 < DEPTH ? nullptr : p.out, p.in[26] + (size_t)l * DM, ssq_c);
    }
}

template <int PH>
__global__ void __launch_bounds__(NTHREADS, 2) k_phase(Params p) {
    extern __shared__ __attribute__((aligned(16))) unsigned char smem[];
    run_phase<PH>(p, p.layer, smem);
}

__global__ void __launch_bounds__(NTHREADS, 2) k_forward(Params p) {
    extern __shared__ __attribute__((aligned(16))) unsigned char smem[];
    if (threadIdx.x == 0) *(uint4*)(smem + LDS_CTL) = make_uint4(0u, 0u, 0u, 0u);
    __syncthreads();
    const XcdBarrier bar = xcd_barrier_post((unsigned*)(p.ws + WS_CTL) + CW_BAR, (volatile LAS unsigned*)(smem + LDS_CTL));
#define RUN(PH) do { run_phase<PH>(p, l, smem); xcd_barrier(bar); if (PROBE_DUP == PH) { run_phase<PH>(p, l, smem, 1); xcd_barrier(bar); } } while (0)
    for (int l = 0; l < DEPTH; ++l) {
        const bool fusedp = gridDim.x == 256;
        RUN(PH_W); RUN(PH_INPROJ); RUN(PH_LAT); RUN(PH_QB_A); RUN(PH_IDX); RUN(PH_BATT); RUN(PH_UV); RUN(PH_OUT); if (!fusedp) RUN(PH_POST1);
        RUN(PH_XQ); RUN(PH_XATT); RUN(PH_XO); if (!fusedp) RUN(PH_POST2); RUN(PH_GU); RUN(PH_DOWN); if (!fusedp) RUN(PH_POST3);
    }
#undef RUN
}

template <int PH>
static void launch_phase(Params& p, int grid, hipStream_t stream) {
    static bool attr = false;
    if (!attr) { (void)hipFuncSetAttribute((const void*)k_phase<PH>, hipFuncAttributeMaxDynamicSharedMemorySize, LDS_BYTES); attr = true; }
    hipLaunchKernelGGL(k_phase<PH>, dim3(grid), dim3(NTHREADS), LDS_BYTES, stream, p);
}

extern "C" void kernel_launch(void* const* d_in, const int* in_sizes, int n_in, void* d_out, int out_size, void* d_ws, size_t ws_size, hipStream_t stream) {
    if (n_in != 29 || out_size != MTOK * DM || ws_size < WS_END) {
        fprintf(stderr, "kernel_launch: unexpected problem (n_in %d, out %d, ws %zu, need %zu); nothing launched\n", n_in, out_size, ws_size, (size_t)WS_END);
        return;
    }
    static int grid = 0;
    if (!grid) {
        int dev = 0, cus = 0; (void)hipGetDevice(&dev); (void)hipDeviceGetAttribute(&cus, hipDeviceAttributeMultiprocessorCount, dev); grid = cus > 0 ? cus : 256;
#if MK_ONE_LAUNCH
        if (hipFuncSetAttribute((const void*)k_forward, hipFuncAttributeMaxDynamicSharedMemorySize, LDS_BYTES) != hipSuccess) { fprintf(stderr, "kernel_launch: hipFuncSetAttribute failed\n"); grid = -1; }
        int per_cu = 0;
        if (grid > 0 && (hipOccupancyMaxActiveBlocksPerMultiprocessor(&per_cu, (const void*)k_forward, NTHREADS, LDS_BYTES) != hipSuccess || per_cu < 1)) {
            fprintf(stderr, "kernel_launch: occupancy query reports %d workgroups per CU; nothing launched\n", per_cu); grid = -1; }
        (void)hipGetLastError();
#endif
    }
    if (grid < 0) return;
    (void)hipMemsetAsync((char*)d_ws + WS_CTL, 0, ZERO_BYTES, stream);
    Params p{};
    for (int i = 0; i < 29; ++i) p.in[i] = (const float*)d_in[i];
    p.out = (float*)d_out; p.ws = (unsigned char*)d_ws; p.layer = 0; p.phase = 0;
#if MK_ONE_LAUNCH
    hipLaunchKernelGGL(k_forward, dim3(grid), dim3(NTHREADS), LDS_BYTES, stream, p);
#else
    for (int l = 0; l < DEPTH; ++l) {
        p.layer = l;
        launch_phase<PH_W>(p, grid, stream);
        launch_phase<PH_INPROJ>(p, grid, stream);
        launch_phase<PH_LAT>(p, grid, stream);
        launch_phase<PH_QB_A>(p, grid, stream);
        launch_phase<PH_IDX>(p, grid, stream);
        launch_phase<PH_BATT>(p, grid, stream);
        launch_phase<PH_UV>(p, grid, stream);
        launch_phase<PH_OUT>(p, grid, stream);
        launch_phase<PH_POST1>(p, grid, stream);
        launch_phase<PH_XQ>(p, grid, stream);
        launch_phase<PH_XATT>(p, grid, stream);
        launch_phase<PH_XO>(p, grid, stream);
        launch_phase<PH_POST2>(p, grid, stream);
        launch_phase<PH_GU>(p, grid, stream);
        launch_phase<PH_DOWN>(p, grid, stream);
        launch_phase<PH_POST3>(p, grid, stream);
    }
#endif
}
```
